# Optimizing an MI355X kernel written in HIP

```python
import math
import jax, jax.numpy as jnp
from jax import lax
import numpy as np

D_MODEL = 1024
BATCH = 16
SEQ = 256
DEPTH = 4
DEC_BATCH = 8
DEC_SEQ = 4096
PAST_LEN = 512

GRID_W = 64
N_EVEN = (DEPTH + 1) // 2
N_ODD = DEPTH // 2
EPS = 1e-6
NEG = -1e30
CONV_W = 4
D_RNN = D_MODEL // 2
RG_BLOCKS = 8
RG_BLOCK = D_RNN // RG_BLOCKS
RG_C = 8.0
N_HEADS = 8
N_KV = 2
HEAD_DIM = 64
Q_GROUP = N_HEADS // N_KV
WINDOW = 128
ATT_BLOCK = 128
ROPE_AXIS = HEAD_DIM // 2
ROPE_BASE = 10000.0
EVEN_SPLIT = [D_RNN, 2 * D_RNN, 2 * D_RNN + N_HEADS * HEAD_DIM, 2 * D_RNN + (N_HEADS + N_KV) * HEAD_DIM]
EVEN_IN = 2 * D_RNN + (N_HEADS + 2 * N_KV) * HEAD_DIM
EVEN_OUT = D_RNN + N_HEADS * HEAD_DIM
DN_HEADS = 8
DN_DK = 128
DN_DV = 128
DN_CHUNK = 64
DN_HK = DN_HEADS * DN_DK
DN_HV = DN_HEADS * DN_DV
DN_QKV = 2 * DN_HK + DN_HV
ODD_IN = DN_QKV + DN_HV + 4 * DN_HEADS
D_FF = -(-8 * D_MODEL // (3 * 256)) * 256

kernel_name = "hybrid_flow_prefix_rglru_swa_gdn_step"


def rmsnorm(x, gain):
    xf = x.astype(jnp.float32)
    y = xf * lax.rsqrt(jnp.mean(xf * xf, axis=-1, keepdims=True) + EPS)
    return (y * gain.astype(jnp.float32)).astype(x.dtype)


def l2norm(x):
    return x * lax.rsqrt(jnp.sum(x * x, axis=-1, keepdims=True) + EPS)


def centred_conv(x, w, b=None):
    T = x.shape[1]
    left = CONV_W // 2
    xp = jnp.pad(x, ((0, 0), (left, CONV_W - 1 - left), (0, 0)))
    y = xp[:, 0:T] * w[0]
    for j in range(1, CONV_W):
        y = y + xp[:, j:j + T] * w[j]
    return y if b is None else y + b


def _lin_combine(left, right):
    a_l, b_l = left
    a_r, b_r = right
    return a_l * a_r, a_r * b_l + b_r


def rglru_scan(xc, w_a, b_a, w_x, b_x, lam, h0):
    B, T, _ = xc.shape
    xb = xc.reshape(B, T, RG_BLOCKS, RG_BLOCK)
    r = jax.nn.sigmoid(jnp.einsum('btnc,ncd->btnd', xb, w_a).reshape(B, T, D_RNN) + b_a)
    i = jax.nn.sigmoid(jnp.einsum('btnc,ncd->btnd', xb, w_x).reshape(B, T, D_RNN) + b_x)
    log_a = -RG_C * r * jax.nn.softplus(-lam.astype(jnp.float32))
    a = jnp.exp(log_a)
    b = jnp.sqrt(-jnp.expm1(2.0 * log_a)) * (i * xc)
    a_cum, b_cum = lax.associative_scan(_lin_combine, (a, b), axis=1)
    h = a_cum * h0[:, None, :] + b_cum
    return h, h[:, -1]


def axial_angles(n_tokens):
    rows = n_tokens // GRID_W
    row = jnp.repeat(jnp.arange(rows, dtype=jnp.float32), GRID_W)
    col = jnp.tile(jnp.arange(GRID_W, dtype=jnp.float32), rows)
    inv = ROPE_BASE ** (-jnp.arange(0, ROPE_AXIS, 2, dtype=jnp.float32) / ROPE_AXIS)
    return row[:, None] * inv, col[:, None] * inv


def rope_1d(x, ang):
    x1, x2 = jnp.split(x.astype(jnp.float32), 2, axis=-1)
    cos = jnp.cos(ang)[None, :, None, :]
    sin = jnp.sin(ang)[None, :, None, :]
    return jnp.concatenate([x1 * cos - x2 * sin, x1 * sin + x2 * cos], axis=-1)


def axial_rope(x, ang_r, ang_c):
    return jnp.concatenate([rope_1d(x[..., :ROPE_AXIS], ang_r), rope_1d(x[..., ROPE_AXIS:], ang_c)], axis=-1).astype(x.dtype)


def context_attention(q, k, v, sink):
    B, L = q.shape[:2]
    nb = L // ATT_BLOCK
    scale = HEAD_DIM ** -0.5
    qb = jnp.moveaxis(q.reshape(B, nb, ATT_BLOCK, N_KV, Q_GROUP, HEAD_DIM), 1, 0)
    sk = sink.astype(jnp.float32).reshape(N_KV, Q_GROUP)[None, :, :, None, None]

    def block(q_n):
        s = jnp.einsum('bikgd,bjkd->bkgij', q_n, k).astype(jnp.float32) * scale
        m = jnp.maximum(jnp.max(s, axis=-1, keepdims=True), sk)
        p = jnp.exp(s - m)
        den = jnp.sum(p, axis=-1, keepdims=True) + jnp.exp(sk - m)
        return jnp.einsum('bkgij,bjkd->bikgd', (p / den).astype(v.dtype), v)

    o = lax.map(block, qb)
    return jnp.moveaxis(o, 0, 1).reshape(B, L, N_HEADS * HEAD_DIM)


def latent_attention(q, k, v, ctx_k, ctx_v, sink):
    B, T = q.shape[:2]
    nb = T // ATT_BLOCK
    scale = HEAD_DIM ** -0.5
    qb = jnp.moveaxis(q.reshape(B, nb, ATT_BLOCK, N_KV, Q_GROUP, HEAD_DIM), 1, 0)
    pad = ((0, 0), (ATT_BLOCK, ATT_BLOCK), (0, 0), (0, 0))
    kp = jnp.pad(k, pad)
    vp = jnp.pad(v, pad)
    ctx_k = ctx_k.astype(q.dtype)
    ctx_v = ctx_v.astype(v.dtype)
    offs = jnp.arange(3 * ATT_BLOCK)[None, :] - ATT_BLOCK - jnp.arange(ATT_BLOCK)[:, None]
    in_window = jnp.abs(offs) <= WINDOW
    sk = sink.astype(jnp.float32).reshape(N_KV, Q_GROUP)[None, :, :, None, None]

    def block(args):
        n, q_n = args
        start = n * ATT_BLOCK
        k_n = lax.dynamic_slice_in_dim(kp, start, 3 * ATT_BLOCK, axis=1)
        v_n = lax.dynamic_slice_in_dim(vp, start, 3 * ATT_BLOCK, axis=1)
        kpos = start - ATT_BLOCK + jnp.arange(3 * ATT_BLOCK)
        valid = in_window & ((kpos >= 0) & (kpos < T))[None, :]
        s_w = jnp.einsum('bikgd,bjkd->bkgij', q_n, k_n).astype(jnp.float32) * scale
        s_w = jnp.where(valid, s_w, NEG)
        s_c = jnp.einsum('bikgd,bckd->bkgic', q_n, ctx_k).astype(jnp.float32) * scale
        m = jnp.maximum(jnp.maximum(jnp.max(s_w, axis=-1, keepdims=True), jnp.max(s_c, axis=-1, keepdims=True)), sk)
        p_w = jnp.exp(s_w - m)
        p_c = jnp.exp(s_c - m)
        den = jnp.sum(p_w, axis=-1, keepdims=True) + jnp.sum(p_c, axis=-1, keepdims=True) + jnp.exp(sk - m)
        return (jnp.einsum('bkgij,bjkd->bikgd', (p_w / den).astype(v.dtype), v_n)
                + jnp.einsum('bkgic,bckd->bikgd', (p_c / den).astype(v.dtype), ctx_v))

    o = lax.map(block, (jnp.arange(nb), qb))
    return jnp.moveaxis(o, 0, 1).reshape(B, T, N_HEADS * HEAD_DIM)


def chunk_gated_delta(q, k, v, g, beta, s0):
    B, T, H, _ = q.shape
    dv = v.shape[-1]
    n, C = T // DN_CHUNK, DN_CHUNK

    def chunks(t):
        return jnp.moveaxis(t.reshape((B, n, C, H) + t.shape[3:]), (1, 3), (0, 2))

    qc, kc, vc, bc = chunks(q), chunks(k), chunks(v), chunks(beta)
    gc = jnp.cumsum(chunks(g), axis=-1)
    idx = jnp.arange(C)
    incl = idx[:, None] >= idx[None, :]
    strict = idx[:, None] > idx[None, :]
    decay = jnp.exp(jnp.where(incl, gc[..., :, None] - gc[..., None, :], NEG))
    kk = jnp.einsum('nbhid,nbhjd->nbhij', kc, kc)
    a_mat = jnp.where(strict, bc[..., :, None] * kk * decay, 0.0) + jnp.eye(C, dtype=jnp.float32)
    rhs = jnp.concatenate([vc * bc[..., None], kc * (bc * jnp.exp(gc))[..., None]], axis=-1)
    sol = lax.linalg.triangular_solve(a_mat, rhs, left_side=True, lower=True, unit_diagonal=True)
    u, w = sol[..., :dv], sol[..., dv:]
    qk = jnp.einsum('nbhid,nbhjd->nbhij', qc, kc) * decay
    qg = qc * jnp.exp(gc)[..., None]
    kd = kc * jnp.exp(gc[..., -1:] - gc)[..., None]
    g_last = jnp.exp(gc[..., -1])

    def step(S, xs):
        qg_c, kd_c, u_c, w_c, qk_c, gl_c = xs
        v_new = u_c - jnp.einsum('bhck,bhkv->bhcv', w_c, S)
        o = jnp.einsum('bhck,bhkv->bhcv', qg_c, S) + jnp.einsum('bhij,bhjv->bhiv', qk_c, v_new)
        S = S * gl_c[..., None, None] + jnp.einsum('bhck,bhcv->bhkv', kd_c, v_new)
        return S, o

    s_final, o = lax.scan(step, s0, (qg, kd, u, w, qk, g_last))
    o = jnp.moveaxis(o, (0, 2), (1, 3)).reshape(B, T, H, dv)
    return o, s_final


def even_mixer(h, w_in, conv_w, conv_b, rg_wa, rg_ba, rg_wx, rg_bx, rg_lam, sink, w_out, ctx_k, ctx_v, h0):
    B, T, _ = h.shape
    xr, gr, q, k, v = jnp.split(h @ w_in, EVEN_SPLIT, axis=-1)
    xc = centred_conv(xr, conv_w, conv_b).astype(jnp.float32)
    hf, sf = rglru_scan(xc, rg_wa[0], rg_ba[0], rg_wx[0], rg_bx[0], rg_lam[0], h0[:, 0])
    hb, sb = rglru_scan(xc[:, ::-1], rg_wa[1], rg_ba[1], rg_wx[1], rg_bx[1], rg_lam[1], h0[:, 1])
    y_r = (hf + hb[:, ::-1]).astype(h.dtype) * jax.nn.gelu(gr)
    q = q.reshape(B, T, N_HEADS, HEAD_DIM)
    k = k.reshape(B, T, N_KV, HEAD_DIM)
    v = v.reshape(B, T, N_KV, HEAD_DIM)
    if ctx_k is None:
        y_a = context_attention(q, k, v, sink)
    else:
        ang_r, ang_c = axial_angles(T)
        q = axial_rope(q, ang_r, ang_c)
        k = axial_rope(k, ang_r, ang_c)
        y_a = latent_attention(q, k, v, ctx_k, ctx_v, sink)
    out = jnp.concatenate([y_r, y_a], axis=-1) @ w_out
    return out, jnp.stack([sf, sb], axis=1), k, v


def odd_mixer(h, w_in, conv_w, a_log, dt_bias, o_norm, w_out, s0):
    B, T, _ = h.shape
    qkv, z, ab = jnp.split(h @ w_in, [DN_QKV, DN_QKV + DN_HV], axis=-1)
    qkv = jax.nn.silu(centred_conv(qkv, conv_w)).astype(jnp.float32)
    q, k, v = jnp.split(qkv, [DN_HK, 2 * DN_HK], axis=-1)
    q = l2norm(q.reshape(B, T, DN_HEADS, DN_DK)) * (DN_DK ** -0.5)
    k = l2norm(k.reshape(B, T, DN_HEADS, DN_DK))
    v = v.reshape(B, T, DN_HEADS, DN_DV)
    ab = ab.astype(jnp.float32).reshape(B, T, 2, 2, DN_HEADS)
    g = -jnp.exp(a_log.astype(jnp.float32)) * jax.nn.softplus(ab[:, :, 0] + dt_bias.astype(jnp.float32))
    beta = jax.nn.sigmoid(ab[:, :, 1])
    o_f, s_f = chunk_gated_delta(q, k, v, g[:, :, 0], beta[:, :, 0], s0[:, 0])
    o_b, s_b = chunk_gated_delta(q[:, ::-1], k[:, ::-1], v[:, ::-1], g[:, ::-1, 1], beta[:, ::-1, 1], s0[:, 1])
    o = rmsnorm(o_f + o_b[:, ::-1], o_norm) * jax.nn.silu(z.astype(jnp.float32).reshape(B, T, DN_HEADS, DN_DV))
    out = o.reshape(B, T, DN_HV).astype(h.dtype) @ w_out
    return out, jnp.stack([s_f, s_b], axis=1)


def swiglu(h, w_gu, w_down):
    gate, up = jnp.split(h @ w_gu, 2, axis=-1)
    return (jax.nn.silu(gate) * up) @ w_down


def run_trunk(x, cond, weights, caches):
    (w_mod, b_mod, g_mix, g_ffn, g_final, w_in_even, conv_rg, conv_rg_b, rg_wa, rg_ba, rg_wx, rg_bx,
     rg_lam, attn_sink, w_out_even, w_in_odd, conv_dn, dn_a_log, dn_dt_bias, dn_o_norm, w_out_odd,
     w_gu, w_down) = weights
    B = x.shape[0]
    ks, vs, rgs, dns = [], [], [], []
    for l in range(DEPTH):
        i = l // 2
        sh1, sc1, ga1, sh2, sc2, ga2 = jnp.split(jax.nn.silu(cond) @ w_mod[l] + b_mod[l], 6, axis=-1)
        h = rmsnorm(x, g_mix[l]) * (1 + sc1) + sh1
        if l % 2 == 0:
            if caches is None:
                ck, cv = None, None
                h0 = jnp.zeros((B, 2, D_RNN), jnp.float32)
            else:
                ck, cv, h0 = caches[0][:, i], caches[1][:, i], caches[2][:, i].astype(jnp.float32)
            out, st, k, v = even_mixer(h, w_in_even[i], conv_rg[i], conv_rg_b[i], rg_wa[i], rg_ba[i], rg_wx[i],
                                       rg_bx[i], rg_lam[i], attn_sink[i], w_out_even[i], ck, cv, h0)
            ks.append(k)
            vs.append(v)
            rgs.append(st)
        else:
            if caches is None:
                s0 = jnp.zeros((B, 2, DN_HEADS, DN_DK, DN_DV), jnp.float32)
            else:
                s0 = caches[3][:, i].astype(jnp.float32)
            out, st = odd_mixer(h, w_in_odd[i], conv_dn[i], dn_a_log[i], dn_dt_bias[i], dn_o_norm[i], w_out_odd[i], s0)
            dns.append(st)
        x = x + ga1 * out
        h = rmsnorm(x, g_ffn[l]) * (1 + sc2) + sh2
        x = x + ga2 * swiglu(h, w_gu[l], w_down[l])
    y = rmsnorm(x, g_final)
    return y, jnp.stack(ks, axis=1), jnp.stack(vs, axis=1), jnp.stack(rgs, axis=1), jnp.stack(dns, axis=1)


def setup_inputs(seed: int = 0) -> dict:
    key = jax.random.key(seed)
    keys = iter(jax.random.split(key, 40))

    def nrm(shape, scale):
        return jax.random.normal(next(keys), shape, jnp.float32) * scale

    def unif(shape, lo, hi):
        return jax.random.uniform(next(keys), shape, jnp.float32, lo, hi)

    x_prompt = nrm((BATCH, SEQ, D_MODEL), 1.0)
    x_sample = nrm((DEC_BATCH, DEC_SEQ, D_MODEL), 1.0)
    c = nrm((DEC_BATCH, D_MODEL), 1.0)
    cache_attn_k = nrm((DEC_BATCH, N_EVEN, PAST_LEN, N_KV, HEAD_DIM), 1.0)
    cache_attn_v = nrm((DEC_BATCH, N_EVEN, PAST_LEN, N_KV, HEAD_DIM), 1.0)
    state_rglru = nrm((DEC_BATCH, N_EVEN, 2, D_RNN), 0.5)
    state_delta = nrm((DEC_BATCH, N_ODD, 2, DN_HEADS, DN_DK, DN_DV), 0.1)
    c_ctx = nrm((D_MODEL,), 1.0)
    w_mod = nrm((DEPTH, D_MODEL, 6 * D_MODEL), D_MODEL ** -0.5)
    b_mod = nrm((DEPTH, 6 * D_MODEL), 0.02)
    g_mix = 1.0 + nrm((DEPTH, D_MODEL), 0.05)
    g_ffn = 1.0 + nrm((DEPTH, D_MODEL), 0.05)
    g_final = 1.0 + nrm((D_MODEL,), 0.05)
    w_in_even = nrm((N_EVEN, D_MODEL, EVEN_IN), D_MODEL ** -0.5)
    conv_rg = nrm((N_EVEN, CONV_W, D_RNN), CONV_W ** -0.5)
    conv_rg_b = nrm((N_EVEN, D_RNN), 0.02)
    rg_wa = nrm((N_EVEN, 2, RG_BLOCKS, RG_BLOCK, RG_BLOCK), RG_BLOCK ** -0.5)
    rg_ba = nrm((N_EVEN, 2, D_RNN), 0.02)
    rg_wx = nrm((N_EVEN, 2, RG_BLOCKS, RG_BLOCK, RG_BLOCK), RG_BLOCK ** -0.5)
    rg_bx = nrm((N_EVEN, 2, D_RNN), 0.02)
    a_c = unif((N_EVEN, 2, D_RNN), 0.9, 0.999) ** (1.0 / RG_C)
    rg_lam = jnp.log(a_c) - jnp.log1p(-a_c)
    attn_sink = nrm((N_EVEN, N_HEADS), 0.5)
    w_out_even = nrm((N_EVEN, EVEN_OUT, D_MODEL), EVEN_OUT ** -0.5)
    w_in_odd = nrm((N_ODD, D_MODEL, ODD_IN), D_MODEL ** -0.5)
    conv_dn = nrm((N_ODD, CONV_W, DN_QKV), CONV_W ** -0.5)
    dn_a_log = jnp.log(unif((N_ODD, 2, DN_HEADS), 1.0, 16.0))
    dt = jnp.exp(unif((N_ODD, 2, DN_HEADS), math.log(1e-3), math.log(1e-1)))
    dn_dt_bias = dt + jnp.log(-jnp.expm1(-dt))
    dn_o_norm = 1.0 + nrm((N_ODD, DN_DV), 0.05)
    w_out_odd = nrm((N_ODD, DN_HV, D_MODEL), DN_HV ** -0.5)
    w_gu = nrm((DEPTH, D_MODEL, 2 * D_FF), D_MODEL ** -0.5)
    w_down = nrm((DEPTH, D_FF, D_MODEL), D_FF ** -0.5)
    return {"x_prompt": x_prompt, "x_sample": x_sample, "c": c,
            "cache_attn_k": cache_attn_k, "cache_attn_v": cache_attn_v,
            "state_rglru": state_rglru, "state_delta": state_delta, "c_ctx": c_ctx,
            "w_mod": w_mod, "b_mod": b_mod, "g_mix": g_mix, "g_ffn": g_ffn, "g_final": g_final,
            "w_in_even": w_in_even, "conv_rg": conv_rg, "conv_rg_b": conv_rg_b, "rg_wa": rg_wa,
            "rg_ba": rg_ba, "rg_wx": rg_wx, "rg_bx": rg_bx, "rg_lam": rg_lam, "attn_sink": attn_sink,
            "w_out_even": w_out_even, "w_in_odd": w_in_odd, "conv_dn": conv_dn, "dn_a_log": dn_a_log,
            "dn_dt_bias": dn_dt_bias, "dn_o_norm": dn_o_norm, "w_out_odd": w_out_odd,
            "w_gu": w_gu, "w_down": w_down}


def reference(x_prompt, x_sample, c, cache_attn_k, cache_attn_v, state_rglru, state_delta, c_ctx,
              w_mod, b_mod, g_mix, g_ffn, g_final, w_in_even, conv_rg, conv_rg_b, rg_wa, rg_ba, rg_wx,
              rg_bx, rg_lam, attn_sink, w_out_even, w_in_odd, conv_dn, dn_a_log, dn_dt_bias, dn_o_norm,
              w_out_odd, w_gu, w_down):
    weights = (w_mod, b_mod, g_mix, g_ffn, g_final, w_in_even, conv_rg, conv_rg_b, rg_wa, rg_ba, rg_wx,
               rg_bx, rg_lam, attn_sink, w_out_even, w_in_odd, conv_dn, dn_a_log, dn_dt_bias, dn_o_norm,
               w_out_odd, w_gu, w_down)
    y_prompt, new_k, new_v, new_rg, new_dn = run_trunk(x_prompt, c_ctx[None, None, :], weights, None)
    y_sample = run_trunk(x_sample, c[:, None, :], weights,
                         (cache_attn_k, cache_attn_v, state_rglru, state_delta))[0]
    return (y_prompt, y_sample, new_k, new_v, new_rg, new_dn)
```

```cpp
#include <hip/hip_runtime.h>
#include <hip/hip_cooperative_groups.h>
#include <cstdio>
namespace cg = cooperative_groups;
#define DI __device__ __forceinline__
#define LAS __attribute__((address_space(3)))
typedef unsigned short bf16_t;
typedef short bf16x8 __attribute__((ext_vector_type(8)));
typedef float f32x4 __attribute__((ext_vector_type(4)));
typedef float f32x16 __attribute__((ext_vector_type(16)));
typedef unsigned u32x4 __attribute__((ext_vector_type(4)));
typedef unsigned u32x2 __attribute__((ext_vector_type(2)));
typedef LAS unsigned char* lptr;

constexpr int M_TOT = 36864, M_P = 4096, DM = 1024;
constexpr int EVEN_IN = 1792, ODD_NP = 4352, ODD_LD = 4096, DFF = 2816;
constexpr int OFF_K = M_TOT * DM, OFF_V = OFF_K + 1048576, OFF_RG = OFF_V + 1048576, OFF_DN = OFF_RG + 32768;
constexpr size_t WS_MOD = 0;
constexpr size_t WS_ROPE = WS_MOD + 884736;
constexpr size_t WS_WIN = WS_ROPE + 1048576;
constexpr size_t WS_WOUT = WS_WIN + (size_t)ODD_NP * 1024 * 2;
constexpr size_t WS_WGU = WS_WOUT + 1024 * 1024 * 2;
constexpr size_t WS_WDN = WS_WGU + (size_t)5632 * 1024 * 2;
constexpr size_t WS_RGW = WS_WDN + (size_t)1024 * 2816 * 2;
constexpr size_t WS_H = WS_RGW + 262144;
constexpr size_t WS_P = WS_H + (size_t)M_TOT * 1024 * 2;
constexpr size_t WS_AB = WS_P + (size_t)M_TOT * 4096 * 2;
constexpr size_t WS_HALO = WS_AB + (size_t)M_TOT * 32 * 4;
constexpr size_t WS_T = WS_HALO + (size_t)576 * 3 * 3072 * 2;
constexpr size_t WS_CARRY = WS_T + (size_t)576 * 8 * 2 * 4096 * 2;
constexpr size_t WS_END = WS_CARRY + (size_t)576 * 2 * 2 * 512 * 4;
constexpr size_t WS_BAR = WS_END;
constexpr size_t WS_TOTAL = WS_BAR + 16384;
constexpr int LDS_BYTES = 160 * 1024;

struct Params {
  const float* in[31];
  float* out;
  unsigned char* ws;
  int p_lo, p_hi, coop, pad;
};

DI int tid_opaque() { int t = threadIdx.x; asm volatile("" : "+v"(t)); return t; }
DI int bid_opaque() { int t = blockIdx.x; asm volatile("" : "+s"(t)); return t; }

typedef __bf16 hwbf16x2 __attribute__((ext_vector_type(2)));
typedef float f32x2v __attribute__((ext_vector_type(2)));
DI unsigned pack2(float lo, float hi) { const f32x2v v = {lo, hi}; return __builtin_bit_cast(unsigned, __builtin_convertvector(v, hwbf16x2)); }
DI bf16_t f2bf(float f) { return (bf16_t)(pack2(f, 0.f) & 0xffffu); }
DI float bf2f(bf16_t b) { return __uint_as_float(((unsigned)b) << 16); }
DI float lo2f(unsigned u) { return __uint_as_float(u << 16); }
DI float hi2f(unsigned u) { return __uint_as_float(u & 0xffff0000u); }
DI float sigmoidf_(float x) { return __builtin_amdgcn_rcpf(1.f + __expf(-x)); }
DI float siluf_(float x) { return x * __builtin_amdgcn_rcpf(1.f + __expf(-x)); }
DI float softplusf_(float x) { return x > 20.f ? x : log1pf(__expf(x)); }
DI int crow(int reg, int h) { return (reg & 3) + 8 * (reg >> 2) + 4 * h; }
DI int row_group(int r) { return r < M_P ? 0 : 1 + ((r - M_P) >> 12); }
DI float wave_sum(float v) {
#pragma unroll
  for (int o = 32; o > 0; o >>= 1) v += __shfl_xor(v, o);
  return v;
}
#define MFMA32(a, b, c) __builtin_amdgcn_mfma_f32_32x32x16_bf16((a), (b), (c), 0, 0, 0)
DI f32x16 mm32(const LAS bf16_t* A, int lda, const LAS bf16_t* Bt, int ldb, int K, f32x16 acc, int lane) {
  const int r = lane & 31, h = lane >> 5;
  const LAS bf16_t* ap = A + r * lda + 8 * h;
  const LAS bf16_t* bp = Bt + r * ldb + 8 * h;
_Pragma("unroll 4")
  for (int k0 = 0; k0 < K; k0 += 16) {
    bf16x8 a = *(const LAS bf16x8*)(ap + k0);
    bf16x8 b = *(const LAS bf16x8*)(bp + k0);
    acc = MFMA32(a, b, acc);
  }
  return acc;
}
DI f32x16 zero16() { f32x16 z; for (int i = 0; i < 16; ++i) z[i] = 0.f; return z; }

DI void phase_pre(const Params& p, lptr lds, int l_lo, int l_hi, int vb, int nb, bool rope) {
  const int tid = tid_opaque(), wid = tid >> 6, lane = tid & 63;
  float* rc = (float*)(p.ws + WS_ROPE); float* rs = rc + 4096 * 32;
  if (rope)
  for (int e = bid_opaque() * 512 + tid; e < 4096 * 32; e += gridDim.x * 512) {
    const int t = e >> 5, f = e & 31, fr = f & 15;
    const float inv = exp2f(-(float)fr * 0.83048202372184058696f);
    const float pos = (f < 16) ? (float)(t >> 6) : (float)(t & 63);
    float x = pos * inv * 0.15915494309189533577f; x -= floorf(x);
    rc[e] = __builtin_amdgcn_cosf(x); rs[e] = __builtin_amdgcn_sinf(x);
  }
  LAS float* sc = (LAS float*)lds;
  LAS float* red = sc + 9 * 1024;
  for (int e = tid; e < 9 * 1024; e += 512) { const int g = e >> 10, k = e & 1023; const float v = g == 0 ? p.in[7][k] : p.in[2][(g - 1) * 1024 + k]; sc[e] = siluf_(v); }
  __syncthreads();
  float* mod = (float*)(p.ws + WS_MOD);
  for (int it = vb; it < (l_hi - l_lo) * 96; it += nb) {
    const int l = l_lo + it / 96, n0 = (it % 96) * 64;
    const float* w = p.in[8] + (size_t)l * 1024 * 6144 + n0 + lane;
    float acc[9];
#pragma unroll
    for (int g = 0; g < 9; ++g) acc[g] = 0.f;
#pragma unroll 16
    for (int k = wid * 128; k < wid * 128 + 128; ++k) {
      const float wv = w[(size_t)k * 6144];
#pragma unroll
      for (int g = 0; g < 9; ++g) acc[g] += sc[g * 1024 + k] * wv;
    }
#pragma unroll
    for (int g = 0; g < 9; ++g) red[(wid * 9 + g) * 64 + lane] = acc[g];
    __syncthreads();
    for (int e = tid; e < 9 * 64; e += 512) {
      const int g = e >> 6, c = e & 63; float s = 0.f;
#pragma unroll
      for (int w8 = 0; w8 < 8; ++w8) s += red[(w8 * 9 + g) * 64 + c];
      mod[((size_t)l * 9 + g) * 6144 + n0 + c] = s + p.in[9][l * 6144 + n0 + c];
    }
    __syncthreads();
  }
}

DI void cvt_tile(const float* src, int lds_src, int nvalid, bf16_t* dst, int ldd, int k0, int n0, int mode, LAS float* buf) {
  const int tid = tid_opaque();
  for (int e = tid; e < 4096; e += 512) { const int i = e >> 6, j = e & 63; buf[i * 65 + j] = (j < nvalid) ? src[(size_t)i * lds_src + j] : 0.f; }
  __syncthreads();
  for (int e = tid; e < 2048; e += 512) {
    const int j = e >> 5, i2 = (e & 31) * 2;
    if (j < nvalid) {
      int n = n0 + j, row = n;
      if (mode == 1) { const int up = n >= DFF ? 1 : 0; const int jj = n - up * DFF; row = 256 * (jj >> 7) + 128 * up + (jj & 127); }
      *(unsigned*)(dst + (size_t)row * ldd + k0 + i2) = pack2(buf[i2 * 65 + j], buf[(i2 + 1) * 65 + j]);
    }
  }
  __syncthreads();
}
DI void cvt_matrix(const float* W, int K, int N, bf16_t* dst, int mode, LAS float* buf, int vb, int nb) {
  const int nk = K / 64, nn = (N + 63) / 64;
  for (int t = vb; t < nk * nn; t += nb) {
    const int tk = t % nk, tn = t / nk, k0 = tk * 64, n0 = tn * 64;
    const int nvalid = (N - n0) < 64 ? (N - n0) : 64;
    cvt_tile(W + (size_t)k0 * N + n0, N, nvalid, dst, K, k0, n0, mode, buf);
  }
}

DI void cvt_layer(const Params& p, lptr lds, int l, int what, int vb, int nb) {
  const int tid = tid_opaque();
  const int i2 = l >> 1;
  LAS float* buf = (LAS float*)lds;
  if (what & 1) {
    if ((l & 1) == 0) {
      cvt_matrix(p.in[13] + (size_t)i2 * 1024 * EVEN_IN, 1024, EVEN_IN, (bf16_t*)(p.ws + WS_WIN), 0, buf, vb, nb);
      cvt_matrix(p.in[22] + (size_t)i2 * 1024 * 1024, 1024, 1024, (bf16_t*)(p.ws + WS_WOUT), 0, buf, vb, nb);
      for (int t = vb; t < 32; t += nb) {
        const int gate = t >> 4, dir = (t >> 3) & 1, n = t & 7;
        const float* srcp = (gate ? p.in[18] : p.in[16]) + ((size_t)(i2 * 2 + dir) * 8 + n) * 4096;
        cvt_tile(srcp, 64, 64, (bf16_t*)(p.ws + WS_RGW) + ((size_t)(dir * 2 + gate) * 8 + n) * 4096, 64, 0, 0, 0, buf);
      }
    } else {
      cvt_matrix(p.in[23] + (size_t)i2 * 1024 * 4128, 1024, 4128, (bf16_t*)(p.ws + WS_WIN), 0, buf, vb, nb);
      cvt_matrix(p.in[28] + (size_t)i2 * 1024 * 1024, 1024, 1024, (bf16_t*)(p.ws + WS_WOUT), 0, buf, vb, nb);
      u32x4* z = (u32x4*)((bf16_t*)(p.ws + WS_WIN) + (size_t)4128 * 1024);
      for (int e = vb * 512 + tid; e < 224 * 1024 / 8; e += nb * 512) z[e] = (u32x4){0u, 0u, 0u, 0u};
    }
  }
  if (what & 2) cvt_matrix(p.in[29] + (size_t)l * 1024 * 5632, 1024, 5632, (bf16_t*)(p.ws + WS_WGU), 1, buf, vb, nb);
  if (what & 4) cvt_matrix(p.in[30] + (size_t)l * DFF * 1024, DFF, 1024, (bf16_t*)(p.ws + WS_WDN), 0, buf, vb, nb);
}

DI void phase_norm(const Params& p, lptr lds, int l, int which) {
  const int tid = tid_opaque(), wid = tid >> 6, lane = tid & 63;
  const int i2 = l >> 1;
  if (which == 0) { if (l == 0) cvt_layer(p, lds, 0, 7, bid_opaque(), gridDim.x); else cvt_layer(p, lds, l, gridDim.x == 256 ? 4 : 7, bid_opaque(), gridDim.x); }
  const bool first = (l == 0 && which == 0);
  const float* mod = (const float*)(p.ws + WS_MOD);
  bf16_t* h = (bf16_t*)(p.ws + WS_H);
  const float* gn = (which ? p.in[11] : p.in[10]) + l * 1024;
  const int rstride = gridDim.x * 8;
  for (int row0 = bid_opaque() * 8 + wid; row0 < M_TOT; row0 += 6 * rstride) {
    f32x4 v[6][4]; float ss[6];
#pragma unroll
    for (int q = 0; q < 6; ++q) {
      const int row = row0 + q * rstride < M_TOT ? row0 + q * rstride : row0;
      const float* xs = first ? (row < M_P ? p.in[0] + (size_t)row * 1024 : p.in[1] + (size_t)(row - M_P) * 1024) : p.out + (size_t)row * 1024;
#pragma unroll
      for (int i = 0; i < 4; ++i) v[q][i] = *(const f32x4*)(xs + lane * 4 + 256 * i);
    }
#pragma unroll
    for (int q = 0; q < 6; ++q) {
      float s = 0.f;
#pragma unroll
      for (int i = 0; i < 4; ++i) s += v[q][i][0] * v[q][i][0] + v[q][i][1] * v[q][i][1] + v[q][i][2] * v[q][i][2] + v[q][i][3] * v[q][i][3];
      ss[q] = wave_sum(s);
    }
#pragma unroll
    for (int q = 0; q < 6; ++q) {
      const int row = row0 + q * rstride;
      if (row < M_TOT) {
        const float rstd = rsqrtf(ss[q] * (1.f / 1024.f) + 1e-6f);
        const float* md = mod + ((size_t)l * 9 + row_group(row)) * 6144 + (which ? 3072 : 0);
#pragma unroll
        for (int i = 0; i < 4; ++i) {
          const int c = lane * 4 + 256 * i;
          const f32x4 gg = *(const f32x4*)(gn + c), sh = *(const f32x4*)(md + c), sc = *(const f32x4*)(md + 1024 + c);
          f32x4 y;
#pragma unroll
          for (int j = 0; j < 4; ++j) y[j] = v[q][i][j] * rstd * gg[j] * (1.f + sc[j]) + sh[j];
          *(u32x2*)(h + (size_t)row * 1024 + c) = (u32x2){pack2(y[0], y[1]), pack2(y[2], y[3])};
          if (first) *(f32x4*)(p.out + (size_t)row * 1024 + c) = v[q][i];
        }
      }
    }
  }
}

DI void phase_final(const Params& p) {
  const int tid = tid_opaque(), wid = tid >> 6, lane = tid & 63;
  const float* gn = p.in[12];
  const int rstride = gridDim.x * 8;
  for (int row0 = bid_opaque() * 8 + wid; row0 < M_TOT; row0 += 3 * rstride) {
    f32x4 v[3][4]; float ss[3];
#pragma unroll
    for (int q = 0; q < 3; ++q) {
      const int row = row0 + q * rstride < M_TOT ? row0 + q * rstride : row0;
      const float* xs = p.out + (size_t)row * 1024;
#pragma unroll
      for (int i = 0; i < 4; ++i) v[q][i] = *(const f32x4*)(xs + lane * 4 + 256 * i);
    }
#pragma unroll
    for (int q = 0; q < 3; ++q) {
      float s = 0.f;
#pragma unroll
      for (int i = 0; i < 4; ++i) s += v[q][i][0] * v[q][i][0] + v[q][i][1] * v[q][i][1] + v[q][i][2] * v[q][i][2] + v[q][i][3] * v[q][i][3];
      ss[q] = wave_sum(s);
    }
#pragma unroll
    for (int q = 0; q < 3; ++q) {
      const int row = row0 + q * rstride;
      if (row < M_TOT) {
        const float rstd = rsqrtf(ss[q] * (1.f / 1024.f) + 1e-6f);
#pragma unroll
        for (int i = 0; i < 4; ++i) {
          const int c = lane * 4 + 256 * i;
          const f32x4 gg = *(const f32x4*)(gn + c);
          f32x4 y;
#pragma unroll
          for (int j = 0; j < 4; ++j) y[j] = v[q][i][j] * rstd * gg[j];
          *(f32x4*)(p.out + (size_t)row * 1024 + c) = y;
        }
      }
    }
  }
}

namespace pg8 {
constexpr int BM = 256, BK = 64, HALF = 128, HTB = HALF * BK * 2, STAGE_BYTES = 8 * HTB, NXCD = 8, WGM = 8;
DI int lds_byte(int r, int c) { const int st = (r >> 4) * 2 + (c >> 5), rr = r & 15, cc = c & 31, ob = rr * 64 + cc * 2; return st * 1024 + (ob ^ (((ob >> 9) & 1) << 5)); }
DI void stage_rc(int b, int& R, int& C) { const int st = b / 1024, sb = b % 1024, swz = sb ^ (((sb >> 9) & 1) << 5); R = (st >> 1) * 16 + swz / 64; C = (st & 1) * 32 + (swz % 64) / 2; }
DI int perm32(int rho) { const int n = rho >> 4, i = rho & 15; return 8 * (i >> 2) + 4 * n + (i & 3); }
struct Unit { int pm, pn; };
struct Gemm { const bf16_t* A; const bf16_t* Bt; int M, N, K; };
struct StaticOrder {
  int nM, nN, nwg, G, c;
  DI void init(int M, int N, int G_, int c_) { nM = M / BM; nN = N / BM; nwg = nM * nN; G = G_; c = c_; }
  DI bool next(int i, Unit& u) const {
    const long L = (long)i * G + c; if (L >= nwg) return false;
    int wgid = (int)L; { const int q = nwg / NXCD, r = nwg % NXCD, xcd = wgid % NXCD, off = wgid / NXCD; wgid = (xcd < r ? xcd * (q + 1) : r * (q + 1) + (xcd - r) * q) + off; }
    const int nig = WGM * nN, gid = wgid / nig, fm = gid * WGM, gsz = (nM - fm) < WGM ? (nM - fm) : WGM;
    u.pm = fm + ((wgid % nig) % gsz); u.pn = (wgid % nig) / gsz; return true;
  }
};
DI unsigned cvt_pk_bf16(float lo, float hi) { unsigned r; asm volatile("v_cvt_pk_bf16_f32 %0, %1, %2" : "=v"(r) : "v"(lo), "v"(hi)); return r; }

template <class Epi>
DI void gemm_phase(lptr lds, const Gemm g, const StaticOrder& S, const Epi& E) {
  const int tid = tid_opaque(), wid = __builtin_amdgcn_readfirstlane(tid >> 6), lane = tid & 63, wr = wid >> 2, wc = wid & 3, fr = lane & 15, fq = lane >> 4;
  const int K = g.K, nt = K / BK;
  unsigned voffA[2], voffB[2];
#pragma unroll
  for (int i = 0; i < 2; ++i) { int R, C; stage_rc(tid * 16 + i * 8192, R, C); const int Rb = Epi::PERM ? ((R & ~31) + perm32(R & 31)) : R;
    voffA[i] = (unsigned)(R * K + C) * 2u; voffB[i] = (unsigned)(Rb * K + C) * 2u; }
  const size_t kstep = (size_t)(BK * 2);
  const size_t hstep = (size_t)HALF * K * 2;
  const size_t tstep = 2 * hstep;
  const unsigned ldsw = (unsigned)wid * 1024u;
  const int aoff = lds_byte(wr * 64 + fr, fq * 8), boff = lds_byte(wc * 32 + fr, fq * 8);
#define PG8_SA(b, h) (((b) * 2 + (h)) * HTB)
#define PG8_SB(b, h) ((4 + (b) * 2 + (h)) * HTB)
#define PG8_STAGE(bufoff, gbase, voff) do { _Pragma("unroll") for (int _i = 0; _i < 2; ++_i) \
    __builtin_amdgcn_global_load_lds((const unsigned*)((const char*)(gbase) + (voff)[_i]), (LAS unsigned*)(lds + (bufoff) + ldsw + _i * 8192), 16, 0, 0); } while (0)
#define PG8_LDA(dst, b, h) do { _Pragma("unroll") for (int m = 0; m < 4; ++m) _Pragma("unroll") for (int k = 0; k < 2; ++k) dst[m][k] = *(const LAS bf16x8*)(lds + PG8_SA(b, h) + aoff + m * 2048 + k * 1024); } while (0)
#define PG8_LDB(dst, b, h) do { _Pragma("unroll") for (int n = 0; n < 2; ++n) _Pragma("unroll") for (int k = 0; k < 2; ++k) dst[n][k] = *(const LAS bf16x8*)(lds + PG8_SB(b, h) + boff + n * 2048 + k * 1024); } while (0)
#define PG8_MMA(ai, bj, At, Bt) do { __builtin_amdgcn_s_setprio(1); _Pragma("unroll") for (int m = 0; m < 4; ++m) _Pragma("unroll") for (int n = 0; n < 2; ++n) _Pragma("unroll") for (int k = 0; k < 2; ++k) \
    acc[ai][bj][m][n] = __builtin_amdgcn_mfma_f32_16x16x32_bf16(Bt[n][k], At[m][k], acc[ai][bj][m][n], 0, 0, 0); __builtin_amdgcn_s_setprio(0); } while (0)
#define PG8_WAIT_V(n) asm volatile("s_waitcnt vmcnt(" #n ")" ::: "memory")
#define PG8_WAIT_L(n) asm volatile("s_waitcnt lgkmcnt(" #n ")" ::: "memory")
#define PG8_BAR __builtin_amdgcn_s_barrier()
#define PG8_SCHED __builtin_amdgcn_sched_barrier(0)
  Unit cur, nxt; int ui = 0;
  if (!S.next(0, cur)) return;
  f32x4 acc[2][2][4][2];
#pragma unroll
  for (int a = 0; a < 2; ++a)
#pragma unroll
    for (int b = 0; b < 2; ++b)
#pragma unroll
      for (int m = 0; m < 4; ++m)
#pragma unroll
        for (int n = 0; n < 2; ++n) acc[a][b][m][n] = (f32x4){0.f, 0.f, 0.f, 0.f};
  bf16x8 At[4][2], B0[2][2], B1[2][2];
  const char* cA = (const char*)g.A + (size_t)cur.pm * tstep; const char* cB = (const char*)g.Bt + (size_t)cur.pn * tstep;
  PG8_STAGE(PG8_SB(0, 0), cB, voffB); PG8_STAGE(PG8_SA(0, 0), cA, voffA); PG8_STAGE(PG8_SB(0, 1), cB + hstep, voffB); PG8_STAGE(PG8_SA(0, 1), cA + hstep, voffA);
  if (wr == 1) PG8_BAR;
  PG8_WAIT_V(4); PG8_BAR;
  PG8_STAGE(PG8_SB(1, 0), cB + kstep, voffB); PG8_STAGE(PG8_SA(1, 0), cA + kstep, voffA); PG8_STAGE(PG8_SB(1, 1), cB + hstep + kstep, voffB);
  PG8_WAIT_V(6); PG8_BAR;
  for (;;) {
    const bool has_next = S.next(ui + 1, nxt);
    const char* nA = has_next ? (const char*)g.A + (size_t)nxt.pm * tstep : cA; const char* nB = has_next ? (const char*)g.Bt + (size_t)nxt.pn * tstep : cB;
    for (int t = 0; t < nt; t += 2) {
      const bool last = (t == nt - 2);
      const char* a1 = cA + (size_t)(t + 1) * kstep;
      const char* a2 = last ? nA : cA + (size_t)(t + 2) * kstep; const char* b2 = last ? nB : cB + (size_t)(t + 2) * kstep;
      const char* a3 = a2 + kstep; const char* b3 = b2 + kstep;
      PG8_LDB(B0, 0, 0); PG8_SCHED; PG8_LDA(At, 0, 0); PG8_STAGE(PG8_SA(1, 1), a1 + hstep, voffA);
      PG8_WAIT_L(8); PG8_BAR; PG8_WAIT_L(0); PG8_MMA(0, 0, At, B0); PG8_BAR; PG8_SCHED;
      PG8_LDB(B1, 0, 1); PG8_STAGE(PG8_SB(0, 0), b2, voffB);
      PG8_BAR; PG8_WAIT_L(0); PG8_MMA(0, 1, At, B1); PG8_BAR;
      PG8_LDA(At, 0, 1); PG8_STAGE(PG8_SA(0, 0), a2, voffA);
      PG8_BAR; PG8_WAIT_L(0); PG8_MMA(1, 0, At, B0); PG8_BAR; PG8_SCHED;
      PG8_STAGE(PG8_SB(0, 1), b2 + hstep, voffB);
      PG8_WAIT_V(6); PG8_BAR; PG8_MMA(1, 1, At, B1); PG8_BAR;
      PG8_LDB(B0, 1, 0); PG8_SCHED; PG8_LDA(At, 1, 0); PG8_STAGE(PG8_SA(0, 1), a2 + hstep, voffA);
      PG8_WAIT_L(8); PG8_BAR; PG8_WAIT_L(0); PG8_MMA(0, 0, At, B0); PG8_BAR; PG8_SCHED;
      PG8_LDB(B1, 1, 1); PG8_STAGE(PG8_SB(1, 0), b3, voffB);
      PG8_BAR; PG8_WAIT_L(0); PG8_MMA(0, 1, At, B1); PG8_BAR;
      PG8_LDA(At, 1, 1); PG8_STAGE(PG8_SA(1, 0), a3, voffA);
      PG8_BAR; PG8_WAIT_L(0); PG8_MMA(1, 0, At, B0); PG8_BAR; PG8_SCHED;
      PG8_STAGE(PG8_SB(1, 1), b3 + hstep, voffB);
      PG8_WAIT_V(6); PG8_BAR; PG8_MMA(1, 1, At, B1); PG8_BAR;
    }
    E(acc, cur, wr, wc, fr, fq);
    if (!has_next) break;
#pragma unroll
    for (int a = 0; a < 2; ++a)
#pragma unroll
      for (int b = 0; b < 2; ++b)
#pragma unroll
        for (int m = 0; m < 4; ++m)
#pragma unroll
          for (int n = 0; n < 2; ++n) acc[a][b][m][n] = (f32x4){0.f, 0.f, 0.f, 0.f};
    cur = nxt; cA = nA; cB = nB; ++ui;
  }
  PG8_WAIT_V(0);
  if (wr == 0) PG8_BAR;
  PG8_BAR;
#undef PG8_SA
#undef PG8_SB
#undef PG8_STAGE
#undef PG8_LDA
#undef PG8_LDB
#undef PG8_MMA
#undef PG8_WAIT_V
#undef PG8_WAIT_L
#undef PG8_BAR
#undef PG8_SCHED
}

struct EpiIn {
  static constexpr bool PERM = true;
  bf16_t* P; int ldp; int odd; float* kout; float* vout; float* ab; bf16_t* halo;
  DI void operator()(const f32x4 (&acc)[2][2][4][2], const Unit& u, int wr, int wc, int fr, int fq) const {
    const int row0 = u.pm * BM + wr * 64 + fr;
    if (odd && u.pn == 16) {
      if (wc == 0) {
#pragma unroll
        for (int ai = 0; ai < 2; ++ai)
#pragma unroll
          for (int m = 0; m < 4; ++m) { const int r = row0 + ai * HALF + m * 16;
#pragma unroll
            for (int n = 0; n < 2; ++n) *(f32x4*)(ab + (size_t)r * 32 + 8 * fq + 4 * n) = acc[ai][0][m][n]; }
      }
      return;
    }
    const int col0 = u.pn * BM + wc * 32 + 8 * fq;
#pragma unroll
    for (int ai = 0; ai < 2; ++ai)
#pragma unroll
      for (int m = 0; m < 4; ++m) {
        const int r = row0 + ai * HALF + m * 16; bf16_t* rowp = P + (size_t)r * ldp + col0;
#pragma unroll
        for (int bj = 0; bj < 2; ++bj) {
          const f32x4 v0 = acc[ai][bj][m][0], v1 = acc[ai][bj][m][1];
          u32x4 w; w.x = cvt_pk_bf16(v0[0], v0[1]); w.y = cvt_pk_bf16(v0[2], v0[3]); w.z = cvt_pk_bf16(v1[0], v1[1]); w.w = cvt_pk_bf16(v1[2], v1[3]);
          *(u32x4*)(rowp + bj * HALF) = w;
          if (odd) {
            const int rc = m * 16 + fr, c = col0 + bj * HALF;
            if (c < 3072 && (rc == 0 || rc >= 62)) { const int slot = rc == 0 ? 0 : rc - 61; *(u32x4*)(halo + ((size_t)(r >> 6) * 3 + slot) * 3072 + c) = w; }
          } else if (u.pn == 6 && r < M_P) {
            float* dst = (bj ? vout : kout) + ((size_t)(r >> 8) * 512 + (r & 255)) * 128 + wc * 32 + 8 * fq;
            *(f32x4*)dst = v0; *(f32x4*)(dst + 4) = v1;
          }
        }
      }
  }
};
struct EpiRes {
  static constexpr bool PERM = false;
  float* x; const float* ga_base; int rbase;
  DI void operator()(const f32x4 (&acc)[2][2][4][2], const Unit& u, int wr, int wc, int fr, int fq) const {
    const int row0 = rbase + u.pm * BM + wr * 64 + fr, col0 = u.pn * BM + wc * 32 + 4 * fq;
    const float* ga = ga_base + (size_t)row_group(rbase + u.pm * BM) * 6144;
    f32x4 gv[2][2];
#pragma unroll
    for (int bj = 0; bj < 2; ++bj)
#pragma unroll
      for (int n = 0; n < 2; ++n) gv[bj][n] = *(const f32x4*)(ga + col0 + bj * HALF + n * 16);
#pragma unroll
    for (int ai = 0; ai < 2; ++ai)
#pragma unroll
      for (int m = 0; m < 4; ++m) { float* rowp = x + (size_t)(row0 + ai * HALF + m * 16) * 1024 + col0;
#pragma unroll
        for (int bj = 0; bj < 2; ++bj)
#pragma unroll
          for (int n = 0; n < 2; ++n) { f32x4* q = (f32x4*)(rowp + bj * HALF + n * 16); *q = *q + gv[bj][n] * acc[ai][bj][m][n]; } }
  }
};
struct EpiGU {
  static constexpr bool PERM = true;
  bf16_t* act;
  DI void operator()(const f32x4 (&acc)[2][2][4][2], const Unit& u, int wr, int wc, int fr, int fq) const {
    const int row0 = u.pm * BM + wr * 64 + fr, col0 = u.pn * HALF + wc * 32 + 8 * fq;
#pragma unroll
    for (int ai = 0; ai < 2; ++ai)
#pragma unroll
      for (int m = 0; m < 4; ++m) {
        bf16_t* rowp = act + (size_t)(row0 + ai * HALF + m * 16) * DFF + col0;
        float o[8];
#pragma unroll
        for (int n = 0; n < 2; ++n)
#pragma unroll
          for (int j = 0; j < 4; ++j) { const float gt = acc[ai][0][m][n][j], up = acc[ai][1][m][n][j]; o[n * 4 + j] = siluf_(gt) * up; }
        u32x4 w; w.x = cvt_pk_bf16(o[0], o[1]); w.y = cvt_pk_bf16(o[2], o[3]); w.z = cvt_pk_bf16(o[4], o[5]); w.w = cvt_pk_bf16(o[6], o[7]);
        *(u32x4*)rowp = w;
      }
  }
};
}

template <class Epi> DI void run_gemm(lptr lds, const bf16_t* A, const bf16_t* Bt, int N, int K, const Epi& E) {
  pg8::Gemm g; g.A = A; g.Bt = Bt; g.M = M_TOT; g.N = N; g.K = K;
  pg8::StaticOrder S; S.init(M_TOT, N, (int)gridDim.x, (int)bid_opaque());
  pg8::gemm_phase<Epi>(lds, g, S, E);
}
template <class Epi> DI void run_gemm_sub(lptr lds, const bf16_t* A, const bf16_t* Bt, int mrows, int N, int K, const Epi& E, int vb, int nb) {
  pg8::Gemm g; g.A = A; g.Bt = Bt; g.M = mrows; g.N = N; g.K = K;
  pg8::StaticOrder S; S.init(mrows, N, nb, vb);
  pg8::gemm_phase<Epi>(lds, g, S, E);
}
DI void tail_panel_sync(unsigned* cnt, int mrows, int N, int vb, int nb, int& pm, int& pn) {
  pg8::StaticOrder S; S.init(mrows, N, nb, vb);
  pg8::Unit u; S.next(0, u); pm = u.pm; pn = u.pn;
  asm volatile("s_waitcnt vmcnt(0)" ::: "memory");
  __syncthreads();
  if (threadIdx.x == 0) {
    __builtin_amdgcn_fence(__ATOMIC_RELEASE, "agent");
    asm volatile("s_waitcnt vmcnt(0)" ::: "memory");
    (void)__hip_atomic_fetch_add(cnt + pm, 1u, __ATOMIC_RELAXED, __HIP_MEMORY_SCOPE_AGENT);
    unsigned sp = 0;
    while (__hip_atomic_load(cnt + pm, __ATOMIC_RELAXED, __HIP_MEMORY_SCOPE_AGENT) < 4u) { __builtin_amdgcn_s_sleep(4); if (++sp > (1u << 22)) break; }
    __builtin_amdgcn_fence(__ATOMIC_ACQUIRE, "agent");
    asm volatile("s_waitcnt vmcnt(0)" ::: "memory");
  }
  __syncthreads();
}
DI void norm_rows(const Params& p, int l, int mode, int row_lo, int row_hi, int vb, int nb) {
  const int tid = tid_opaque(), wid = tid >> 6, lane = tid & 63;
  const float* mod = (const float*)(p.ws + WS_MOD);
  bf16_t* h = (bf16_t*)(p.ws + WS_H);
  const float* gn = mode == 2 ? p.in[12] : (mode ? p.in[11] : p.in[10]) + l * 1024;
  const int rstride = nb * 8;
  for (int row0 = row_lo + vb * 8 + wid; row0 < row_hi; row0 += 6 * rstride) {
    f32x4 v[6][4]; float ss[6];
#pragma unroll
    for (int q = 0; q < 6; ++q) {
      const int row = row0 + q * rstride < row_hi ? row0 + q * rstride : row0;
      const float* xs = p.out + (size_t)row * 1024;
#pragma unroll
      for (int i = 0; i < 4; ++i) v[q][i] = *(const f32x4*)(xs + lane * 4 + 256 * i);
    }
#pragma unroll
    for (int q = 0; q < 6; ++q) {
      float s = 0.f;
#pragma unroll
      for (int i = 0; i < 4; ++i) s += v[q][i][0] * v[q][i][0] + v[q][i][1] * v[q][i][1] + v[q][i][2] * v[q][i][2] + v[q][i][3] * v[q][i][3];
      ss[q] = wave_sum(s);
    }
#pragma unroll
    for (int q = 0; q < 6; ++q) {
      const int row = row0 + q * rstride;
      if (row < row_hi) {
        const float rstd = rsqrtf(ss[q] * (1.f / 1024.f) + 1e-6f);
        const float* md = mod + ((size_t)l * 9 + row_group(row)) * 6144 + (mode ? 3072 : 0);
#pragma unroll
        for (int i = 0; i < 4; ++i) {
          const int c = lane * 4 + 256 * i;
          const f32x4 gg = *(const f32x4*)(gn + c);
          f32x4 y;
          if (mode == 2) {
#pragma unroll
            for (int j = 0; j < 4; ++j) y[j] = v[q][i][j] * rstd * gg[j];
            *(f32x4*)(p.out + (size_t)row * 1024 + c) = y;
          } else {
            const f32x4 sh = *(const f32x4*)(md + c), sc = *(const f32x4*)(md + 1024 + c);
#pragma unroll
            for (int j = 0; j < 4; ++j) y[j] = v[q][i][j] * rstd * gg[j] * (1.f + sc[j]) + sh[j];
            *(u32x2*)(h + (size_t)row * 1024 + c) = (u32x2){pack2(y[0], y[1]), pack2(y[2], y[3])};
          }
        }
      }
    }
  }
}

DI float gelu_tanh(float x) { const float u = 0.7978845608028654f * (x + 0.044715f * x * x * x); const float t = 1.f - 2.f * __builtin_amdgcn_rcpf(1.f + __expf(2.f * u)); return 0.5f * x * (1.f + t); }
DI void rg_phase(const Params& p, lptr lds, int l, int mode) {
  const int tid = tid_opaque(), wid = tid >> 6, lane = tid & 63;
  const int i2 = l >> 1, bid = bid_opaque(), G = gridDim.x;
  const int n = bid & 7;
  const bf16_t* P = (const bf16_t*)(p.ws + WS_P);
  bf16_t* Y = (bf16_t*)(p.ws + WS_H);
  float* carry = (float*)(p.ws + WS_CARRY);
  constexpr int SUB = 74752;
  LAS float* Pf = (LAS float*)(lds + 2 * SUB);
  const int ct = tid >> 3, c8 = (tid & 7) * 8, chc = n * 64 + c8;
  LAS float* cwl = (LAS float*)(lds + 2 * SUB + 8192);
  if (tid < 320) { const int j = tid >> 6, c = tid & 63; cwl[tid] = j < 4 ? p.in[14][((size_t)i2 * 4 + j) * 512 + n * 64 + c] : p.in[15][i2 * 512 + n * 64 + c]; }
  __syncthreads();
  const int gdir = wid >> 2, gdt = (wid >> 1) & 1, gt2 = wid & 1, r = lane & 31, hh = lane >> 5;
  bf16x8 wa[4], wx[4];
  {
    const bf16_t* rgw = (const bf16_t*)(p.ws + WS_RGW);
    const bf16_t* wap = rgw + ((size_t)(gdir * 2 + 0) * 8 + n) * 4096 + (gdt * 32 + r) * 64 + 8 * hh;
    const bf16_t* wxp = rgw + ((size_t)(gdir * 2 + 1) * 8 + n) * 4096 + (gdt * 32 + r) * 64 + 8 * hh;
#pragma unroll
    for (int s = 0; s < 4; ++s) { wa[s] = *(const bf16x8*)(wap + 16 * s); wx[s] = *(const bf16x8*)(wxp + 16 * s); }
  }
  const int gd = gdt * 32 + r, gpi = (i2 * 2 + gdir) * 512 + n * 64 + gd;
  const float ba = p.in[17][gpi], bx = p.in[19][gpi], sp8 = -8.f * softplusf_(-p.in[20][gpi]);
  u32x4 praw[2][4], pgr[2];
  pgr[0] = pgr[1] = (u32x4){0u, 0u, 0u, 0u};
#define RG_PREFETCH(s_, item_) do { const int tt_ = (item_) >> 3; const int row0_ = tt_ * 64; \
    const int ti_ = tt_ < 64 ? (tt_ & 3) : ((tt_ - 64) & 63); const int nt_ = tt_ < 64 ? 4 : 64; \
    _Pragma("unroll") for (int j_ = 0; j_ < 4; ++j_) { const int tl_ = ti_ * 64 + ct + j_ - 2; const bool ok_ = tl_ >= 0 && tl_ < nt_ * 64; \
      const u32x4 v_ = *(const u32x4*)(P + (size_t)(row0_ + (ok_ ? ct + j_ - 2 : ct)) * EVEN_IN + chc); praw[s_][j_] = ok_ ? v_ : (u32x4){0u, 0u, 0u, 0u}; } \
    if (mode == 1) pgr[s_] = *(const u32x4*)(P + (size_t)(row0_ + ct) * EVEN_IN + 512 + chc); } while (0)
  if (bid < 4608) RG_PREFETCH(0, bid);
  if (bid + G < 4608) RG_PREFETCH(1, bid + G);
  for (int item0 = bid; item0 < 4608; item0 += 2 * G) {
    const int nsub = item0 + G < 4608 ? 2 : 1;
    u32x4 gr_cur[2];
#pragma unroll
    for (int s = 0; s < 2; ++s) {
      if (s < nsub) {
        const int tt = (item0 + s * G) >> 3;
        const int ti = tt < 64 ? (tt & 3) : ((tt - 64) & 63), ntile = tt < 64 ? 4 : 64;
        LAS bf16_t* Xc = (LAS bf16_t*)(lds + s * SUB);
        float ca[16], cbv[16];
        if (mode == 1) {
          const int q4 = tid >> 7, dir = (tid >> 6) & 1, d = tid & 63, ch = n * 64 + d, tbase = tt - ti;
#pragma unroll
          for (int jj = 0; jj < 16; ++jj) {
            const int j = dir ? (16 * q4 + 15 - jj) : (16 * q4 + jj);
            const bool valid = dir ? (j > ti && j < ntile) : (j < ti);
            const int jc = valid ? j : ti;
            const size_t o = ((size_t)((tbase + jc) * 2 + dir) * 2) * 512 + ch;
            const float va = carry[o], vb = carry[o + 512];
            ca[jj] = valid ? va : 1.f; cbv[jj] = valid ? vb : 0.f;
          }
        }
        {
          const f32x4 b0 = *(const LAS f32x4*)(cwl + 256 + c8), b1 = *(const LAS f32x4*)(cwl + 256 + c8 + 4);
          float a[8] = {b0[0], b0[1], b0[2], b0[3], b1[0], b1[1], b1[2], b1[3]};
#pragma unroll
          for (int j = 0; j < 4; ++j) {
            const u32x4 raw = praw[s][j];
            const f32x4 w0 = *(const LAS f32x4*)(cwl + j * 64 + c8), w1 = *(const LAS f32x4*)(cwl + j * 64 + c8 + 4);
            a[0] += w0[0] * lo2f(raw.x); a[1] += w0[1] * hi2f(raw.x); a[2] += w0[2] * lo2f(raw.y); a[3] += w0[3] * hi2f(raw.y);
            a[4] += w1[0] * lo2f(raw.z); a[5] += w1[1] * hi2f(raw.z); a[6] += w1[2] * lo2f(raw.w); a[7] += w1[3] * hi2f(raw.w);
          }
          *(LAS u32x4*)(Xc + ct * 72 + c8) = (u32x4){pack2(a[0], a[1]), pack2(a[2], a[3]), pack2(a[4], a[5]), pack2(a[6], a[7])};
        }
        gr_cur[s] = pgr[s];
        if (mode == 1) {
          const int q4 = tid >> 7, dir = (tid >> 6) & 1, d = tid & 63;
          float A = 1.f, B = 0.f;
#pragma unroll
          for (int jj = 0; jj < 16; ++jj) { B = ca[jj] * B + cbv[jj]; A = ca[jj] * A; }
          Pf[s * 1024 + (q4 * 2 + dir) * 64 + d] = A; Pf[s * 1024 + 512 + (q4 * 2 + dir) * 64 + d] = B;
        }
      }
      __builtin_amdgcn_sched_barrier(0);
    }
    __syncthreads();
#pragma unroll 1
    for (int s = 0; s < 2; ++s) {
      if (s < nsub) {
        LAS bf16_t* Xc = (LAS bf16_t*)(lds + s * SUB);
        LAS float* Aa = (LAS float*)(lds + s * SUB + 9216); LAS float* Bb = (LAS float*)(lds + s * SUB + 41984);
        f32x16 ga = zero16(), gx = zero16();
#pragma unroll
        for (int ks = 0; ks < 4; ++ks) {
          const bf16x8 a = *(const LAS bf16x8*)(Xc + (gt2 * 32 + r) * 72 + 16 * ks + 8 * hh);
          ga = MFMA32(a, wa[ks], ga); gx = MFMA32(a, wx[ks], gx);
        }
#pragma unroll
        for (int ii = 0; ii < 16; ++ii) {
          const int t = gt2 * 32 + crow(ii, hh);
          const float rr = sigmoidf_(ga[ii] + ba), iv = sigmoidf_(gx[ii] + bx);
          const float la = rr * sp8, a = __expf(la), x2 = 2.f * la;
          const float om = x2 > -0.25f ? -x2 * (1.f + x2 * (0.5f + x2 * (0.16666667f + x2 * (0.041666668f + x2 * 0.0083333338f)))) : 1.f - __expf(x2);
          const float bb = __builtin_amdgcn_sqrtf(fmaxf(om, 0.f)) * (iv * bf2f(Xc[t * 72 + gd]));
          Aa[(gdir * 64 + t) * 64 + gd] = a; Bb[(gdir * 64 + t) * 64 + gd] = bb;
        }
      }
    }
    __syncthreads();
    if (item0 + 2 * G < 4608) RG_PREFETCH(0, item0 + 2 * G);
    if (item0 + 3 * G < 4608) RG_PREFETCH(1, item0 + 3 * G);
    if (tid < 128 * nsub) {
      const int s = tid >> 7, dir = (tid >> 6) & 1, d = tid & 63, ch = n * 64 + d;
      const int tt = (item0 + s * G) >> 3;
      const int ti = tt < 64 ? (tt & 3) : ((tt - 64) & 63), ntile = tt < 64 ? 4 : 64;
      const int seq = tt < 64 ? (tt >> 2) : 16 + ((tt - 64) >> 6);
      LAS float* Aa = (LAS float*)(lds + s * SUB + 9216); LAS float* Bb = (LAS float*)(lds + s * SUB + 41984);
      if (mode == 0) {
        float A = 1.f, B = 0.f;
#pragma unroll 8
        for (int st = 0; st < 64; ++st) { const int t = dir ? 63 - st : st; const float a = Aa[(dir * 64 + t) * 64 + d], b = Bb[(dir * 64 + t) * 64 + d]; A *= a; B = a * B + b; }
        carry[((size_t)(tt * 2 + dir) * 2 + 0) * 512 + ch] = A; carry[((size_t)(tt * 2 + dir) * 2 + 1) * 512 + ch] = B;
      } else {
        float h = (tt < 64) ? 0.f : p.in[5][(((size_t)(seq - 16) * 2 + i2) * 2 + dir) * 512 + ch];
#pragma unroll
        for (int qq = 0; qq < 4; ++qq) { const int q4 = dir ? 3 - qq : qq; h = Pf[s * 1024 + (q4 * 2 + dir) * 64 + d] * h + Pf[s * 1024 + 512 + (q4 * 2 + dir) * 64 + d]; }
#pragma unroll 8
        for (int st = 0; st < 64; ++st) { const int t = dir ? 63 - st : st; h = Aa[(dir * 64 + t) * 64 + d] * h + Bb[(dir * 64 + t) * 64 + d]; Aa[(dir * 64 + t) * 64 + d] = h; }
        if (tt < 64 && ((dir == 0 && ti == ntile - 1) || (dir == 1 && ti == 0))) p.out[OFF_RG + (((size_t)seq * 2 + i2) * 2 + dir) * 512 + ch] = h;
      }
    }
    if (mode == 1) {
      __syncthreads();
#pragma unroll
      for (int s = 0; s < 2; ++s) {
        if (s < nsub) {
          const int row0 = ((item0 + s * G) >> 3) * 64;
          const LAS float* Hf = (const LAS float*)(lds + s * SUB + 9216); const LAS float* Hb = Hf + 4096;
          const u32x4 raw = gr_cur[s];
          float gr[8] = {lo2f(raw.x), hi2f(raw.x), lo2f(raw.y), hi2f(raw.y), lo2f(raw.z), hi2f(raw.z), lo2f(raw.w), hi2f(raw.w)};
          float y[8];
#pragma unroll
          for (int e = 0; e < 8; ++e) y[e] = (Hf[ct * 64 + c8 + e] + Hb[ct * 64 + c8 + e]) * gelu_tanh(gr[e]);
          *(u32x4*)(Y + (size_t)(row0 + ct) * 1024 + n * 64 + c8) = (u32x4){pack2(y[0], y[1]), pack2(y[2], y[3]), pack2(y[4], y[5]), pack2(y[6], y[7])};
        }
      }
    }
    __syncthreads();
  }
#undef RG_PREFETCH
}

DI void att_item(const Params& p, lptr lds, int l, int item) {
  const int tid = tid_opaque(), wid = tid >> 6, lane = tid & 63, q = lane & 31, hh = lane >> 5;
  const int i2 = l >> 1;
  const bool samp = item < 1024;
  int b, kvh, qt, rowbase;
  if (samp) { b = item >> 7; kvh = (item >> 6) & 1; qt = item & 63; rowbase = M_P + b * 4096; }
  else { const int j = item - 1024; b = j >> 3; kvh = (j >> 2) & 1; qt = j & 3; rowbase = b * 256; }
  const bf16_t* P = (const bf16_t*)(p.ws + WS_P);
  bf16_t* Y = (bf16_t*)(p.ws + WS_H);
  const float* rc = (const float*)(p.ws + WS_ROPE); const float* rs = rc + 4096 * 32;
  LAS bf16_t* Ks = (LAS bf16_t*)lds; LAS bf16_t* Vt = (LAS bf16_t*)(lds + 9216);
  const int head = kvh * 4 + (wid >> 1);
  const int qpos = qt * 64 + 32 * (wid & 1) + q;
  bf16x8 Qf[4];
  {
    const bf16_t* qp = P + (size_t)(rowbase + qpos) * EVEN_IN + 1024 + head * 64 + 8 * hh;
    float qv[4][8];
#pragma unroll
    for (int s = 0; s < 4; ++s) { const u32x4 raw = *(const u32x4*)(qp + 16 * s);
      qv[s][0] = lo2f(raw.x); qv[s][1] = hi2f(raw.x); qv[s][2] = lo2f(raw.y); qv[s][3] = hi2f(raw.y); qv[s][4] = lo2f(raw.z); qv[s][5] = hi2f(raw.z); qv[s][6] = lo2f(raw.w); qv[s][7] = hi2f(raw.w); }
    if (samp) {
#pragma unroll
      for (int pr = 0; pr < 2; ++pr)
#pragma unroll
        for (int j = 0; j < 8; ++j) { const int f = 16 * pr + 8 * hh + j; const float c = rc[qpos * 32 + f], sn = rs[qpos * 32 + f];
          const float x1 = qv[2 * pr][j], x2 = qv[2 * pr + 1][j]; qv[2 * pr][j] = x1 * c - x2 * sn; qv[2 * pr + 1][j] = x1 * sn + x2 * c; }
    }
#pragma unroll
    for (int s = 0; s < 4; ++s) { const float qs = 0.125f * 1.44269504088896341f;
      u32x4 w; w.x = pack2(qv[s][0] * qs, qv[s][1] * qs); w.y = pack2(qv[s][2] * qs, qv[s][3] * qs); w.z = pack2(qv[s][4] * qs, qv[s][5] * qs); w.w = pack2(qv[s][6] * qs, qv[s][7] * qs); Qf[s] = __builtin_bit_cast(bf16x8, w); }
  }
  float m_run = p.in[21][i2 * 8 + head] * 1.44269504088896341f, l_run = hh == 0 ? 1.f : 0.f;
  f32x16 o0 = zero16(), o1 = zero16();
  const int nctx = samp ? 8 : 0;
  int w0, w1; if (samp) { w0 = qt - 2 < 0 ? 0 : qt - 2; w1 = qt + 2 > 63 ? 63 : qt + 2; } else { w0 = 0; w1 = 3; }
  const int ntiles = nctx + (w1 - w0 + 1);
  const bool isK = tid < 256;
  const int skey = (tid & 255) >> 2, spc = tid & 3;
  const int sd0 = isK ? (spc & 1) * 8 + (spc >> 1) * 32 : spc * 16;
  const int so1 = isK ? 16 : 8;
  f32x4 pc4[4]; u32x4 pw2[2]; f32x4 prc[4];
#define ATT_PREFETCH(kt_) do { const bool ctx_ = (kt_) < nctx; const int wt_ = w0 + ((kt_) - nctx); \
    if (ctx_) { const float* sp_ = (isK ? p.in[3] : p.in[4]) + (((size_t)(b * 2 + i2) * 512 + (kt_) * 64 + skey) * 2 + kvh) * 64 + sd0; \
      pc4[0] = *(const f32x4*)sp_; pc4[1] = *(const f32x4*)(sp_ + 4); pc4[2] = *(const f32x4*)(sp_ + so1); pc4[3] = *(const f32x4*)(sp_ + so1 + 4); } \
    else { const bf16_t* sp_ = P + (size_t)(rowbase + wt_ * 64 + skey) * EVEN_IN + (isK ? 1536 : 1664) + kvh * 64 + sd0; \
      pw2[0] = *(const u32x4*)sp_; pw2[1] = *(const u32x4*)(sp_ + so1); \
      if (samp && isK) { const int kpos_ = wt_ * 64 + skey, fb_ = (sd0 & 8) + (sd0 >= 32 ? 16 : 0); \
        prc[0] = *(const f32x4*)(rc + kpos_ * 32 + fb_); prc[1] = *(const f32x4*)(rc + kpos_ * 32 + fb_ + 4); \
        prc[2] = *(const f32x4*)(rs + kpos_ * 32 + fb_); prc[3] = *(const f32x4*)(rs + kpos_ * 32 + fb_ + 4); } } } while (0)
  ATT_PREFETCH(0);
  for (int kt = 0; kt < ntiles; ++kt) {
    const bool ctx = kt < nctx; const int wt = w0 + (kt - nctx);
    __syncthreads();
    {
      float x1[8], x2[8];
      if (ctx) {
#pragma unroll
        for (int e = 0; e < 4; ++e) { x1[e] = pc4[0][e]; x1[4 + e] = pc4[1][e]; x2[e] = pc4[2][e]; x2[4 + e] = pc4[3][e]; }
      } else {
        const u32x4 r1 = pw2[0], r2 = pw2[1];
        x1[0] = lo2f(r1.x); x1[1] = hi2f(r1.x); x1[2] = lo2f(r1.y); x1[3] = hi2f(r1.y); x1[4] = lo2f(r1.z); x1[5] = hi2f(r1.z); x1[6] = lo2f(r1.w); x1[7] = hi2f(r1.w);
        x2[0] = lo2f(r2.x); x2[1] = hi2f(r2.x); x2[2] = lo2f(r2.y); x2[3] = hi2f(r2.y); x2[4] = lo2f(r2.z); x2[5] = hi2f(r2.z); x2[6] = lo2f(r2.w); x2[7] = hi2f(r2.w);
        if (samp && isK) {
#pragma unroll
          for (int j = 0; j < 8; ++j) { const float c = prc[j >> 2][j & 3], sn = prc[2 + (j >> 2)][j & 3]; const float a = x1[j], bb = x2[j]; x1[j] = a * c - bb * sn; x2[j] = a * sn + bb * c; }
        }
      }
      if (isK) {
        *(LAS u32x4*)(Ks + skey * 72 + sd0) = (u32x4){pack2(x1[0], x1[1]), pack2(x1[2], x1[3]), pack2(x1[4], x1[5]), pack2(x1[6], x1[7])};
        *(LAS u32x4*)(Ks + skey * 72 + sd0 + 16) = (u32x4){pack2(x2[0], x2[1]), pack2(x2[2], x2[3]), pack2(x2[4], x2[5]), pack2(x2[6], x2[7])};
      } else {
#pragma unroll
        for (int e = 0; e < 8; ++e) { Vt[(sd0 + e) * 72 + skey] = f2bf(x1[e]); Vt[(sd0 + 8 + e) * 72 + skey] = f2bf(x2[e]); }
      }
    }
    __syncthreads();
    if (kt + 1 < ntiles) ATT_PREFETCH(kt + 1);
#pragma unroll
    for (int ks = 0; ks < 2; ++ks) {
      f32x16 sacc = zero16();
#pragma unroll
      for (int s = 0; s < 4; ++s) { const bf16x8 a = *(const LAS bf16x8*)(Ks + (32 * ks + q) * 72 + 16 * s + 8 * hh); sacc = MFMA32(a, Qf[s], sacc); }
      if (!ctx && samp) {
        const int kbase = wt * 64 + 32 * ks;
#pragma unroll
        for (int ii = 0; ii < 16; ++ii) { const int dl = qpos - (kbase + crow(ii, hh)); if (dl > 128 || dl < -128) sacc[ii] = -1e30f; }
      }
      float mx = sacc[0];
#pragma unroll
      for (int ii = 1; ii < 16; ++ii) mx = fmaxf(mx, sacc[ii]);
      mx = fmaxf(mx, __shfl_xor(mx, 32));
      if (__any(mx > m_run)) {
        const float m_new = fmaxf(m_run, mx), alpha = __builtin_amdgcn_exp2f(m_run - m_new); m_run = m_new;
        l_run *= alpha;
#pragma unroll
        for (int ii = 0; ii < 16; ++ii) { o0[ii] *= alpha; o1[ii] *= alpha; }
      }
      float pv[16], ps = 0.f;
#pragma unroll
      for (int ii = 0; ii < 16; ++ii) { pv[ii] = __builtin_amdgcn_exp2f(sacc[ii] - m_run); ps += pv[ii]; }
      l_run += ps;
#pragma unroll
      for (int s2 = 0; s2 < 2; ++s2) {
        u32x4 pw; pw.x = pack2(pv[8 * s2], pv[8 * s2 + 1]); pw.y = pack2(pv[8 * s2 + 2], pv[8 * s2 + 3]); pw.z = pack2(pv[8 * s2 + 4], pv[8 * s2 + 5]); pw.w = pack2(pv[8 * s2 + 6], pv[8 * s2 + 7]);
        const bf16x8 bfrag = __builtin_bit_cast(bf16x8, pw);
        {
          const LAS bf16_t* vp = Vt + q * 72 + 32 * ks + 16 * s2 + 4 * hh;
          const u32x2 lo = *(const LAS u32x2*)vp, hi = *(const LAS u32x2*)(vp + 8);
          o0 = MFMA32(__builtin_bit_cast(bf16x8, ((u32x4){lo.x, lo.y, hi.x, hi.y})), bfrag, o0);
        }
        {
          const LAS bf16_t* vp = Vt + (32 + q) * 72 + 32 * ks + 16 * s2 + 4 * hh;
          const u32x2 lo = *(const LAS u32x2*)vp, hi = *(const LAS u32x2*)(vp + 8);
          o1 = MFMA32(__builtin_bit_cast(bf16x8, ((u32x4){lo.x, lo.y, hi.x, hi.y})), bfrag, o1);
        }
      }
    }
  }
#undef ATT_PREFETCH
  const float inv = 1.f / (l_run + __shfl_xor(l_run, 32));
  bf16_t* yp = Y + (size_t)(rowbase + qpos) * 1024 + 512 + head * 64;
#pragma unroll
  for (int g = 0; g < 4; ++g) {
    *(u32x2*)(yp + 8 * g + 4 * hh) = (u32x2){pack2(o0[4 * g] * inv, o0[4 * g + 1] * inv), pack2(o0[4 * g + 2] * inv, o0[4 * g + 3] * inv)};
    *(u32x2*)(yp + 32 + 8 * g + 4 * hh) = (u32x2){pack2(o1[4 * g] * inv, o1[4 * g + 1] * inv), pack2(o1[4 * g + 2] * inv, o1[4 * g + 3] * inv)};
  }
  __syncthreads();
}

DI float wave_incl_scan(float v, int lane) {
#pragma unroll
  for (int o = 1; o < 64; o <<= 1) { const float t = __shfl_up(v, o); if (lane >= o) v += t; }
  return v;
}
DI void dn1_phase(const Params& p, lptr lds, int l) {
  const int tid = tid_opaque(), wid = tid >> 6, lane = tid & 63;
  const int i2 = l >> 1, bid = bid_opaque(), G = gridDim.x, hd = bid & 7;
  bf16_t* P = (bf16_t*)(p.ws + WS_P);
  const bf16_t* halo = (const bf16_t*)(p.ws + WS_HALO);
  const float* ab = (const float*)(p.ws + WS_AB);
  LAS bf16_t* Raw = (LAS bf16_t*)lds;
  LAS float* X = (LAS float*)lds;
  LAS bf16_t* Kn = (LAS bf16_t*)(lds + 51456);
  LAS float* KK = (LAS float*)(lds + 68864);
  LAS float* Lm = (LAS float*)(lds + 85248);
  LAS float* gcs = (LAS float*)(lds + 118016);
  LAS float* bts = (LAS float*)(lds + 118528);
  const float alog0 = -__expf(p.in[25][(i2 * 2 + (wid & 1)) * 8 + hd]), dtb0 = p.in[26][(i2 * 2 + (wid & 1)) * 8 + hd];
  LAS float* cwl = (LAS float*)(lds + 131072);
  for (int e = tid; e < 1536; e += 512) { const int part = e >> 9, j = (e >> 7) & 3, c = e & 127; cwl[e] = p.in[24][((size_t)i2 * 4 + j) * 3072 + part * 1024 + hd * 128 + c]; }
  __syncthreads();
  u32x4 rv[7]; float pa0 = 0.f, pa1 = 0.f;
#define DN1_PREFETCH(item_) do { const int ck_ = (item_) >> 3; const int row0_ = ck_ * 64; \
    const int ci_ = ck_ < 64 ? (ck_ & 3) : ((ck_ - 64) & 63); const int nch_ = ck_ < 64 ? 4 : 64; \
    _Pragma("unroll") for (int k_ = 0; k_ < 7; ++k_) { \
      int e_ = tid + 512 * k_; if (e_ > 3215) e_ = 3215; \
      const int part_ = e_ / 1072, rem_ = e_ % 1072, rr_ = rem_ >> 4, pc_ = rem_ & 15, col_ = part_ * 1024 + hd * 128 + pc_ * 8; \
      const bool mid_ = rr_ >= 2 && rr_ < 66; \
      const bool zero_ = (rr_ < 2 && ci_ == 0) || (rr_ >= 66 && ci_ == nch_ - 1); \
      const bf16_t* srcp_ = mid_ ? P + (size_t)(row0_ + rr_ - 2) * ODD_LD + col_ \
                               : (rr_ < 2 ? halo + ((size_t)(ck_ - 1) * 3 + 1 + rr_) * 3072 + col_ : halo + ((size_t)(ck_ + 1) * 3) * 3072 + col_); \
      if (zero_) srcp_ = P + (size_t)row0_ * ODD_LD + col_; \
      u32x4 v_ = *(const u32x4*)srcp_; \
      if (zero_) v_ = (u32x4){0u, 0u, 0u, 0u}; \
      rv[k_] = v_; } \
    if (wid < 2) { const int t_ = wid ? 63 - lane : lane; pa0 = ab[(size_t)(row0_ + t_) * 32 + wid * 8 + hd]; pa1 = ab[(size_t)(row0_ + t_) * 32 + 16 + wid * 8 + hd]; } } while (0)
  if (bid < 4608) DN1_PREFETCH(bid);
  for (int item = bid; item < 4608; item += G) {
  const int ck = item >> 3;
  const int row0 = ck * 64;
  {
#pragma unroll
    for (int k = 0; k < 7; ++k) {
      int e = tid + 512 * k; if (e > 3215) e = 3215;
      const int part = e / 1072, rem = e % 1072, rr = rem >> 4, pc = rem & 15;
      *(LAS u32x4*)(Raw + (part * 67 + rr) * 128 + pc * 8) = rv[k];
    }
  }
  const float a0 = pa0, a1 = pa1;
  __syncthreads();
  if (item + G < 4608) DN1_PREFETCH(item + G);
#pragma unroll 2
  for (int tk = 0; tk < 6; ++tk) {
    const int task = tid + 512 * tk;
    const int c8i = task & 15, rp = task >> 4, part = tk >> 1, t = rp & 63, col = part * 1024 + hd * 128 + c8i * 8;
    float y[8];
#pragma unroll
    for (int e = 0; e < 8; ++e) y[e] = 0.f;
#pragma unroll
    for (int j = 0; j < 4; ++j) {
      const u32x4 raw = *(const LAS u32x4*)(Raw + (part * 67 + t + j) * 128 + c8i * 8);
      const f32x4 cw0 = *(const LAS f32x4*)(cwl + (part * 4 + j) * 128 + c8i * 8), cw1 = *(const LAS f32x4*)(cwl + (part * 4 + j) * 128 + c8i * 8 + 4);
      y[0] += cw0[0] * lo2f(raw.x); y[1] += cw0[1] * hi2f(raw.x); y[2] += cw0[2] * lo2f(raw.y); y[3] += cw0[3] * hi2f(raw.y);
      y[4] += cw1[0] * lo2f(raw.z); y[5] += cw1[1] * hi2f(raw.z); y[6] += cw1[2] * lo2f(raw.w); y[7] += cw1[3] * hi2f(raw.w);
    }
    float ss = 0.f;
#pragma unroll
    for (int e = 0; e < 8; ++e) { y[e] = siluf_(y[e]); ss += y[e] * y[e]; }
    if (part < 2) {
      ss += __shfl_xor(ss, 1); ss += __shfl_xor(ss, 2); ss += __shfl_xor(ss, 4); ss += __shfl_xor(ss, 8);
      const float sc = rsqrtf(ss + 1e-6f) * (part == 0 ? 0.08838834764831845f : 1.f);
#pragma unroll
      for (int e = 0; e < 8; ++e) y[e] *= sc;
    }
    const u32x4 w = (u32x4){pack2(y[0], y[1]), pack2(y[2], y[3]), pack2(y[4], y[5]), pack2(y[6], y[7])};
    *(u32x4*)(P + (size_t)(row0 + t) * ODD_LD + col) = w;
    if (part == 1) *(LAS u32x4*)(Kn + t * 136 + c8i * 8) = w;
  }
  if (wid < 2) {
    const int dir = wid;
    const float g = alog0 * softplusf_(a0 + dtb0);
    const float gcv = wave_incl_scan(g, lane), btv = sigmoidf_(a1);
    gcs[dir * 64 + lane] = gcv; bts[dir * 64 + lane] = btv;
    float* gcb = (float*)(p.ws + WS_CARRY) + ((size_t)(ck * 8 + hd) * 2 + dir) * 128;
    gcb[lane] = gcv; gcb[64 + lane] = btv;
  }
  __syncthreads();
  if (wid < 4) {
    const int it = wid >> 1, jt = wid & 1, hh = lane >> 5;
    const f32x16 acc = mm32(Kn + it * 32 * 136, 136, Kn + jt * 32 * 136, 136, 128, zero16(), lane);
#pragma unroll
    for (int ii = 0; ii < 16; ++ii) KK[(it * 32 + crow(ii, hh)) * 64 + jt * 32 + (lane & 31)] = acc[ii];
  }
  __syncthreads();
  for (int e = tid; e < 8192; e += 512) {
    const int dir = e >> 12, ip = (e >> 6) & 63, jp = e & 63;
    const int ti = dir ? 63 - ip : ip, tj = dir ? 63 - jp : jp;
    const float w = bts[dir * 64 + ip] * KK[ti * 64 + tj] * __expf(fminf(gcs[dir * 64 + ip] - gcs[dir * 64 + jp], 0.f));
    Lm[e] = (ip > jp) ? w : 0.f;
  }
  __syncthreads();
  for (int e = tid; e < 8192; e += 512) X[e] = 0.f;
  __syncthreads();
  {
    const int d = wid >> 2, bi = wid & 3;
    if (lane < 16) {
      const int c = lane; float x[16];
      const LAS float* L = Lm + d * 4096 + (16 * bi) * 64 + 16 * bi;
#pragma unroll
      for (int i = 0; i < 16; ++i) {
        float s = (c == i) ? 1.f : 0.f;
#pragma unroll
        for (int j = 0; j < i; ++j) s -= L[i * 64 + j] * x[j];
        x[i] = s;
      }
#pragma unroll
      for (int i = 0; i < 16; ++i) X[d * 4096 + (16 * bi + i) * 64 + 16 * bi + c] = x[i];
    }
  }
  __syncthreads();
  LAS float* Tm = (LAS float*)(lds + 119040) + wid * 256;
  for (int dd = 1; dd < 4; ++dd) {
    const int nb = 4 - dd; const bool act = wid < 2 * nb;
    const int d = act ? wid / nb : 0, bi = act ? dd + wid % nb : dd, bj = bi - dd;
    const int lr = lane & 15, lq = lane >> 4;
    if (act) {
      f32x4 acc = (f32x4){0.f, 0.f, 0.f, 0.f};
      for (int kb = bj; kb < bi; ++kb) {
#pragma unroll
        for (int kk = 0; kk < 4; ++kk) {
          const float a = Lm[d * 4096 + (16 * bi + lr) * 64 + 16 * kb + 4 * kk + lq];
          const float b = X[d * 4096 + (16 * kb + 4 * kk + lq) * 64 + 16 * bj + lr];
          acc = __builtin_amdgcn_mfma_f32_16x16x4f32(a, b, acc, 0, 0, 0);
        }
      }
#pragma unroll
      for (int rg = 0; rg < 4; ++rg) Tm[(lq * 4 + rg) * 16 + lr] = acc[rg];
    }
    __syncthreads();
    if (act) {
      f32x4 acc = (f32x4){0.f, 0.f, 0.f, 0.f};
#pragma unroll
      for (int kk = 0; kk < 4; ++kk) {
        const float a = X[d * 4096 + (16 * bi + lr) * 64 + 16 * bi + 4 * kk + lq];
        const float b = Tm[(4 * kk + lq) * 16 + lr];
        acc = __builtin_amdgcn_mfma_f32_16x16x4f32(a, b, acc, 0, 0, 0);
      }
#pragma unroll
      for (int rg = 0; rg < 4; ++rg) X[d * 4096 + (16 * bi + lq * 4 + rg) * 64 + 16 * bj + lr] = -acc[rg];
    }
    __syncthreads();
  }
  {
    bf16_t* Tg = (bf16_t*)(p.ws + WS_T) + ((size_t)(ck * 8 + hd) * 2) * 4096;
    for (int e = tid; e < 4096; e += 512) *(unsigned*)(Tg + 2 * e) = pack2(X[2 * e], X[2 * e + 1]);
  }
  __syncthreads();
  }
#undef DN1_PREFETCH
}

constexpr int DN2_DIR_BYTES = 80896;
DI void dn2_item(const Params& p, lptr lds, int l, int item) {
  const int tid = tid_opaque(), wid = tid >> 6, lane = tid & 63, r = lane & 31, hh = lane >> 5;
  const int i2 = l >> 1;
  const bool samp = item < 256;
  int b, hd, slab, nch, seqrow, ckb;
  if (samp) { b = item >> 5; hd = (item >> 2) & 7; slab = item & 3; nch = 64; seqrow = M_P + b * 4096; ckb = 64 + b * 64; }
  else { const int j = item - 256; b = j >> 5; hd = (j >> 2) & 7; slab = j & 3; nch = 4; seqrow = b * 256; ckb = b * 4; }
  const int dir = wid >> 2, w4 = wid & 3, td = tid & 255;
  const bf16_t* P = (const bf16_t*)(p.ws + WS_P);
  const bf16_t* Tg = (const bf16_t*)(p.ws + WS_T);
  const float* gcbase = (const float*)(p.ws + WS_CARRY);
  bf16_t* O = (bf16_t*)(p.ws + WS_H);
  lptr base = lds + dir * DN2_DIR_BYTES;
  LAS bf16_t* Qn = (LAS bf16_t*)base;
  LAS bf16_t* Kn = (LAS bf16_t*)(base + 17408);
  LAS bf16_t* Tm = (LAS bf16_t*)(base + 34816);
  LAS bf16_t* QK = (LAS bf16_t*)(base + 44032);
  LAS bf16_t* St = (LAS bf16_t*)(base + 53248);
  LAS bf16_t* Rt = (LAS bf16_t*)(base + 61952);
  LAS bf16_t* Vt = (LAS bf16_t*)(base + 66560);
  LAS bf16_t* Vn = (LAS bf16_t*)(base + 71168);
  LAS bf16_t* Vd = (LAS bf16_t*)(base + 75776);
  LAS float* gcs = (LAS float*)(base + 80384);
  LAS float* bts = gcs + 64;
  LAS float* egs = (LAS float*)(lds + 2 * DN2_DIR_BYTES) + dir * 128;
  LAS float* dds = egs + 64;
  f32x16 S;
  const size_t sidx = ((((size_t)(b * 2 + i2) * 2 + dir) * 8 + hd) * 128 + 32 * w4) * 128 + slab * 32 + r;
#pragma unroll
  for (int ii = 0; ii < 16; ++ii) S[ii] = samp ? p.in[6][sidx + (size_t)crow(ii, hh) * 128] : 0.f;
#pragma unroll
  for (int g = 0; g < 4; ++g) *(LAS u32x2*)(St + r * 136 + 32 * w4 + 8 * g + 4 * hh) = (u32x2){pack2(S[4 * g], S[4 * g + 1]), pack2(S[4 * g + 2], S[4 * g + 3])};
  u32x4 pq[4], pk[4], pt[2], pv; float pa0 = 0.f, pa1 = 0.f;
#define DN2_PREFETCH(sn) do { const int cn_ = dir ? nch - 1 - (sn) : (sn); const size_t r0_ = (size_t)seqrow + (size_t)cn_ * 64; \
    _Pragma("unroll") for (int k_ = 0; k_ < 4; ++k_) { const int e_ = td + 256 * k_, ip_ = e_ >> 4, pc_ = e_ & 15; const size_t rg_ = r0_ + (dir ? 63 - ip_ : ip_); \
      pq[k_] = *(const u32x4*)(P + rg_ * ODD_LD + hd * 128 + pc_ * 8); pk[k_] = *(const u32x4*)(P + rg_ * ODD_LD + 1024 + hd * 128 + pc_ * 8); } \
    _Pragma("unroll") for (int k_ = 0; k_ < 2; ++k_) { const int e_ = td + 256 * k_; pt[k_] = *(const u32x4*)(Tg + ((size_t)((ckb + cn_) * 8 + hd) * 2 + dir) * 4096 + e_ * 8); } \
    { const int ip_ = td >> 2, pc_ = td & 3; const size_t rg_ = r0_ + (dir ? 63 - ip_ : ip_); pv = *(const u32x4*)(P + rg_ * ODD_LD + 2048 + hd * 128 + slab * 32 + pc_ * 8); } \
    if (w4 == 0) { const float* gcb_ = gcbase + ((size_t)((ckb + cn_) * 8 + hd) * 2 + dir) * 128; pa0 = gcb_[lane]; pa1 = gcb_[64 + lane]; } } while (0)
  DN2_PREFETCH(0);
  f32x16 o1 = zero16();
  for (int s = 0; s < nch; ++s) {
    const int c = dir ? nch - 1 - s : s;
    const int row0c = seqrow + c * 64;
#pragma unroll
    for (int k = 0; k < 4; ++k) { const int e = td + 256 * k, ip = e >> 4, pc = e & 15; *(LAS u32x4*)(Qn + ip * 136 + pc * 8) = pq[k]; *(LAS u32x4*)(Kn + ip * 136 + pc * 8) = pk[k]; }
#pragma unroll
    for (int k = 0; k < 2; ++k) { const int e = td + 256 * k; *(LAS u32x4*)(Tm + (e >> 3) * 72 + (e & 7) * 8) = pt[k]; }
    { const int ip = td >> 2, pc = td & 3;
      Vt[(pc * 8 + 0) * 72 + ip] = (bf16_t)(pv.x & 0xffffu); Vt[(pc * 8 + 1) * 72 + ip] = (bf16_t)(pv.x >> 16);
      Vt[(pc * 8 + 2) * 72 + ip] = (bf16_t)(pv.y & 0xffffu); Vt[(pc * 8 + 3) * 72 + ip] = (bf16_t)(pv.y >> 16);
      Vt[(pc * 8 + 4) * 72 + ip] = (bf16_t)(pv.z & 0xffffu); Vt[(pc * 8 + 5) * 72 + ip] = (bf16_t)(pv.z >> 16);
      Vt[(pc * 8 + 6) * 72 + ip] = (bf16_t)(pv.w & 0xffffu); Vt[(pc * 8 + 7) * 72 + ip] = (bf16_t)(pv.w >> 16); }
    if (w4 == 0) { gcs[lane] = pa0; bts[lane] = pa1; egs[lane] = __expf(pa0); dds[lane] = __expf(__shfl(pa0, 63) - pa0); }
    __syncthreads();
    if (s + 1 < nch) DN2_PREFETCH(s + 1);
    bf16_t* const orow = O + (size_t)(row0c + (dir ? 63 - (td >> 2) : (td >> 2))) * 1024 + hd * 128 + slab * 32 + (td & 3) * 8;
    u32x4 po = (u32x4){0u, 0u, 0u, 0u};
    if (2 * s >= nch) po = *(const u32x4*)orow;
    {
      const int jt = w4 >> 1, it = w4 & 1;
      const LAS bf16_t* a2 = w4 < 2 ? Qn + w4 * 32 * 136 : Kn + (w4 - 2) * 32 * 136;
      f32x16 acc = zero16(), acc2 = zero16();
      {
        const LAS bf16_t* ap = Kn + jt * 32 * 136 + r * 136 + 8 * hh; const LAS bf16_t* bp = Qn + it * 32 * 136 + r * 136 + 8 * hh;
        const LAS bf16_t* cp = a2 + r * 136 + 8 * hh; const LAS bf16_t* dp = St + r * 136 + 8 * hh;
#pragma unroll 4
        for (int k0 = 0; k0 < 128; k0 += 16) {
          const bf16x8 fa = *(const LAS bf16x8*)(ap + k0), fb = *(const LAS bf16x8*)(bp + k0), fc = *(const LAS bf16x8*)(cp + k0), fd = *(const LAS bf16x8*)(dp + k0);
          acc = MFMA32(fa, fb, acc); acc2 = MFMA32(fc, fd, acc2);
        }
      }
      const int i = it * 32 + r; const float gi = gcs[i];
#pragma unroll
      for (int g = 0; g < 4; ++g) {
        const int j0 = jt * 32 + 8 * g + 4 * hh; float v[4];
        const f32x4 gj = *(const LAS f32x4*)(gcs + j0);
#pragma unroll
        for (int e = 0; e < 4; ++e) { const float w = acc[4 * g + e] * __expf(fminf(gi - gj[e], 0.f)); v[e] = (i >= j0 + e) ? w : 0.f; }
        *(LAS u32x2*)(QK + i * 72 + j0) = (u32x2){pack2(v[0], v[1]), pack2(v[2], v[3])};
      }
      if (w4 < 2) {
        o1 = acc2;
      } else {
        const int jt2 = w4 - 2;
#pragma unroll
        for (int g = 0; g < 4; ++g) {
          const int j0 = jt2 * 32 + 8 * g + 4 * hh;
          const u32x2 vv = *(const LAS u32x2*)(Vt + r * 72 + j0);
          const float ve[4] = {lo2f(vv.x), hi2f(vv.x), lo2f(vv.y), hi2f(vv.y)}; float rv[4];
          const f32x4 gj4 = *(const LAS f32x4*)(egs + j0), bj4 = *(const LAS f32x4*)(bts + j0);
#pragma unroll
          for (int e = 0; e < 4; ++e) rv[e] = bj4[e] * (ve[e] - gj4[e] * acc2[4 * g + e]);
          *(LAS u32x2*)(Rt + r * 72 + j0) = (u32x2){pack2(rv[0], rv[1]), pack2(rv[2], rv[3])};
        }
      }
    }
    __syncthreads();
    if (w4 >= 2) {
      const int it = w4 - 2;
      const f32x16 acc = mm32(Tm + it * 32 * 72, 72, Rt, 72, 64, zero16(), lane);
      const float gl = gcs[63];
#pragma unroll
      for (int g = 0; g < 4; ++g) {
        const int i0 = it * 32 + 8 * g + 4 * hh; float dv[4];
        const f32x4 gi4 = *(const LAS f32x4*)(dds + i0);
#pragma unroll
        for (int e = 0; e < 4; ++e) dv[e] = acc[4 * g + e] * gi4[e];
        *(LAS u32x2*)(Vn + r * 72 + i0) = (u32x2){pack2(acc[4 * g], acc[4 * g + 1]), pack2(acc[4 * g + 2], acc[4 * g + 3])};
        *(LAS u32x2*)(Vd + r * 72 + i0) = (u32x2){pack2(dv[0], dv[1]), pack2(dv[2], dv[3])};
      }
    }
    __syncthreads();
    if (w4 < 2) {
      const int it = w4;
#pragma unroll
      for (int g = 0; g < 4; ++g) { const f32x4 gi4 = *(const LAS f32x4*)(egs + it * 32 + 8 * g + 4 * hh);
#pragma unroll
        for (int e = 0; e < 4; ++e) o1[4 * g + e] *= gi4[e]; }
      o1 = mm32(QK + it * 32 * 72, 72, Vn, 72, 64, o1, lane);
#pragma unroll
      for (int ii = 0; ii < 16; ++ii) Rt[(it * 32 + crow(ii, hh)) * 32 + r] = f2bf(o1[ii]);
    }
    {
      const float gl = egs[63];
#pragma unroll
      for (int ii = 0; ii < 16; ++ii) S[ii] *= gl;
#pragma unroll
      for (int jt = 0; jt < 2; ++jt) {
        unsigned x[16];
#pragma unroll
        for (int ii = 0; ii < 16; ++ii) x[ii] = Kn[(jt * 32 + crow(ii, hh)) * 136 + 32 * w4 + r];
#pragma unroll
        for (int s2 = 0; s2 < 2; ++s2) {
          const u32x4 aw = (u32x4){x[8 * s2] | (x[8 * s2 + 1] << 16), x[8 * s2 + 2] | (x[8 * s2 + 3] << 16), x[8 * s2 + 4] | (x[8 * s2 + 5] << 16), x[8 * s2 + 6] | (x[8 * s2 + 7] << 16)};
          const LAS bf16_t* bp = Vd + r * 72 + jt * 32 + 16 * s2 + 4 * hh;
          const u32x2 lo = *(const LAS u32x2*)bp, hi = *(const LAS u32x2*)(bp + 8);
          S = MFMA32(__builtin_bit_cast(bf16x8, aw), __builtin_bit_cast(bf16x8, ((u32x4){lo.x, lo.y, hi.x, hi.y})), S);
        }
      }
#pragma unroll
      for (int g = 0; g < 4; ++g) *(LAS u32x2*)(St + r * 136 + 32 * w4 + 8 * g + 4 * hh) = (u32x2){pack2(S[4 * g], S[4 * g + 1]), pack2(S[4 * g + 2], S[4 * g + 3])};
    }
    __syncthreads();
    {
      u32x4 ov = *(const LAS u32x4*)(Rt + (td >> 2) * 32 + (td & 3) * 8);
      if (2 * s >= nch) {
        ov.x = pack2(lo2f(ov.x) + lo2f(po.x), hi2f(ov.x) + hi2f(po.x)); ov.y = pack2(lo2f(ov.y) + lo2f(po.y), hi2f(ov.y) + hi2f(po.y));
        ov.z = pack2(lo2f(ov.z) + lo2f(po.z), hi2f(ov.z) + hi2f(po.z)); ov.w = pack2(lo2f(ov.w) + lo2f(po.w), hi2f(ov.w) + hi2f(po.w));
      }
      *(u32x4*)orow = ov;
    }
  }
#undef DN2_PREFETCH
  if (!samp) {
    const size_t oidx = (size_t)OFF_DN + ((((size_t)(b * 2 + i2) * 2 + dir) * 8 + hd) * 128 + 32 * w4) * 128 + slab * 32 + r;
#pragma unroll
    for (int ii = 0; ii < 16; ++ii) p.out[oidx + (size_t)crow(ii, hh) * 128] = S[ii];
  }
}

DI void phase_dn3(const Params& p, int l) {
  const int i2 = l >> 1;
  bf16_t* Y = (bf16_t*)(p.ws + WS_H);
  const bf16_t* P = (const bf16_t*)(p.ws + WS_P);
  const float* gain = p.in[27] + i2 * 128;
  const int tstride = gridDim.x * 512;
  for (int task0 = bid_opaque() * 512 + tid_opaque(); task0 < M_TOT * 128; task0 += 2 * tstride) {
    u32x4 ov[2], zv[2];
#pragma unroll
    for (int q = 0; q < 2; ++q) {
      const int task = task0 + q * tstride < M_TOT * 128 ? task0 + q * tstride : task0;
      const int pc = task & 15, rh = task >> 4, hd = rh & 7, row = rh >> 3, col = hd * 128 + pc * 8;
      ov[q] = *(const u32x4*)(Y + (size_t)row * 1024 + col);
      zv[q] = *(const u32x4*)(P + (size_t)row * ODD_LD + 3072 + col);
    }
#pragma unroll
    for (int q = 0; q < 2; ++q) {
      const int task = task0 + q * tstride;
      const int pc = task & 15, rh = task >> 4, hd = rh & 7, row = rh >> 3, col = hd * 128 + pc * 8;
      float o[8] = {lo2f(ov[q].x), hi2f(ov[q].x), lo2f(ov[q].y), hi2f(ov[q].y), lo2f(ov[q].z), hi2f(ov[q].z), lo2f(ov[q].w), hi2f(ov[q].w)};
      const float z[8] = {lo2f(zv[q].x), hi2f(zv[q].x), lo2f(zv[q].y), hi2f(zv[q].y), lo2f(zv[q].z), hi2f(zv[q].z), lo2f(zv[q].w), hi2f(zv[q].w)};
      float ss = 0.f;
#pragma unroll
      for (int e = 0; e < 8; ++e) ss += o[e] * o[e];
      ss += __shfl_xor(ss, 1); ss += __shfl_xor(ss, 2); ss += __shfl_xor(ss, 4); ss += __shfl_xor(ss, 8);
      const float rstd = rsqrtf(ss * (1.f / 128.f) + 1e-6f);
      const f32x4 g0 = *(const f32x4*)(gain + pc * 8), g1 = *(const f32x4*)(gain + pc * 8 + 4);
      const float gg[8] = {g0[0], g0[1], g0[2], g0[3], g1[0], g1[1], g1[2], g1[3]};
#pragma unroll
      for (int e = 0; e < 8; ++e) o[e] = o[e] * rstd * gg[e] * siluf_(z[e]);
      if (task < M_TOT * 128) *(u32x4*)(Y + (size_t)row * 1024 + col) = (u32x4){pack2(o[0], o[1]), pack2(o[2], o[3]), pack2(o[4], o[5]), pack2(o[6], o[7])};
    }
  }
}

constexpr int ROWS_A = 32768;
constexpr int N_PHASES = 1 + 9 + 9 + 8 + 9;
enum { ST_N1, ST_IN, ST_M0, ST_M1, ST_M2, ST_OUTA, ST_OUTB, ST_N2T, ST_GU, ST_DNA, ST_DNB, ST_N1T };
DI void run_phase(const Params& p, lptr lds, int ph) {
  const int G = gridDim.x, bid = bid_opaque();
  if (ph == 0) { phase_pre(p, lds, 0, G == 256 ? 2 : 4, bid, G, true); return; }
  int l, k; { int q = ph - 1; if (q < 9) { l = 0; k = q; } else if (q < 18) { l = 1; k = q - 9; } else if (q < 26) { l = 2; k = q - 18; } else { l = 3; k = q - 26; } }
  const bool odd = l & 1; const int i2 = l >> 1;
  int st;
  if (l == 0) { const int tab[9] = {ST_N1, ST_IN, ST_M0, ST_M1, ST_OUTA, ST_OUTB, ST_GU, ST_DNA, ST_DNB}; st = tab[k]; }
  else if (odd) { const int tab[9] = {ST_IN, ST_M0, ST_M1, ST_M2, ST_OUTA, ST_OUTB, ST_GU, ST_DNA, ST_DNB}; st = tab[k]; }
  else { const int tab[8] = {ST_IN, ST_M0, ST_M1, ST_OUTA, ST_OUTB, ST_GU, ST_DNA, ST_DNB}; st = tab[k]; }
  unsigned* tcnt = (unsigned*)(p.ws + WS_BAR) + 3600 + (l * 2) * 16;
  float* mod = (float*)(p.ws + WS_MOD);
  bf16_t* H = (bf16_t*)(p.ws + WS_H); bf16_t* Pb = (bf16_t*)(p.ws + WS_P);
  if (st == ST_N1) { phase_norm(p, lds, l, 0); return; }
  if (st == ST_IN) {
    pg8::EpiIn E; E.P = Pb; E.ldp = odd ? ODD_LD : EVEN_IN; E.odd = odd ? 1 : 0;
    E.kout = p.out + OFF_K + (size_t)i2 * 256 * 128; E.vout = p.out + OFF_V + (size_t)i2 * 256 * 128;
    E.ab = (float*)(p.ws + WS_AB); E.halo = (bf16_t*)(p.ws + WS_HALO);
    run_gemm(lds, H, (const bf16_t*)(p.ws + WS_WIN), odd ? ODD_NP : EVEN_IN, 1024, E); return;
  }
  if (st == ST_M0 || st == ST_M1 || st == ST_M2) {
    const int ms = st - ST_M0;
    if (ms == 0 && l > 0) { cvt_layer(p, lds, l, 4, bid, G); __syncthreads(); }
    if (!odd) {
      if (ms == 0) {
        for (int it = bid; it < 1152; it += G) att_item(p, lds, l, it);
        rg_phase(p, lds, l, 0);
      } else { rg_phase(p, lds, l, 1); }
    } else {
      if (ms == 0) dn1_phase(p, lds, l);
      else if (ms == 1) {
        for (int it = bid; it < 768; it += G) {
          const int grp = it >> 8, j = it & 255, xcd = j & 7, idx = j >> 3;
          dn2_item(p, lds, l, grp * 256 + ((xcd * 8 + (idx >> 2)) * 4 + (idx & 3))); __syncthreads();
        }
      }
      else phase_dn3(p, l);
    }
    return;
  }
  if (st == ST_OUTA || st == ST_OUTB) {
    pg8::EpiRes E; E.x = p.out; E.ga_base = mod + (size_t)l * 9 * 6144 + 2048;
    if (st == ST_OUTA) { E.rbase = 0; run_gemm_sub(lds, H, (const bf16_t*)(p.ws + WS_WOUT), ROWS_A, 1024, 1024, E, bid, G); return; }
    if (bid < 64) {
      E.rbase = ROWS_A; run_gemm_sub(lds, H + (size_t)ROWS_A * 1024, (const bf16_t*)(p.ws + WS_WOUT), M_TOT - ROWS_A, 1024, 1024, E, bid, 64);
      int pm, pn; tail_panel_sync(tcnt, M_TOT - ROWS_A, 1024, bid, 64, pm, pn);
      norm_rows(p, l, 1, ROWS_A + pm * 256 + pn * 64, ROWS_A + pm * 256 + pn * 64 + 64, 0, 1);
    }
    else norm_rows(p, l, 1, 0, ROWS_A, bid - 64, G - 64);
    return;
  }
  if (st == ST_GU) { pg8::EpiGU E; E.act = Pb; run_gemm(lds, H, (const bf16_t*)(p.ws + WS_WGU), 5632, 1024, E); return; }
  if (st == ST_DNA || st == ST_DNB) {
    pg8::EpiRes E; E.x = p.out; E.ga_base = mod + (size_t)l * 9 * 6144 + 5120;
    if (st == ST_DNA) { E.rbase = 0; run_gemm_sub(lds, Pb, (const bf16_t*)(p.ws + WS_WDN), ROWS_A, 1024, DFF, E, bid, G); return; }
    if (bid < 64) {
      E.rbase = ROWS_A; run_gemm_sub(lds, Pb + (size_t)ROWS_A * DFF, (const bf16_t*)(p.ws + WS_WDN), M_TOT - ROWS_A, 1024, DFF, E, bid, 64);
      int pm, pn; tail_panel_sync(tcnt + 16, M_TOT - ROWS_A, 1024, bid, 64, pm, pn);
      const int lo = ROWS_A + pm * 256 + pn * 64;
      if (l < 3) norm_rows(p, l + 1, 0, lo, lo + 64, 0, 1); else norm_rows(p, 0, 2, lo, lo + 64, 0, 1);
    }
    else {
      if (l < 3) { norm_rows(p, l + 1, 0, 0, ROWS_A, bid - 64, G - 64); cvt_layer(p, lds, l + 1, 3, bid - 64, G - 64); if (l == 0 && G == 256) { __syncthreads(); phase_pre(p, lds, 2, 4, bid - 64, G - 64, false); } }
      else norm_rows(p, 0, 2, 0, ROWS_A, bid - 64, G - 64);
    }
    return;
  }
}

#define XB_TMO      128
#define XB_XCNT(j)  (256  + 64 * (j))
#define XB_XSUB(j)  (1280 + 64 * (j))
#define XB_XGEN(j)  (2304 + 64 * (j))
#define XB_TOP      3328
#define XB_TOPGEN   3392
#define XCD_BAR_WORDS 3456
#define XB_SPIN_CAP (1u << 20)
DI unsigned xb_ld(unsigned* p) { return __hip_atomic_load(p, __ATOMIC_RELAXED, __HIP_MEMORY_SCOPE_AGENT); }
DI unsigned xb_add(unsigned* p, unsigned v) { return __hip_atomic_fetch_add(p, v, __ATOMIC_RELAXED, __HIP_MEMORY_SCOPE_AGENT); }
DI unsigned xb_xcc_id() { return (unsigned)__builtin_amdgcn_s_getreg((3 << 11) | 20) & 0xFu; }
#define XB_SPIN(cond, bar) do { unsigned _sp = 0; while (cond) { __builtin_amdgcn_s_sleep(1); \
    if ((++_sp & 255u) == 0u) { if (xb_ld(&(bar)[XB_TMO])) break; if (_sp > XB_SPIN_CAP) { atomicAdd(&(bar)[XB_TMO], 1u); break; } } } } while (0)
struct XcdBarrier { unsigned* bar; unsigned x; volatile LAS unsigned* st; };
DI XcdBarrier xcd_barrier_post(unsigned* bar, volatile LAS unsigned* st) {
  XcdBarrier b; b.bar = bar; b.x = xb_xcc_id(); b.st = st;
  if (threadIdx.x == 0) (void)xb_add(&bar[XB_XCNT(b.x)], 1u);
  return b;
}
DI void xcd_barrier_complete(unsigned* bar, unsigned x, unsigned& nloc, unsigned& nx) {
  const unsigned G = gridDim.x;
  unsigned sum, cnt, mine, sp = 0u;
  for (;;) {
    sum = 0u; cnt = 0u; mine = 0u;
#pragma unroll
    for (unsigned j = 0; j < 16; ++j) { const unsigned c = xb_ld(&bar[XB_XCNT(j)]); sum += c; cnt += (c > 0u) ? 1u : 0u; mine = (j == x) ? c : mine; }
    if (sum == G) break;
    __builtin_amdgcn_s_sleep(1);
    if ((++sp & 255u) == 0u) { if (xb_ld(&bar[XB_TMO])) break; if (sp > XB_SPIN_CAP) { atomicAdd(&bar[XB_TMO], 1u); break; } }
  }
  nloc = mine > 0u ? mine : 1u; nx = cnt > 0u ? cnt : 1u;
}
DI void xcd_barrier(const XcdBarrier& b) {
  asm volatile("s_waitcnt vmcnt(0)" ::: "memory");
  __syncthreads();
  if (threadIdx.x == 0) {
    unsigned* bar = b.bar;
    __builtin_amdgcn_s_waitcnt(0);
    unsigned nloc = b.st[0], nx = b.st[1];
    if (nloc == 0u) { xcd_barrier_complete(bar, b.x, nloc, nx); b.st[0] = nloc; b.st[1] = nx; }
    const unsigned old = xb_add(&bar[XB_XSUB(b.x)], 1u);
    const unsigned gen = old / nloc;
    if (old + 1u == (gen + 1u) * nloc) {
      __builtin_amdgcn_fence(__ATOMIC_RELEASE, "agent");
      asm volatile("s_waitcnt vmcnt(0)" ::: "memory");
      const unsigned og = xb_add(&bar[XB_TOP], 1u);
      const unsigned tg = og / nx;
      if (og + 1u == (tg + 1u) * nx) xb_add(&bar[XB_TOPGEN], 1u);
      else XB_SPIN(xb_ld(&bar[XB_TOPGEN]) == tg, bar);
      __builtin_amdgcn_fence(__ATOMIC_ACQUIRE, "agent");
      xb_add(&bar[XB_XGEN(b.x)], 1u);
      asm volatile("s_waitcnt vmcnt(0)" ::: "memory");
    } else {
      XB_SPIN(xb_ld(&bar[XB_XGEN(b.x)]) == gen, bar);
      __builtin_amdgcn_fence(__ATOMIC_ACQUIRE, "agent");
      asm volatile("s_waitcnt vmcnt(0)" ::: "memory");
    }
  }
  __syncthreads();
}

__global__ void __launch_bounds__(512, 2) fwd_kernel(Params p) {
  extern __shared__ __attribute__((aligned(16))) unsigned char smem[];
  lptr lds = (lptr)smem;
  cg::grid_group grid = cg::this_grid();
  volatile LAS unsigned* xst = (volatile LAS unsigned*)(lds + LDS_BYTES - 16);
  if (threadIdx.x == 0) { xst[0] = 0u; xst[1] = 0u; }
  __syncthreads();
  const XcdBarrier xb = xcd_barrier_post((unsigned*)(p.ws + WS_BAR), xst);
  const int p_lo = p.p_lo, p_hi = p.p_hi, coop = p.coop;
  for (int ph = p_lo; ph < p_hi; ++ph) {
    unsigned long long kav = (unsigned long long)__builtin_amdgcn_kernarg_segment_ptr();
    asm volatile("" : "+s"(kav));
    const __attribute__((address_space(4))) Params* kp = (const __attribute__((address_space(4))) Params*)kav;
    run_phase(*(const Params*)kp, lds, ph);
    if (coop && ph + 1 < p_hi) {
      if (ph == p_lo) grid.sync();
      else xcd_barrier(xb);
    }
  }
}

extern "C" void kernel_launch(void* const* d_in, const int* in_sizes, int n_in, void* d_out, int out_size, void* d_ws, size_t ws_size, hipStream_t stream) {
  static int grid = 0;
  if (grid == 0) {
    if (n_in != 31 || ws_size < WS_TOTAL) { fprintf(stderr, "kernel_launch: unexpected n_in %d or ws_size %zu (need %zu)\n", n_in, ws_size, (size_t)WS_END); grid = -1; return; }
    int dev = 0, cus = 0, per_cu = 0;
    hipGetDevice(&dev);
    hipDeviceGetAttribute(&cus, hipDeviceAttributeMultiprocessorCount, dev);
    if (hipFuncSetAttribute((const void*)fwd_kernel, hipFuncAttributeMaxDynamicSharedMemorySize, LDS_BYTES) != hipSuccess) { fprintf(stderr, "kernel_launch: hipFuncSetAttribute failed\n"); }
    hipOccupancyMaxActiveBlocksPerMultiprocessor(&per_cu, (const void*)fwd_kernel, 512, LDS_BYTES);
    (void)hipGetLastError();
    if (per_cu < 1) per_cu = 1;
    grid = cus * per_cu;
    if (grid > 256) grid = 256;
    fprintf(stderr, "kernel_launch: cus %d per_cu %d grid %d ws %zu need %zu\n", cus, per_cu, grid, ws_size, (size_t)WS_END);
  }
  if (grid < 0) return;
  if (hipMemsetAsync((char*)d_ws + WS_BAR, 0, 16384, stream) != hipSuccess) fprintf(stderr, "kernel_launch: memset failed\n");
  Params p{};
  for (int i = 0; i < 31; ++i) p.in[i] = (const float*)d_in[i];
  p.out = (float*)d_out; p.ws = (unsigned char*)d_ws; p.p_lo = 0; p.p_hi = N_PHASES; p.coop = 1; p.pad = 0;
  void* args[] = {&p};
  hipError_t e = hipLaunchCooperativeKernel((const void*)fwd_kernel, dim3(grid), dim3(512), args, LDS_BYTES, stream);
  if (e != hipSuccess) fprintf(stderr, "cooperative launch failed: %s (grid %d)\n", hipGetErrorString(e), grid);
}
```

```cpp
#include <hip/hip_runtime.h>
#include <hip/hip_cooperative_groups.h>
#include <cstdio>
namespace cg = cooperative_groups;
#define DI __device__ __forceinline__
#define LAS __attribute__((address_space(3)))
typedef unsigned short bf16_t;
typedef short bf16x8 __attribute__((ext_vector_type(8)));
typedef float f32x4 __attribute__((ext_vector_type(4)));
typedef float f32x16 __attribute__((ext_vector_type(16)));
typedef unsigned u32x4 __attribute__((ext_vector_type(4)));
typedef unsigned u32x2 __attribute__((ext_vector_type(2)));
typedef LAS unsigned char* lptr;

constexpr int M_TOT = 36864, M_P = 4096, DM = 1024;
constexpr int EVEN_IN = 1792, ODD_NP = 4352, ODD_LD = 4096, DFF = 2816;
constexpr int OFF_K = M_TOT * DM, OFF_V = OFF_K + 1048576, OFF_RG = OFF_V + 1048576, OFF_DN = OFF_RG + 32768;
constexpr size_t WS_MOD = 0;
constexpr size_t WS_ROPE = WS_MOD + 884736;
constexpr size_t WS_WIN = WS_ROPE + 1048576;
constexpr size_t WS_WOUT = WS_WIN + (size_t)ODD_NP * 1024 * 2;
constexpr size_t WS_WGU = WS_WOUT + 1024 * 1024 * 2;
constexpr size_t WS_WDN = WS_WGU + (size_t)5632 * 1024 * 2;
constexpr size_t WS_RGW = WS_WDN + (size_t)1024 * 2816 * 2;
constexpr size_t WS_H = WS_RGW + 262144;
constexpr size_t WS_P = WS_H + (size_t)M_TOT * 1024 * 2;
constexpr size_t WS_AB = WS_P + (size_t)M_TOT * 4096 * 2;
constexpr size_t WS_HALO = WS_AB + (size_t)M_TOT * 32 * 4;
constexpr size_t WS_T = WS_HALO + (size_t)576 * 3 * 3072 * 2;
constexpr size_t WS_CARRY = WS_T + (size_t)576 * 8 * 2 * 4096 * 2;
constexpr size_t WS_END = WS_CARRY + (size_t)576 * 2 * 2 * 512 * 4;
constexpr size_t WS_BAR = WS_END;
constexpr size_t WS_TOTAL = WS_BAR + 16384;
constexpr int LDS_BYTES = 160 * 1024;

struct Params {
  const float* in[31];
  float* out;
  unsigned char* ws;
  int p_lo, p_hi, coop, pad;
};

DI int tid_opaque() { int t = threadIdx.x; asm volatile("" : "+v"(t)); return t; }
DI int bid_opaque() { int t = blockIdx.x; asm volatile("" : "+s"(t)); return t; }

typedef __bf16 hwbf16x2 __attribute__((ext_vector_type(2)));
typedef float f32x2v __attribute__((ext_vector_type(2)));
DI unsigned pack2(float lo, float hi) { const f32x2v v = {lo, hi}; return __builtin_bit_cast(unsigned, __builtin_convertvector(v, hwbf16x2)); }
DI bf16_t f2bf(float f) { return (bf16_t)(pack2(f, 0.f) & 0xffffu); }
DI float bf2f(bf16_t b) { return __uint_as_float(((unsigned)b) << 16); }
DI float lo2f(unsigned u) { return __uint_as_float(u << 16); }
DI float hi2f(unsigned u) { return __uint_as_float(u & 0xffff0000u); }
DI float sigmoidf_(float x) { return __builtin_amdgcn_rcpf(1.f + __expf(-x)); }
DI float siluf_(float x) { return x * __builtin_amdgcn_rcpf(1.f + __expf(-x)); }
DI float softplusf_(float x) { return x > 20.f ? x : log1pf(__expf(x)); }
DI int crow(int reg, int h) { return (reg & 3) + 8 * (reg >> 2) + 4 * h; }
DI int row_group(int r) { return r < M_P ? 0 : 1 + ((r - M_P) >> 12); }
DI float wave_sum(float v) {
#pragma unroll
  for (int o = 32; o > 0; o >>= 1) v += __shfl_xor(v, o);
  return v;
}
#define MFMA32(a, b, c) __builtin_amdgcn_mfma_f32_32x32x16_bf16((a), (b), (c), 0, 0, 0)
DI f32x16 mm32(const LAS bf16_t* A, int lda, const LAS bf16_t* Bt, int ldb, int K, f32x16 acc, int lane) {
  const int r = lane & 31, h = lane >> 5;
  const LAS bf16_t* ap = A + r * lda + 8 * h;
  const LAS bf16_t* bp = Bt + r * ldb + 8 * h;
_Pragma("unroll 4")
  for (int k0 = 0; k0 < K; k0 += 16) {
    bf16x8 a = *(const LAS bf16x8*)(ap + k0);
    bf16x8 b = *(const LAS bf16x8*)(bp + k0);
    acc = MFMA32(a, b, acc);
  }
  return acc;
}
DI f32x16 zero16() { f32x16 z; for (int i = 0; i < 16; ++i) z[i] = 0.f; return z; }

DI void phase_pre(const Params& p, lptr lds, int l_lo, int l_hi, int vb, int nb, bool rope) {
  const int tid = tid_opaque(), wid = tid >> 6, lane = tid & 63;
  float* rc = (float*)(p.ws + WS_ROPE); float* rs = rc + 4096 * 32;
  if (rope)
  for (int e = bid_opaque() * 512 + tid; e < 4096 * 32; e += gridDim.x * 512) {
    const int t = e >> 5, f = e & 31, fr = f & 15;
    const float inv = exp2f(-(float)fr * 0.83048202372184058696f);
    const float pos = (f < 16) ? (float)(t >> 6) : (float)(t & 63);
    float x = pos * inv * 0.15915494309189533577f; x -= floorf(x);
    rc[e] = __builtin_amdgcn_cosf(x); rs[e] = __builtin_amdgcn_sinf(x);
  }
  LAS float* sc = (LAS float*)lds;
  LAS float* red = sc + 9 * 1024;
  for (int e = tid; e < 9 * 1024; e += 512) { const int g = e >> 10, k = e & 1023; const float v = g == 0 ? p.in[7][k] : p.in[2][(g - 1) * 1024 + k]; sc[e] = siluf_(v); }
  __syncthreads();
  float* mod = (float*)(p.ws + WS_MOD);
  for (int it = vb; it < (l_hi - l_lo) * 96; it += nb) {
    const int l = l_lo + it / 96, n0 = (it % 96) * 64;
    const float* w = p.in[8] + (size_t)l * 1024 * 6144 + n0 + lane;
    float acc[9];
#pragma unroll
    for (int g = 0; g < 9; ++g) acc[g] = 0.f;
#pragma unroll 16
    for (int k = wid * 128; k < wid * 128 + 128; ++k) {
      const float wv = w[(size_t)k * 6144];
#pragma unroll
      for (int g = 0; g < 9; ++g) acc[g] += sc[g * 1024 + k] * wv;
    }
#pragma unroll
    for (int g = 0; g < 9; ++g) red[(wid * 9 + g) * 64 + lane] = acc[g];
    __syncthreads();
    for (int e = tid; e < 9 * 64; e += 512) {
      const int g = e >> 6, c = e & 63; float s = 0.f;
#pragma unroll
      for (int w8 = 0; w8 < 8; ++w8) s += red[(w8 * 9 + g) * 64 + c];
      mod[((size_t)l * 9 + g) * 6144 + n0 + c] = s + p.in[9][l * 6144 + n0 + c];
    }
    __syncthreads();
  }
}

DI void cvt_tile(const float* src, int lds_src, int nvalid, bf16_t* dst, int ldd, int k0, int n0, int mode, LAS float* buf) {
  const int tid = tid_opaque();
  for (int e = tid; e < 4096; e += 512) { const int i = e >> 6, j = e & 63; buf[i * 65 + j] = (j < nvalid) ? src[(size_t)i * lds_src + j] : 0.f; }
  __syncthreads();
  for (int e = tid; e < 2048; e += 512) {
    const int j = e >> 5, i2 = (e & 31) * 2;
    if (j < nvalid) {
      int n = n0 + j, row = n;
      if (mode == 1) { const int up = n >= DFF ? 1 : 0; const int jj = n - up * DFF; row = 256 * (jj >> 7) + 128 * up + (jj & 127); }
      *(unsigned*)(dst + (size_t)row * ldd + k0 + i2) = pack2(buf[i2 * 65 + j], buf[(i2 + 1) * 65 + j]);
    }
  }
  __syncthreads();
}
DI void cvt_matrix(const float* W, int K, int N, bf16_t* dst, int mode, LAS float* buf, int vb, int nb) {
  const int nk = K / 64, nn = (N + 63) / 64;
  for (int t = vb; t < nk * nn; t += nb) {
    const int tk = t % nk, tn = t / nk, k0 = tk * 64, n0 = tn * 64;
    const int nvalid = (N - n0) < 64 ? (N - n0) : 64;
    cvt_tile(W + (size_t)k0 * N + n0, N, nvalid, dst, K, k0, n0, mode, buf);
  }
}

DI void cvt_layer(const Params& p, lptr lds, int l, int what, int vb, int nb) {
  const int tid = tid_opaque();
  const int i2 = l >> 1;
  LAS float* buf = (LAS float*)lds;
  if (what & 1) {
    if ((l & 1) == 0) {
      cvt_matrix(p.in[13] + (size_t)i2 * 1024 * EVEN_IN, 1024, EVEN_IN, (bf16_t*)(p.ws + WS_WIN), 0, buf, vb, nb);
      cvt_matrix(p.in[22] + (size_t)i2 * 1024 * 1024, 1024, 1024, (bf16_t*)(p.ws + WS_WOUT), 0, buf, vb, nb);
      for (int t = vb; t < 32; t += nb) {
        const int gate = t >> 4, dir = (t >> 3) & 1, n = t & 7;
        const float* srcp = (gate ? p.in[18] : p.in[16]) + ((size_t)(i2 * 2 + dir) * 8 + n) * 4096;
        cvt_tile(srcp, 64, 64, (bf16_t*)(p.ws + WS_RGW) + ((size_t)(dir * 2 + gate) * 8 + n) * 4096, 64, 0, 0, 0, buf);
      }
    } else {
      cvt_matrix(p.in[23] + (size_t)i2 * 1024 * 4128, 1024, 4128, (bf16_t*)(p.ws + WS_WIN), 0, buf, vb, nb);
      cvt_matrix(p.in[28] + (size_t)i2 * 1024 * 1024, 1024, 1024, (bf16_t*)(p.ws + WS_WOUT), 0, buf, vb, nb);
      u32x4* z = (u32x4*)((bf16_t*)(p.ws + WS_WIN) + (size_t)4128 * 1024);
      for (int e = vb * 512 + tid; e < 224 * 1024 / 8; e += nb * 512) z[e] = (u32x4){0u, 0u, 0u, 0u};
    }
  }
  if (what & 2) cvt_matrix(p.in[29] + (size_t)l * 1024 * 5632, 1024, 5632, (bf16_t*)(p.ws + WS_WGU), 1, buf, vb, nb);
  if (what & 4) cvt_matrix(p.in[30] + (size_t)l * DFF * 1024, DFF, 1024, (bf16_t*)(p.ws + WS_WDN), 0, buf, vb, nb);
}

DI void phase_norm(const Params& p, lptr lds, int l, int which) {
  const int tid = tid_opaque(), wid = tid >> 6, lane = tid & 63;
  const int i2 = l >> 1;
  if (which == 0) { if (l == 0) cvt_layer(p, lds, 0, 7, bid_opaque(), gridDim.x); else cvt_layer(p, lds, l, gridDim.x == 256 ? 4 : 7, bid_opaque(), gridDim.x); }
  const bool first = (l == 0 && which == 0);
  const float* mod = (const float*)(p.ws + WS_MOD);
  bf16_t* h = (bf16_t*)(p.ws + WS_H);
  const float* gn = (which ? p.in[11] : p.in[10]) + l * 1024;
  const int rstride = gridDim.x * 8;
  for (int row0 = bid_opaque() * 8 + wid; row0 < M_TOT; row0 += 6 * rstride) {
    f32x4 v[6][4]; float ss[6];
#pragma unroll
    for (int q = 0; q < 6; ++q) {
      const int row = row0 + q * rstride < M_TOT ? row0 + q * rstride : row0;
      const float* xs = first ? (row < M_P ? p.in[0] + (size_t)row * 1024 : p.in[1] + (size_t)(row - M_P) * 1024) : p.out + (size_t)row * 1024;
#pragma unroll
      for (int i = 0; i < 4; ++i) v[q][i] = *(const f32x4*)(xs + lane * 4 + 256 * i);
    }
#pragma unroll
    for (int q = 0; q < 6; ++q) {
      float s = 0.f;
#pragma unroll
      for (int i = 0; i < 4; ++i) s += v[q][i][0] * v[q][i][0] + v[q][i][1] * v[q][i][1] + v[q][i][2] * v[q][i][2] + v[q][i][3] * v[q][i][3];
      ss[q] = wave_sum(s);
    }
#pragma unroll
    for (int q = 0; q < 6; ++q) {
      const int row = row0 + q * rstride;
      if (row < M_TOT) {
        const float rstd = rsqrtf(ss[q] * (1.f / 1024.f) + 1e-6f);
        const float* md = mod + ((size_t)l * 9 + row_group(row)) * 6144 + (which ? 3072 : 0);
#pragma unroll
        for (int i = 0; i < 4; ++i) {
          const int c = lane * 4 + 256 * i;
          const f32x4 gg = *(const f32x4*)(gn + c), sh = *(const f32x4*)(md + c), sc = *(const f32x4*)(md + 1024 + c);
          f32x4 y;
#pragma unroll
          for (int j = 0; j < 4; ++j) y[j] = v[q][i][j] * rstd * gg[j] * (1.f + sc[j]) + sh[j];
          *(u32x2*)(h + (size_t)row * 1024 + c) = (u32x2){pack2(y[0], y[1]), pack2(y[2], y[3])};
        }
      }
    }
    if (first) {
#pragma unroll
      for (int q = 0; q < 6; ++q) {
        const int row = row0 + q * rstride;
        if (row < M_TOT) {
#pragma unroll
          for (int i = 0; i < 4; ++i) *(f32x4*)(p.out + (size_t)row * 1024 + lane * 4 + 256 * i) = v[q][i];
        }
      }
    }
  }
}

DI void phase_final(const Params& p) {
  const int tid = tid_opaque(), wid = tid >> 6, lane = tid & 63;
  const float* gn = p.in[12];
  const int rstride = gridDim.x * 8;
  for (int row0 = bid_opaque() * 8 + wid; row0 < M_TOT; row0 += 3 * rstride) {
    f32x4 v[3][4]; float ss[3];
#pragma unroll
    for (int q = 0; q < 3; ++q) {
      const int row = row0 + q * rstride < M_TOT ? row0 + q * rstride : row0;
      const float* xs = p.out + (size_t)row * 1024;
#pragma unroll
      for (int i = 0; i < 4; ++i) v[q][i] = *(const f32x4*)(xs + lane * 4 + 256 * i);
    }
#pragma unroll
    for (int q = 0; q < 3; ++q) {
      float s = 0.f;
#pragma unroll
      for (int i = 0; i < 4; ++i) s += v[q][i][0] * v[q][i][0] + v[q][i][1] * v[q][i][1] + v[q][i][2] * v[q][i][2] + v[q][i][3] * v[q][i][3];
      ss[q] = wave_sum(s);
    }
#pragma unroll
    for (int q = 0; q < 3; ++q) {
      const int row = row0 + q * rstride;
      if (row < M_TOT) {
        const float rstd = rsqrtf(ss[q] * (1.f / 1024.f) + 1e-6f);
#pragma unroll
        for (int i = 0; i < 4; ++i) {
          const int c = lane * 4 + 256 * i;
          const f32x4 gg = *(const f32x4*)(gn + c);
          f32x4 y;
#pragma unroll
          for (int j = 0; j < 4; ++j) y[j] = v[q][i][j] * rstd * gg[j];
          *(f32x4*)(p.out + (size_t)row * 1024 + c) = y;
        }
      }
    }
  }
}

namespace pg8 {
constexpr int BM = 256, BK = 64, HALF = 128, HTB = HALF * BK * 2, STAGE_BYTES = 8 * HTB, NXCD = 8, WGM = 8;
DI int lds_byte(int r, int c) { const int st = (r >> 4) * 2 + (c >> 5), rr = r & 15, cc = c & 31, ob = rr * 64 + cc * 2; return st * 1024 + (ob ^ (((ob >> 9) & 1) << 5)); }
DI void stage_rc(int b, int& R, int& C) { const int st = b / 1024, sb = b % 1024, swz = sb ^ (((sb >> 9) & 1) << 5); R = (st >> 1) * 16 + swz / 64; C = (st & 1) * 32 + (swz % 64) / 2; }
DI int perm32(int rho) { const int n = rho >> 4, i = rho & 15; return 8 * (i >> 2) + 4 * n + (i & 3); }
struct Unit { int pm, pn; };
struct Gemm { const bf16_t* A; const bf16_t* Bt; int M, N, K; };
struct StaticOrder {
  int nM, nN, nwg, G, c;
  DI void init(int M, int N, int G_, int c_) { nM = M / BM; nN = N / BM; nwg = nM * nN; G = G_; c = c_; }
  DI bool next(int i, Unit& u) const {
    const long L = (long)i * G + c; if (L >= nwg) return false;
    int wgid = (int)L; { const int q = nwg / NXCD, r = nwg % NXCD, xcd = wgid % NXCD, off = wgid / NXCD; wgid = (xcd < r ? xcd * (q + 1) : r * (q + 1) + (xcd - r) * q) + off; }
    const int nig = WGM * nN, gid = wgid / nig, fm = gid * WGM, gsz = (nM - fm) < WGM ? (nM - fm) : WGM;
    u.pm = fm + ((wgid % nig) % gsz); u.pn = (wgid % nig) / gsz; return true;
  }
};
DI unsigned cvt_pk_bf16(float lo, float hi) { unsigned r; asm volatile("v_cvt_pk_bf16_f32 %0, %1, %2" : "=v"(r) : "v"(lo), "v"(hi)); return r; }

template <class Epi>
DI void gemm_phase(lptr lds, const Gemm g, const StaticOrder& S, const Epi& E) {
  const int tid = tid_opaque(), wid = __builtin_amdgcn_readfirstlane(tid >> 6), lane = tid & 63, wr = wid >> 2, wc = wid & 3, fr = lane & 15, fq = lane >> 4;
  const int K = g.K, nt = K / BK;
  unsigned voffA[2], voffB[2];
#pragma unroll
  for (int i = 0; i < 2; ++i) { int R, C; stage_rc(tid * 16 + i * 8192, R, C); const int Rb = Epi::PERM ? ((R & ~31) + perm32(R & 31)) : R;
    voffA[i] = (unsigned)(R * K + C) * 2u; voffB[i] = (unsigned)(Rb * K + C) * 2u; }
  const size_t kstep = (size_t)(BK * 2);
  const size_t hstep = (size_t)HALF * K * 2;
  const size_t tstep = 2 * hstep;
  const unsigned ldsw = (unsigned)wid * 1024u;
  const int aoff = lds_byte(wr * 64 + fr, fq * 8), boff = lds_byte(wc * 32 + fr, fq * 8);
#define PG8_SA(b, h) (((b) * 2 + (h)) * HTB)
#define PG8_SB(b, h) ((4 + (b) * 2 + (h)) * HTB)
#define PG8_STAGE(bufoff, gbase, voff) do { _Pragma("unroll") for (int _i = 0; _i < 2; ++_i) \
    __builtin_amdgcn_global_load_lds((const unsigned*)((const char*)(gbase) + (voff)[_i]), (LAS unsigned*)(lds + (bufoff) + ldsw + _i * 8192), 16, 0, 0); } while (0)
#define PG8_LDA(dst, b, h) do { _Pragma("unroll") for (int m = 0; m < 4; ++m) _Pragma("unroll") for (int k = 0; k < 2; ++k) dst[m][k] = *(const LAS bf16x8*)(lds + PG8_SA(b, h) + aoff + m * 2048 + k * 1024); } while (0)
#define PG8_LDB(dst, b, h) do { _Pragma("unroll") for (int n = 0; n < 2; ++n) _Pragma("unroll") for (int k = 0; k < 2; ++k) dst[n][k] = *(const LAS bf16x8*)(lds + PG8_SB(b, h) + boff + n * 2048 + k * 1024); } while (0)
#define PG8_MMA(ai, bj, At, Bt) do { __builtin_amdgcn_s_setprio(1); _Pragma("unroll") for (int m = 0; m < 4; ++m) _Pragma("unroll") for (int n = 0; n < 2; ++n) _Pragma("unroll") for (int k = 0; k < 2; ++k) \
    acc[ai][bj][m][n] = __builtin_amdgcn_mfma_f32_16x16x32_bf16(Bt[n][k], At[m][k], acc[ai][bj][m][n], 0, 0, 0); __builtin_amdgcn_s_setprio(0); } while (0)
#define PG8_WAIT_V(n) asm volatile("s_waitcnt vmcnt(" #n ")" ::: "memory")
#define PG8_WAIT_L(n) asm volatile("s_waitcnt lgkmcnt(" #n ")" ::: "memory")
#define PG8_BAR __builtin_amdgcn_s_barrier()
#define PG8_SCHED __builtin_amdgcn_sched_barrier(0)
  Unit cur, nxt; int ui = 0;
  if (!S.next(0, cur)) return;
  f32x4 acc[2][2][4][2];
#pragma unroll
  for (int a = 0; a < 2; ++a)
#pragma unroll
    for (int b = 0; b < 2; ++b)
#pragma unroll
      for (int m = 0; m < 4; ++m)
#pragma unroll
        for (int n = 0; n < 2; ++n) acc[a][b][m][n] = (f32x4){0.f, 0.f, 0.f, 0.f};
  bf16x8 At[4][2], B0[2][2], B1[2][2];
  const char* cA = (const char*)g.A + (size_t)cur.pm * tstep; const char* cB = (const char*)g.Bt + (size_t)cur.pn * tstep;
  PG8_STAGE(PG8_SB(0, 0), cB, voffB); PG8_STAGE(PG8_SA(0, 0), cA, voffA); PG8_STAGE(PG8_SB(0, 1), cB + hstep, voffB); PG8_STAGE(PG8_SA(0, 1), cA + hstep, voffA);
  if (wr == 1) PG8_BAR;
  PG8_WAIT_V(4); PG8_BAR;
  PG8_STAGE(PG8_SB(1, 0), cB + kstep, voffB); PG8_STAGE(PG8_SA(1, 0), cA + kstep, voffA); PG8_STAGE(PG8_SB(1, 1), cB + hstep + kstep, voffB);
  PG8_WAIT_V(6); PG8_BAR;
  for (;;) {
    const bool has_next = S.next(ui + 1, nxt);
    const char* nA = has_next ? (const char*)g.A + (size_t)nxt.pm * tstep : cA; const char* nB = has_next ? (const char*)g.Bt + (size_t)nxt.pn * tstep : cB;
    for (int t = 0; t < nt; t += 2) {
      const bool last = (t == nt - 2);
      const char* a1 = cA + (size_t)(t + 1) * kstep;
      const char* a2 = last ? nA : cA + (size_t)(t + 2) * kstep; const char* b2 = last ? nB : cB + (size_t)(t + 2) * kstep;
      const char* a3 = a2 + kstep; const char* b3 = b2 + kstep;
      PG8_LDB(B0, 0, 0); PG8_SCHED; PG8_LDA(At, 0, 0); PG8_STAGE(PG8_SA(1, 1), a1 + hstep, voffA);
      PG8_WAIT_L(8); PG8_BAR; PG8_WAIT_L(0); PG8_MMA(0, 0, At, B0); PG8_BAR; PG8_SCHED;
      PG8_LDB(B1, 0, 1); PG8_STAGE(PG8_SB(0, 0), b2, voffB);
      PG8_BAR; PG8_WAIT_L(0); PG8_MMA(0, 1, At, B1); PG8_BAR;
      PG8_LDA(At, 0, 1); PG8_STAGE(PG8_SA(0, 0), a2, voffA);
      PG8_BAR; PG8_WAIT_L(0); PG8_MMA(1, 0, At, B0); PG8_BAR; PG8_SCHED;
      PG8_STAGE(PG8_SB(0, 1), b2 + hstep, voffB);
      PG8_WAIT_V(6); PG8_BAR; PG8_MMA(1, 1, At, B1); PG8_BAR;
      PG8_LDB(B0, 1, 0); PG8_SCHED; PG8_LDA(At, 1, 0); PG8_STAGE(PG8_SA(0, 1), a2 + hstep, voffA);
      PG8_WAIT_L(8); PG8_BAR; PG8_WAIT_L(0); PG8_MMA(0, 0, At, B0); PG8_BAR; PG8_SCHED;
      PG8_LDB(B1, 1, 1); PG8_STAGE(PG8_SB(1, 0), b3, voffB);
      PG8_BAR; PG8_WAIT_L(0); PG8_MMA(0, 1, At, B1); PG8_BAR;
      PG8_LDA(At, 1, 1); PG8_STAGE(PG8_SA(1, 0), a3, voffA);
      PG8_BAR; PG8_WAIT_L(0); PG8_MMA(1, 0, At, B0); PG8_BAR; PG8_SCHED;
      PG8_STAGE(PG8_SB(1, 1), b3 + hstep, voffB);
      PG8_WAIT_V(6); PG8_BAR; PG8_MMA(1, 1, At, B1); PG8_BAR;
    }
    E(acc, cur, wr, wc, fr, fq);
    if (!has_next) break;
#pragma unroll
    for (int a = 0; a < 2; ++a)
#pragma unroll
      for (int b = 0; b < 2; ++b)
#pragma unroll
        for (int m = 0; m < 4; ++m)
#pragma unroll
          for (int n = 0; n < 2; ++n) acc[a][b][m][n] = (f32x4){0.f, 0.f, 0.f, 0.f};
    cur = nxt; cA = nA; cB = nB; ++ui;
  }
  PG8_WAIT_V(0);
  if (wr == 0) PG8_BAR;
  PG8_BAR;
#undef PG8_SA
#undef PG8_SB
#undef PG8_STAGE
#undef PG8_LDA
#undef PG8_LDB
#undef PG8_MMA
#undef PG8_WAIT_V
#undef PG8_WAIT_L
#undef PG8_BAR
#undef PG8_SCHED
}

struct EpiIn {
  static constexpr bool PERM = true;
  bf16_t* P; int ldp; int odd; float* kout; float* vout; float* ab; bf16_t* halo;
  DI void operator()(const f32x4 (&acc)[2][2][4][2], const Unit& u, int wr, int wc, int fr, int fq) const {
    const int row0 = u.pm * BM + wr * 64 + fr;
    if (odd && u.pn == 16) {
      if (wc == 0) {
#pragma unroll
        for (int ai = 0; ai < 2; ++ai)
#pragma unroll
          for (int m = 0; m < 4; ++m) { const int r = row0 + ai * HALF + m * 16;
#pragma unroll
            for (int n = 0; n < 2; ++n) *(f32x4*)(ab + (size_t)r * 32 + 8 * fq + 4 * n) = acc[ai][0][m][n]; }
      }
      return;
    }
    const int col0 = u.pn * BM + wc * 32 + 8 * fq;
#pragma unroll
    for (int ai = 0; ai < 2; ++ai)
#pragma unroll
      for (int m = 0; m < 4; ++m) {
        const int r = row0 + ai * HALF + m * 16; bf16_t* rowp = P + (size_t)r * ldp + col0;
#pragma unroll
        for (int bj = 0; bj < 2; ++bj) {
          const f32x4 v0 = acc[ai][bj][m][0], v1 = acc[ai][bj][m][1];
          u32x4 w; w.x = cvt_pk_bf16(v0[0], v0[1]); w.y = cvt_pk_bf16(v0[2], v0[3]); w.z = cvt_pk_bf16(v1[0], v1[1]); w.w = cvt_pk_bf16(v1[2], v1[3]);
          *(u32x4*)(rowp + bj * HALF) = w;
          if (odd) {
            const int rc = m * 16 + fr, c = col0 + bj * HALF;
            if (c < 3072 && (rc == 0 || rc >= 62)) { const int slot = rc == 0 ? 0 : rc - 61; *(u32x4*)(halo + ((size_t)(r >> 6) * 3 + slot) * 3072 + c) = w; }
          } else if (u.pn == 6 && r < M_P) {
            float* dst = (bj ? vout : kout) + ((size_t)(r >> 8) * 512 + (r & 255)) * 128 + wc * 32 + 8 * fq;
            *(f32x4*)dst = v0; *(f32x4*)(dst + 4) = v1;
          }
        }
      }
  }
};
struct EpiRes {
  static constexpr bool PERM = false;
  float* x; const float* ga_base; int rbase;
  DI void operator()(const f32x4 (&acc)[2][2][4][2], const Unit& u, int wr, int wc, int fr, int fq) const {
    const int row0 = rbase + u.pm * BM + wr * 64 + fr, col0 = u.pn * BM + wc * 32 + 4 * fq;
    const float* ga = ga_base + (size_t)row_group(rbase + u.pm * BM) * 6144;
    f32x4 gv[2][2];
#pragma unroll
    for (int bj = 0; bj < 2; ++bj)
#pragma unroll
      for (int n = 0; n < 2; ++n) gv[bj][n] = *(const f32x4*)(ga + col0 + bj * HALF + n * 16);
#pragma unroll
    for (int ai = 0; ai < 2; ++ai) {
      f32x4 xv[4][2][2];
#pragma unroll
      for (int m = 0; m < 4; ++m) { const float* rowp = x + (size_t)(row0 + ai * HALF + m * 16) * 1024 + col0;
#pragma unroll
        for (int bj = 0; bj < 2; ++bj)
#pragma unroll
          for (int n = 0; n < 2; ++n) xv[m][bj][n] = *(const f32x4*)(rowp + bj * HALF + n * 16); }
#pragma unroll
      for (int m = 0; m < 4; ++m) { float* rowp = x + (size_t)(row0 + ai * HALF + m * 16) * 1024 + col0;
#pragma unroll
        for (int bj = 0; bj < 2; ++bj)
#pragma unroll
          for (int n = 0; n < 2; ++n) *(f32x4*)(rowp + bj * HALF + n * 16) = xv[m][bj][n] + gv[bj][n] * acc[ai][bj][m][n]; }
    }
  }
};
struct EpiGU {
  static constexpr bool PERM = true;
  bf16_t* act;
  DI void operator()(const f32x4 (&acc)[2][2][4][2], const Unit& u, int wr, int wc, int fr, int fq) const {
    const int row0 = u.pm * BM + wr * 64 + fr, col0 = u.pn * HALF + wc * 32 + 8 * fq;
#pragma unroll
    for (int ai = 0; ai < 2; ++ai)
#pragma unroll
      for (int m = 0; m < 4; ++m) {
        bf16_t* rowp = act + (size_t)(row0 + ai * HALF + m * 16) * DFF + col0;
        float o[8];
#pragma unroll
        for (int n = 0; n < 2; ++n)
#pragma unroll
          for (int j = 0; j < 4; ++j) { const float gt = acc[ai][0][m][n][j], up = acc[ai][1][m][n][j]; o[n * 4 + j] = siluf_(gt) * up; }
        u32x4 w; w.x = cvt_pk_bf16(o[0], o[1]); w.y = cvt_pk_bf16(o[2], o[3]); w.z = cvt_pk_bf16(o[4], o[5]); w.w = cvt_pk_bf16(o[6], o[7]);
        *(u32x4*)rowp = w;
      }
  }
};
}

template <class Epi> DI void run_gemm(lptr lds, const bf16_t* A, const bf16_t* Bt, int N, int K, const Epi& E) {
  pg8::Gemm g; g.A = A; g.Bt = Bt; g.M = M_TOT; g.N = N; g.K = K;
  pg8::StaticOrder S; S.init(M_TOT, N, (int)gridDim.x, (int)bid_opaque());
  pg8::gemm_phase<Epi>(lds, g, S, E);
}
template <class Epi> DI void run_gemm_sub(lptr lds, const bf16_t* A, const bf16_t* Bt, int mrows, int N, int K, const Epi& E, int vb, int nb) {
  pg8::Gemm g; g.A = A; g.Bt = Bt; g.M = mrows; g.N = N; g.K = K;
  pg8::StaticOrder S; S.init(mrows, N, nb, vb);
  pg8::gemm_phase<Epi>(lds, g, S, E);
}
DI void norm_rows(const Params& p, int l, int mode, int row_lo, int row_hi, int vb, int nb) {
  const int tid = tid_opaque(), wid = tid >> 6, lane = tid & 63;
  const float* mod = (const float*)(p.ws + WS_MOD);
  bf16_t* h = (bf16_t*)(p.ws + WS_H);
  const float* gn = mode == 2 ? p.in[12] : (mode ? p.in[11] : p.in[10]) + l * 1024;
  const int rstride = nb * 8;
  f32x4 ggv[4];
#pragma unroll
  for (int i = 0; i < 4; ++i) ggv[i] = *(const f32x4*)(gn + lane * 4 + 256 * i);
  for (int row0 = row_lo + vb * 8 + wid; row0 < row_hi; row0 += 6 * rstride) {
    f32x4 v[6][4]; float ss[6];
#pragma unroll
    for (int q = 0; q < 6; ++q) {
      const int row = row0 + q * rstride < row_hi ? row0 + q * rstride : row0;
      const float* xs = p.out + (size_t)row * 1024;
#pragma unroll
      for (int i = 0; i < 4; ++i) v[q][i] = *(const f32x4*)(xs + lane * 4 + 256 * i);
    }
#pragma unroll
    for (int q = 0; q < 6; ++q) {
      float s = 0.f;
#pragma unroll
      for (int i = 0; i < 4; ++i) s += v[q][i][0] * v[q][i][0] + v[q][i][1] * v[q][i][1] + v[q][i][2] * v[q][i][2] + v[q][i][3] * v[q][i][3];
      ss[q] = wave_sum(s);
    }
#pragma unroll
    for (int q = 0; q < 6; ++q) {
      const int row = row0 + q * rstride;
      if (row < row_hi) {
        const float rstd = rsqrtf(ss[q] * (1.f / 1024.f) + 1e-6f);
        const float* md = mod + ((size_t)l * 9 + row_group(row)) * 6144 + (mode ? 3072 : 0);
#pragma unroll
        for (int i = 0; i < 4; ++i) {
          const int c = lane * 4 + 256 * i;
          const f32x4 gg = ggv[i];
          f32x4 y;
          if (mode == 2) {
#pragma unroll
            for (int j = 0; j < 4; ++j) y[j] = v[q][i][j] * rstd * gg[j];
            *(f32x4*)(p.out + (size_t)row * 1024 + c) = y;
          } else {
            const f32x4 sh = *(const f32x4*)(md + c), sc = *(const f32x4*)(md + 1024 + c);
#pragma unroll
            for (int j = 0; j < 4; ++j) y[j] = v[q][i][j] * rstd * gg[j] * (1.f + sc[j]) + sh[j];
            *(u32x2*)(h + (size_t)row * 1024 + c) = (u32x2){pack2(y[0], y[1]), pack2(y[2], y[3])};
          }
        }
      }
    }
  }
}

DI float gelu_tanh(float x) { const float u = 0.7978845608028654f * (x + 0.044715f * x * x * x); const float t = 1.f - 2.f * __builtin_amdgcn_rcpf(1.f + __expf(2.f * u)); return 0.5f * x * (1.f + t); }
DI void rg_phase(const Params& p, lptr lds, int l, int mode) {
  const int tid = tid_opaque(), wid = tid >> 6, lane = tid & 63;
  const int i2 = l >> 1, bid = bid_opaque(), G = gridDim.x;
  const int n = bid & 7;
  const bf16_t* P = (const bf16_t*)(p.ws + WS_P);
  bf16_t* Y = (bf16_t*)(p.ws + WS_H);
  float* carry = (float*)(p.ws + WS_CARRY);
  constexpr int SUB = 74752;
  LAS float* Pf = (LAS float*)(lds + 2 * SUB);
  const int ct = tid >> 3, c8 = (tid & 7) * 8, chc = n * 64 + c8;
  LAS float* cwl = (LAS float*)(lds + 2 * SUB + 8192);
  if (tid < 320) { const int j = tid >> 6, c = tid & 63; cwl[tid] = j < 4 ? p.in[14][((size_t)i2 * 4 + j) * 512 + n * 64 + c] : p.in[15][i2 * 512 + n * 64 + c]; }
  __syncthreads();
  const int gdir = wid >> 2, gdt = (wid >> 1) & 1, gt2 = wid & 1, r = lane & 31, hh = lane >> 5;
  bf16x8 wa[4], wx[4];
  {
    const bf16_t* rgw = (const bf16_t*)(p.ws + WS_RGW);
    const bf16_t* wap = rgw + ((size_t)(gdir * 2 + 0) * 8 + n) * 4096 + (gdt * 32 + r) * 64 + 8 * hh;
    const bf16_t* wxp = rgw + ((size_t)(gdir * 2 + 1) * 8 + n) * 4096 + (gdt * 32 + r) * 64 + 8 * hh;
#pragma unroll
    for (int s = 0; s < 4; ++s) { wa[s] = *(const bf16x8*)(wap + 16 * s); wx[s] = *(const bf16x8*)(wxp + 16 * s); }
  }
  const int gd = gdt * 32 + r, gpi = (i2 * 2 + gdir) * 512 + n * 64 + gd;
  const float ba = p.in[17][gpi], bx = p.in[19][gpi], sp8 = -8.f * softplusf_(-p.in[20][gpi]);
  u32x4 praw[2][4], pgr[2];
  pgr[0] = pgr[1] = (u32x4){0u, 0u, 0u, 0u};
#define RG_PREFETCH(s_, item_) do { const int tt_ = (item_) >> 3; const int row0_ = tt_ * 64; \
    const int ti_ = tt_ < 64 ? (tt_ & 3) : ((tt_ - 64) & 63); const int nt_ = tt_ < 64 ? 4 : 64; \
    _Pragma("unroll") for (int j_ = 0; j_ < 4; ++j_) { const int tl_ = ti_ * 64 + ct + j_ - 2; const bool ok_ = tl_ >= 0 && tl_ < nt_ * 64; \
      const u32x4 v_ = *(const u32x4*)(P + (size_t)(row0_ + (ok_ ? ct + j_ - 2 : ct)) * EVEN_IN + chc); praw[s_][j_] = ok_ ? v_ : (u32x4){0u, 0u, 0u, 0u}; } \
    if (mode == 1) pgr[s_] = *(const u32x4*)(P + (size_t)(row0_ + ct) * EVEN_IN + 512 + chc); } while (0)
  if (bid < 4608) RG_PREFETCH(0, bid);
  if (bid + G < 4608) RG_PREFETCH(1, bid + G);
  for (int item0 = bid; item0 < 4608; item0 += 2 * G) {
    const int nsub = item0 + G < 4608 ? 2 : 1;
    u32x4 gr_cur[2];
#pragma unroll
    for (int s = 0; s < 2; ++s) {
      if (s < nsub) {
        const int tt = (item0 + s * G) >> 3;
        const int ti = tt < 64 ? (tt & 3) : ((tt - 64) & 63), ntile = tt < 64 ? 4 : 64;
        LAS bf16_t* Xc = (LAS bf16_t*)(lds + s * SUB);
        float ca[16], cbv[16];
        if (mode == 1) {
          const int q4 = tid >> 7, dir = (tid >> 6) & 1, d = tid & 63, ch = n * 64 + d, tbase = tt - ti;
#pragma unroll
          for (int jj = 0; jj < 16; ++jj) {
            const int j = dir ? (16 * q4 + 15 - jj) : (16 * q4 + jj);
            const bool valid = dir ? (j > ti && j < ntile) : (j < ti);
            const int jc = valid ? j : ti;
            const size_t o = ((size_t)((tbase + jc) * 2 + dir) * 2) * 512 + ch;
            const float va = carry[o], vb = carry[o + 512];
            ca[jj] = valid ? va : 1.f; cbv[jj] = valid ? vb : 0.f;
          }
        }
        {
          const f32x4 b0 = *(const LAS f32x4*)(cwl + 256 + c8), b1 = *(const LAS f32x4*)(cwl + 256 + c8 + 4);
          float a[8] = {b0[0], b0[1], b0[2], b0[3], b1[0], b1[1], b1[2], b1[3]};
#pragma unroll
          for (int j = 0; j < 4; ++j) {
            const u32x4 raw = praw[s][j];
            const f32x4 w0 = *(const LAS f32x4*)(cwl + j * 64 + c8), w1 = *(const LAS f32x4*)(cwl + j * 64 + c8 + 4);
            a[0] += w0[0] * lo2f(raw.x); a[1] += w0[1] * hi2f(raw.x); a[2] += w0[2] * lo2f(raw.y); a[3] += w0[3] * hi2f(raw.y);
            a[4] += w1[0] * lo2f(raw.z); a[5] += w1[1] * hi2f(raw.z); a[6] += w1[2] * lo2f(raw.w); a[7] += w1[3] * hi2f(raw.w);
          }
          *(LAS u32x4*)(Xc + ct * 72 + c8) = (u32x4){pack2(a[0], a[1]), pack2(a[2], a[3]), pack2(a[4], a[5]), pack2(a[6], a[7])};
        }
        gr_cur[s] = pgr[s];
        if (mode == 1) {
          const int q4 = tid >> 7, dir = (tid >> 6) & 1, d = tid & 63;
          float A = 1.f, B = 0.f;
#pragma unroll
          for (int jj = 0; jj < 16; ++jj) { B = ca[jj] * B + cbv[jj]; A = ca[jj] * A; }
          Pf[s * 1024 + (q4 * 2 + dir) * 64 + d] = A; Pf[s * 1024 + 512 + (q4 * 2 + dir) * 64 + d] = B;
        }
      }
      __builtin_amdgcn_sched_barrier(0);
    }
    __syncthreads();
#pragma unroll 1
    for (int s = 0; s < 2; ++s) {
      if (s < nsub) {
        LAS bf16_t* Xc = (LAS bf16_t*)(lds + s * SUB);
        LAS float* Aa = (LAS float*)(lds + s * SUB + 9216); LAS float* Bb = (LAS float*)(lds + s * SUB + 41984);
        f32x16 ga = zero16(), gx = zero16();
#pragma unroll
        for (int ks = 0; ks < 4; ++ks) {
          const bf16x8 a = *(const LAS bf16x8*)(Xc + (gt2 * 32 + r) * 72 + 16 * ks + 8 * hh);
          ga = MFMA32(a, wa[ks], ga); gx = MFMA32(a, wx[ks], gx);
        }
#pragma unroll
        for (int ii = 0; ii < 16; ++ii) {
          const int t = gt2 * 32 + crow(ii, hh);
          const float rr = sigmoidf_(ga[ii] + ba), iv = sigmoidf_(gx[ii] + bx);
          const float la = rr * sp8, a = __expf(la), x2 = 2.f * la;
          const float om = x2 > -0.25f ? -x2 * (1.f + x2 * (0.5f + x2 * (0.16666667f + x2 * (0.041666668f + x2 * 0.0083333338f)))) : 1.f - __expf(x2);
          const float bb = __builtin_amdgcn_sqrtf(fmaxf(om, 0.f)) * (iv * bf2f(Xc[t * 72 + gd]));
          Aa[(gdir * 64 + t) * 64 + gd] = a; Bb[(gdir * 64 + t) * 64 + gd] = bb;
        }
      }
    }
    __syncthreads();
    if (item0 + 2 * G < 4608) RG_PREFETCH(0, item0 + 2 * G);
    if (item0 + 3 * G < 4608) RG_PREFETCH(1, item0 + 3 * G);
    if (tid < 128 * nsub) {
      const int s = tid >> 7, dir = (tid >> 6) & 1, d = tid & 63, ch = n * 64 + d;
      const int tt = (item0 + s * G) >> 3;
      const int ti = tt < 64 ? (tt & 3) : ((tt - 64) & 63), ntile = tt < 64 ? 4 : 64;
      const int seq = tt < 64 ? (tt >> 2) : 16 + ((tt - 64) >> 6);
      LAS float* Aa = (LAS float*)(lds + s * SUB + 9216); LAS float* Bb = (LAS float*)(lds + s * SUB + 41984);
      if (mode == 0) {
        float A = 1.f, B = 0.f;
#pragma unroll 8
        for (int st = 0; st < 64; ++st) { const int t = dir ? 63 - st : st; const float a = Aa[(dir * 64 + t) * 64 + d], b = Bb[(dir * 64 + t) * 64 + d]; A *= a; B = a * B + b; }
        carry[((size_t)(tt * 2 + dir) * 2 + 0) * 512 + ch] = A; carry[((size_t)(tt * 2 + dir) * 2 + 1) * 512 + ch] = B;
      } else {
        float h = (tt < 64) ? 0.f : p.in[5][(((size_t)(seq - 16) * 2 + i2) * 2 + dir) * 512 + ch];
#pragma unroll
        for (int qq = 0; qq < 4; ++qq) { const int q4 = dir ? 3 - qq : qq; h = Pf[s * 1024 + (q4 * 2 + dir) * 64 + d] * h + Pf[s * 1024 + 512 + (q4 * 2 + dir) * 64 + d]; }
#pragma unroll 8
        for (int st = 0; st < 64; ++st) { const int t = dir ? 63 - st : st; h = Aa[(dir * 64 + t) * 64 + d] * h + Bb[(dir * 64 + t) * 64 + d]; Aa[(dir * 64 + t) * 64 + d] = h; }
        if (tt < 64 && ((dir == 0 && ti == ntile - 1) || (dir == 1 && ti == 0))) p.out[OFF_RG + (((size_t)seq * 2 + i2) * 2 + dir) * 512 + ch] = h;
      }
    }
    if (mode == 1) {
      __syncthreads();
#pragma unroll
      for (int s = 0; s < 2; ++s) {
        if (s < nsub) {
          const int row0 = ((item0 + s * G) >> 3) * 64;
          const LAS float* Hf = (const LAS float*)(lds + s * SUB + 9216); const LAS float* Hb = Hf + 4096;
          const u32x4 raw = gr_cur[s];
          float gr[8] = {lo2f(raw.x), hi2f(raw.x), lo2f(raw.y), hi2f(raw.y), lo2f(raw.z), hi2f(raw.z), lo2f(raw.w), hi2f(raw.w)};
          float y[8];
#pragma unroll
          for (int e = 0; e < 8; ++e) y[e] = (Hf[ct * 64 + c8 + e] + Hb[ct * 64 + c8 + e]) * gelu_tanh(gr[e]);
          *(u32x4*)(Y + (size_t)(row0 + ct) * 1024 + n * 64 + c8) = (u32x4){pack2(y[0], y[1]), pack2(y[2], y[3]), pack2(y[4], y[5]), pack2(y[6], y[7])};
        }
      }
    }
    __syncthreads();
  }
#undef RG_PREFETCH
}

DI void att_item(const Params& p, lptr lds, int l, int item) {
  const int tid = tid_opaque(), wid = tid >> 6, lane = tid & 63, q = lane & 31, hh = lane >> 5;
  const int i2 = l >> 1;
  const bool samp = item < 1024;
  int b, kvh, qt, rowbase;
  if (samp) { b = item >> 7; kvh = (item >> 6) & 1; qt = item & 63; rowbase = M_P + b * 4096; }
  else { const int j = item - 1024; b = j >> 3; kvh = (j >> 2) & 1; qt = j & 3; rowbase = b * 256; }
  const bf16_t* P = (const bf16_t*)(p.ws + WS_P);
  bf16_t* Y = (bf16_t*)(p.ws + WS_H);
  const float* rc = (const float*)(p.ws + WS_ROPE); const float* rs = rc + 4096 * 32;
  LAS bf16_t* Ks = (LAS bf16_t*)lds; LAS bf16_t* Vt = (LAS bf16_t*)(lds + 9216);
  const int head = kvh * 4 + (wid >> 1);
  const int qpos = qt * 64 + 32 * (wid & 1) + q;
  bf16x8 Qf[4];
  {
    const bf16_t* qp = P + (size_t)(rowbase + qpos) * EVEN_IN + 1024 + head * 64 + 8 * hh;
    float qv[4][8];
#pragma unroll
    for (int s = 0; s < 4; ++s) { const u32x4 raw = *(const u32x4*)(qp + 16 * s);
      qv[s][0] = lo2f(raw.x); qv[s][1] = hi2f(raw.x); qv[s][2] = lo2f(raw.y); qv[s][3] = hi2f(raw.y); qv[s][4] = lo2f(raw.z); qv[s][5] = hi2f(raw.z); qv[s][6] = lo2f(raw.w); qv[s][7] = hi2f(raw.w); }
    if (samp) {
#pragma unroll
      for (int pr = 0; pr < 2; ++pr)
#pragma unroll
        for (int j = 0; j < 8; ++j) { const int f = 16 * pr + 8 * hh + j; const float c = rc[qpos * 32 + f], sn = rs[qpos * 32 + f];
          const float x1 = qv[2 * pr][j], x2 = qv[2 * pr + 1][j]; qv[2 * pr][j] = x1 * c - x2 * sn; qv[2 * pr + 1][j] = x1 * sn + x2 * c; }
    }
#pragma unroll
    for (int s = 0; s < 4; ++s) { const float qs = 0.125f * 1.44269504088896341f;
      u32x4 w; w.x = pack2(qv[s][0] * qs, qv[s][1] * qs); w.y = pack2(qv[s][2] * qs, qv[s][3] * qs); w.z = pack2(qv[s][4] * qs, qv[s][5] * qs); w.w = pack2(qv[s][6] * qs, qv[s][7] * qs); Qf[s] = __builtin_bit_cast(bf16x8, w); }
  }
  float m_run = p.in[21][i2 * 8 + head] * 1.44269504088896341f, l_run = hh == 0 ? 1.f : 0.f;
  f32x16 o0 = zero16(), o1 = zero16();
  const int nctx = samp ? 8 : 0;
  int w0, w1; if (samp) { w0 = qt - 2 < 0 ? 0 : qt - 2; w1 = qt + 2 > 63 ? 63 : qt + 2; } else { w0 = 0; w1 = 3; }
  const int ntiles = nctx + (w1 - w0 + 1);
  const bool isK = tid < 256;
  const int skey = (tid & 255) >> 2, spc = tid & 3;
  const int sd0 = isK ? (spc & 1) * 8 + (spc >> 1) * 32 : spc * 16;
  const int so1 = isK ? 16 : 8;
  f32x4 pc4[4]; u32x4 pw2[2]; f32x4 prc[4];
#define ATT_PREFETCH(kt_) do { const bool ctx_ = (kt_) < nctx; const int wt_ = w0 + ((kt_) - nctx); \
    if (ctx_) { const float* sp_ = (isK ? p.in[3] : p.in[4]) + (((size_t)(b * 2 + i2) * 512 + (kt_) * 64 + skey) * 2 + kvh) * 64 + sd0; \
      pc4[0] = *(const f32x4*)sp_; pc4[1] = *(const f32x4*)(sp_ + 4); pc4[2] = *(const f32x4*)(sp_ + so1); pc4[3] = *(const f32x4*)(sp_ + so1 + 4); } \
    else { const bf16_t* sp_ = P + (size_t)(rowbase + wt_ * 64 + skey) * EVEN_IN + (isK ? 1536 : 1664) + kvh * 64 + sd0; \
      pw2[0] = *(const u32x4*)sp_; pw2[1] = *(const u32x4*)(sp_ + so1); \
      if (samp && isK) { const int kpos_ = wt_ * 64 + skey, fb_ = (sd0 & 8) + (sd0 >= 32 ? 16 : 0); \
        prc[0] = *(const f32x4*)(rc + kpos_ * 32 + fb_); prc[1] = *(const f32x4*)(rc + kpos_ * 32 + fb_ + 4); \
        prc[2] = *(const f32x4*)(rs + kpos_ * 32 + fb_); prc[3] = *(const f32x4*)(rs + kpos_ * 32 + fb_ + 4); } } } while (0)
  ATT_PREFETCH(0);
  for (int kt = 0; kt < ntiles; ++kt) {
    const bool ctx = kt < nctx; const int wt = w0 + (kt - nctx);
    __syncthreads();
    {
      float x1[8], x2[8];
      if (ctx) {
#pragma unroll
        for (int e = 0; e < 4; ++e) { x1[e] = pc4[0][e]; x1[4 + e] = pc4[1][e]; x2[e] = pc4[2][e]; x2[4 + e] = pc4[3][e]; }
      } else {
        const u32x4 r1 = pw2[0], r2 = pw2[1];
        x1[0] = lo2f(r1.x); x1[1] = hi2f(r1.x); x1[2] = lo2f(r1.y); x1[3] = hi2f(r1.y); x1[4] = lo2f(r1.z); x1[5] = hi2f(r1.z); x1[6] = lo2f(r1.w); x1[7] = hi2f(r1.w);
        x2[0] = lo2f(r2.x); x2[1] = hi2f(r2.x); x2[2] = lo2f(r2.y); x2[3] = hi2f(r2.y); x2[4] = lo2f(r2.z); x2[5] = hi2f(r2.z); x2[6] = lo2f(r2.w); x2[7] = hi2f(r2.w);
        if (samp && isK) {
#pragma unroll
          for (int j = 0; j < 8; ++j) { const float c = prc[j >> 2][j & 3], sn = prc[2 + (j >> 2)][j & 3]; const float a = x1[j], bb = x2[j]; x1[j] = a * c - bb * sn; x2[j] = a * sn + bb * c; }
        }
      }
      if (isK) {
        *(LAS u32x4*)(Ks + skey * 72 + sd0) = (u32x4){pack2(x1[0], x1[1]), pack2(x1[2], x1[3]), pack2(x1[4], x1[5]), pack2(x1[6], x1[7])};
        *(LAS u32x4*)(Ks + skey * 72 + sd0 + 16) = (u32x4){pack2(x2[0], x2[1]), pack2(x2[2], x2[3]), pack2(x2[4], x2[5]), pack2(x2[6], x2[7])};
      } else {
#pragma unroll
        for (int e = 0; e < 8; ++e) { Vt[(sd0 + e) * 72 + skey] = f2bf(x1[e]); Vt[(sd0 + 8 + e) * 72 + skey] = f2bf(x2[e]); }
      }
    }
    __syncthreads();
    if (kt + 1 < ntiles) ATT_PREFETCH(kt + 1);
#pragma unroll
    for (int ks = 0; ks < 2; ++ks) {
      f32x16 sacc = zero16();
#pragma unroll
      for (int s = 0; s < 4; ++s) { const bf16x8 a = *(const LAS bf16x8*)(Ks + (32 * ks + q) * 72 + 16 * s + 8 * hh); sacc = MFMA32(a, Qf[s], sacc); }
      if (!ctx && samp) {
        const int kbase = wt * 64 + 32 * ks;
#pragma unroll
        for (int ii = 0; ii < 16; ++ii) { const int dl = qpos - (kbase + crow(ii, hh)); if (dl > 128 || dl < -128) sacc[ii] = -1e30f; }
      }
      float mx = sacc[0];
#pragma unroll
      for (int ii = 1; ii < 16; ++ii) mx = fmaxf(mx, sacc[ii]);
      mx = fmaxf(mx, __shfl_xor(mx, 32));
      if (__any(mx > m_run)) {
        const float m_new = fmaxf(m_run, mx), alpha = __builtin_amdgcn_exp2f(m_run - m_new); m_run = m_new;
        l_run *= alpha;
#pragma unroll
        for (int ii = 0; ii < 16; ++ii) { o0[ii] *= alpha; o1[ii] *= alpha; }
      }
      float pv[16], ps = 0.f;
#pragma unroll
      for (int ii = 0; ii < 16; ++ii) { pv[ii] = __builtin_amdgcn_exp2f(sacc[ii] - m_run); ps += pv[ii]; }
      l_run += ps;
#pragma unroll
      for (int s2 = 0; s2 < 2; ++s2) {
        u32x4 pw; pw.x = pack2(pv[8 * s2], pv[8 * s2 + 1]); pw.y = pack2(pv[8 * s2 + 2], pv[8 * s2 + 3]); pw.z = pack2(pv[8 * s2 + 4], pv[8 * s2 + 5]); pw.w = pack2(pv[8 * s2 + 6], pv[8 * s2 + 7]);
        const bf16x8 bfrag = __builtin_bit_cast(bf16x8, pw);
        {
          const LAS bf16_t* vp = Vt + q * 72 + 32 * ks + 16 * s2 + 4 * hh;
          const u32x2 lo = *(const LAS u32x2*)vp, hi = *(const LAS u32x2*)(vp + 8);
          o0 = MFMA32(__builtin_bit_cast(bf16x8, ((u32x4){lo.x, lo.y, hi.x, hi.y})), bfrag, o0);
        }
        {
          const LAS bf16_t* vp = Vt + (32 + q) * 72 + 32 * ks + 16 * s2 + 4 * hh;
          const u32x2 lo = *(const LAS u32x2*)vp, hi = *(const LAS u32x2*)(vp + 8);
          o1 = MFMA32(__builtin_bit_cast(bf16x8, ((u32x4){lo.x, lo.y, hi.x, hi.y})), bfrag, o1);
        }
      }
    }
  }
#undef ATT_PREFETCH
  const float inv = 1.f / (l_run + __shfl_xor(l_run, 32));
  bf16_t* yp = Y + (size_t)(rowbase + qpos) * 1024 + 512 + head * 64;
#pragma unroll
  for (int g = 0; g < 4; ++g) {
    *(u32x2*)(yp + 8 * g + 4 * hh) = (u32x2){pack2(o0[4 * g] * inv, o0[4 * g + 1] * inv), pack2(o0[4 * g + 2] * inv, o0[4 * g + 3] * inv)};
    *(u32x2*)(yp + 32 + 8 * g + 4 * hh) = (u32x2){pack2(o1[4 * g] * inv, o1[4 * g + 1] * inv), pack2(o1[4 * g + 2] * inv, o1[4 * g + 3] * inv)};
  }
  __syncthreads();
}

DI float wave_incl_scan(float v, int lane) {
#pragma unroll
  for (int o = 1; o < 64; o <<= 1) { const float t = __shfl_up(v, o); if (lane >= o) v += t; }
  return v;
}
DI void dn1_phase(const Params& p, lptr lds, int l) {
  const int tid = tid_opaque(), wid = tid >> 6, lane = tid & 63;
  const int i2 = l >> 1, bid = bid_opaque(), G = gridDim.x, hd = bid & 7;
  bf16_t* P = (bf16_t*)(p.ws + WS_P);
  const bf16_t* halo = (const bf16_t*)(p.ws + WS_HALO);
  const float* ab = (const float*)(p.ws + WS_AB);
  LAS bf16_t* Raw = (LAS bf16_t*)lds;
  LAS float* X = (LAS float*)lds;
  LAS bf16_t* Kn = (LAS bf16_t*)(lds + 51456);
  LAS float* KK = (LAS float*)(lds + 68864);
  LAS float* Lm = (LAS float*)(lds + 85248);
  LAS float* gcs = (LAS float*)(lds + 118016);
  LAS float* bts = (LAS float*)(lds + 118528);
  const float alog0 = -__expf(p.in[25][(i2 * 2 + (wid & 1)) * 8 + hd]), dtb0 = p.in[26][(i2 * 2 + (wid & 1)) * 8 + hd];
  LAS float* cwl = (LAS float*)(lds + 131072);
  for (int e = tid; e < 1536; e += 512) { const int part = e >> 9, j = (e >> 7) & 3, c = e & 127; cwl[e] = p.in[24][((size_t)i2 * 4 + j) * 3072 + part * 1024 + hd * 128 + c]; }
  __syncthreads();
  u32x4 rv[7]; float pa0 = 0.f, pa1 = 0.f;
#define DN1_PREFETCH(item_) do { const int ck_ = (item_) >> 3; const int row0_ = ck_ * 64; \
    const int ci_ = ck_ < 64 ? (ck_ & 3) : ((ck_ - 64) & 63); const int nch_ = ck_ < 64 ? 4 : 64; \
    _Pragma("unroll") for (int k_ = 0; k_ < 7; ++k_) { \
      int e_ = tid + 512 * k_; if (e_ > 3215) e_ = 3215; \
      const int part_ = e_ / 1072, rem_ = e_ % 1072, rr_ = rem_ >> 4, pc_ = rem_ & 15, col_ = part_ * 1024 + hd * 128 + pc_ * 8; \
      const bool mid_ = rr_ >= 2 && rr_ < 66; \
      const bool zero_ = (rr_ < 2 && ci_ == 0) || (rr_ >= 66 && ci_ == nch_ - 1); \
      const bf16_t* srcp_ = mid_ ? P + (size_t)(row0_ + rr_ - 2) * ODD_LD + col_ \
                               : (rr_ < 2 ? halo + ((size_t)(ck_ - 1) * 3 + 1 + rr_) * 3072 + col_ : halo + ((size_t)(ck_ + 1) * 3) * 3072 + col_); \
      if (zero_) srcp_ = P + (size_t)row0_ * ODD_LD + col_; \
      u32x4 v_ = *(const u32x4*)srcp_; \
      if (zero_) v_ = (u32x4){0u, 0u, 0u, 0u}; \
      rv[k_] = v_; } \
    if (wid < 2) { const int t_ = wid ? 63 - lane : lane; pa0 = ab[(size_t)(row0_ + t_) * 32 + wid * 8 + hd]; pa1 = ab[(size_t)(row0_ + t_) * 32 + 16 + wid * 8 + hd]; } } while (0)
  if (bid < 4608) DN1_PREFETCH(bid);
  for (int item = bid; item < 4608; item += G) {
  const int ck = item >> 3;
  const int row0 = ck * 64;
  {
#pragma unroll
    for (int k = 0; k < 7; ++k) {
      int e = tid + 512 * k; if (e > 3215) e = 3215;
      const int part = e / 1072, rem = e % 1072, rr = rem >> 4, pc = rem & 15;
      *(LAS u32x4*)(Raw + (part * 67 + rr) * 128 + pc * 8) = rv[k];
    }
  }
  const float a0 = pa0, a1 = pa1;
  __syncthreads();
  if (item + G < 4608) DN1_PREFETCH(item + G);
#pragma unroll 2
  for (int tk = 0; tk < 6; ++tk) {
    const int task = tid + 512 * tk;
    const int c8i = task & 15, rp = task >> 4, part = tk >> 1, t = rp & 63, col = part * 1024 + hd * 128 + c8i * 8;
    float y[8];
#pragma unroll
    for (int e = 0; e < 8; ++e) y[e] = 0.f;
#pragma unroll
    for (int j = 0; j < 4; ++j) {
      const u32x4 raw = *(const LAS u32x4*)(Raw + (part * 67 + t + j) * 128 + c8i * 8);
      const f32x4 cw0 = *(const LAS f32x4*)(cwl + (part * 4 + j) * 128 + c8i * 8), cw1 = *(const LAS f32x4*)(cwl + (part * 4 + j) * 128 + c8i * 8 + 4);
      y[0] += cw0[0] * lo2f(raw.x); y[1] += cw0[1] * hi2f(raw.x); y[2] += cw0[2] * lo2f(raw.y); y[3] += cw0[3] * hi2f(raw.y);
      y[4] += cw1[0] * lo2f(raw.z); y[5] += cw1[1] * hi2f(raw.z); y[6] += cw1[2] * lo2f(raw.w); y[7] += cw1[3] * hi2f(raw.w);
    }
    float ss = 0.f;
#pragma unroll
    for (int e = 0; e < 8; ++e) { y[e] = siluf_(y[e]); ss += y[e] * y[e]; }
    if (part < 2) {
      ss += __shfl_xor(ss, 1); ss += __shfl_xor(ss, 2); ss += __shfl_xor(ss, 4); ss += __shfl_xor(ss, 8);
      const float sc = rsqrtf(ss + 1e-6f) * (part == 0 ? 0.08838834764831845f : 1.f);
#pragma unroll
      for (int e = 0; e < 8; ++e) y[e] *= sc;
    }
    const u32x4 w = (u32x4){pack2(y[0], y[1]), pack2(y[2], y[3]), pack2(y[4], y[5]), pack2(y[6], y[7])};
    *(u32x4*)(P + (size_t)(row0 + t) * ODD_LD + col) = w;
    if (part == 1) *(LAS u32x4*)(Kn + t * 136 + c8i * 8) = w;
  }
  if (wid < 2) {
    const int dir = wid;
    const float g = alog0 * softplusf_(a0 + dtb0);
    const float gcv = wave_incl_scan(g, lane), btv = sigmoidf_(a1);
    gcs[dir * 64 + lane] = gcv; bts[dir * 64 + lane] = btv;
    float* gcb = (float*)(p.ws + WS_CARRY) + ((size_t)(ck * 8 + hd) * 2 + dir) * 128;
    gcb[lane] = gcv; gcb[64 + lane] = btv;
  }
  __syncthreads();
  if (wid < 4) {
    const int it = wid >> 1, jt = wid & 1, hh = lane >> 5;
    const f32x16 acc = mm32(Kn + it * 32 * 136, 136, Kn + jt * 32 * 136, 136, 128, zero16(), lane);
#pragma unroll
    for (int ii = 0; ii < 16; ++ii) KK[(it * 32 + crow(ii, hh)) * 64 + jt * 32 + (lane & 31)] = acc[ii];
  }
  __syncthreads();
  for (int e = tid; e < 8192; e += 512) {
    const int dir = e >> 12, ip = (e >> 6) & 63, jp = e & 63;
    const int ti = dir ? 63 - ip : ip, tj = dir ? 63 - jp : jp;
    const float w = bts[dir * 64 + ip] * KK[ti * 64 + tj] * __expf(fminf(gcs[dir * 64 + ip] - gcs[dir * 64 + jp], 0.f));
    Lm[e] = (ip > jp) ? w : 0.f;
  }
  __syncthreads();
  for (int e = tid; e < 8192; e += 512) X[e] = 0.f;
  __syncthreads();
  {
    const int d = wid >> 2, bi = wid & 3;
    if (lane < 16) {
      const int c = lane; float x[16];
      const LAS float* L = Lm + d * 4096 + (16 * bi) * 64 + 16 * bi;
#pragma unroll
      for (int i = 0; i < 16; ++i) {
        float s = (c == i) ? 1.f : 0.f;
#pragma unroll
        for (int j = 0; j < i; ++j) s -= L[i * 64 + j] * x[j];
        x[i] = s;
      }
#pragma unroll
      for (int i = 0; i < 16; ++i) X[d * 4096 + (16 * bi + i) * 64 + 16 * bi + c] = x[i];
    }
  }
  __syncthreads();
  LAS float* Tm = (LAS float*)(lds + 119040) + wid * 256;
  for (int dd = 1; dd < 4; ++dd) {
    const int nb = 4 - dd; const bool act = wid < 2 * nb;
    const int d = act ? wid / nb : 0, bi = act ? dd + wid % nb : dd, bj = bi - dd;
    const int lr = lane & 15, lq = lane >> 4;
    if (act) {
      f32x4 acc = (f32x4){0.f, 0.f, 0.f, 0.f};
      for (int kb = bj; kb < bi; ++kb) {
#pragma unroll
        for (int kk = 0; kk < 4; ++kk) {
          const float a = Lm[d * 4096 + (16 * bi + lr) * 64 + 16 * kb + 4 * kk + lq];
          const float b = X[d * 4096 + (16 * kb + 4 * kk + lq) * 64 + 16 * bj + lr];
          acc = __builtin_amdgcn_mfma_f32_16x16x4f32(a, b, acc, 0, 0, 0);
        }
      }
#pragma unroll
      for (int rg = 0; rg < 4; ++rg) Tm[(lq * 4 + rg) * 16 + lr] = acc[rg];
    }
    __syncthreads();
    if (act) {
      f32x4 acc = (f32x4){0.f, 0.f, 0.f, 0.f};
#pragma unroll
      for (int kk = 0; kk < 4; ++kk) {
        const float a = X[d * 4096 + (16 * bi + lr) * 64 + 16 * bi + 4 * kk + lq];
        const float b = Tm[(4 * kk + lq) * 16 + lr];
        acc = __builtin_amdgcn_mfma_f32_16x16x4f32(a, b, acc, 0, 0, 0);
      }
#pragma unroll
      for (int rg = 0; rg < 4; ++rg) X[d * 4096 + (16 * bi + lq * 4 + rg) * 64 + 16 * bj + lr] = -acc[rg];
    }
    __syncthreads();
  }
  {
    bf16_t* Tg = (bf16_t*)(p.ws + WS_T) + ((size_t)(ck * 8 + hd) * 2) * 4096;
    for (int e = tid; e < 4096; e += 512) *(unsigned*)(Tg + 2 * e) = pack2(X[2 * e], X[2 * e + 1]);
  }
  __syncthreads();
  }
#undef DN1_PREFETCH
}

constexpr int DN2_DIR_BYTES = 80896;
DI void dn2_item(const Params& p, lptr lds, int l, int item) {
  const int tid = tid_opaque(), wid = tid >> 6, lane = tid & 63, r = lane & 31, hh = lane >> 5;
  const int i2 = l >> 1;
  const bool samp = item < 256;
  int b, hd, slab, nch, seqrow, ckb;
  if (samp) { b = item >> 5; hd = (item >> 2) & 7; slab = item & 3; nch = 64; seqrow = M_P + b * 4096; ckb = 64 + b * 64; }
  else { const int j = item - 256; b = j >> 5; hd = (j >> 2) & 7; slab = j & 3; nch = 4; seqrow = b * 256; ckb = b * 4; }
  const int dir = wid >> 2, w4 = wid & 3, td = tid & 255;
  const bf16_t* P = (const bf16_t*)(p.ws + WS_P);
  const bf16_t* Tg = (const bf16_t*)(p.ws + WS_T);
  const float* gcbase = (const float*)(p.ws + WS_CARRY);
  bf16_t* O = (bf16_t*)(p.ws + WS_H);
  lptr base = lds + dir * DN2_DIR_BYTES;
  LAS bf16_t* Qn = (LAS bf16_t*)base;
  LAS bf16_t* Kn = (LAS bf16_t*)(base + 17408);
  LAS bf16_t* Tm = (LAS bf16_t*)(base + 34816);
  LAS bf16_t* QK = (LAS bf16_t*)(base + 44032);
  LAS bf16_t* St = (LAS bf16_t*)(base + 53248);
  LAS bf16_t* Rt = (LAS bf16_t*)(base + 61952);
  LAS bf16_t* Vt = (LAS bf16_t*)(base + 66560);
  LAS bf16_t* Vn = (LAS bf16_t*)(base + 71168);
  LAS bf16_t* Vd = (LAS bf16_t*)(base + 75776);
  LAS float* gcs = (LAS float*)(base + 80384);
  LAS float* bts = gcs + 64;
  LAS float* egs = (LAS float*)(lds + 2 * DN2_DIR_BYTES) + dir * 128;
  LAS float* dds = egs + 64;
  f32x16 S;
  const size_t sidx = ((((size_t)(b * 2 + i2) * 2 + dir) * 8 + hd) * 128 + 32 * w4) * 128 + slab * 32 + r;
#pragma unroll
  for (int ii = 0; ii < 16; ++ii) S[ii] = samp ? p.in[6][sidx + (size_t)crow(ii, hh) * 128] : 0.f;
#pragma unroll
  for (int g = 0; g < 4; ++g) *(LAS u32x2*)(St + r * 136 + 32 * w4 + 8 * g + 4 * hh) = (u32x2){pack2(S[4 * g], S[4 * g + 1]), pack2(S[4 * g + 2], S[4 * g + 3])};
  u32x4 pq[4], pk[4], pt[2], pv; float pa0 = 0.f, pa1 = 0.f;
#define DN2_PREFETCH(sn) do { const int cn_ = dir ? nch - 1 - (sn) : (sn); const size_t r0_ = (size_t)seqrow + (size_t)cn_ * 64; \
    _Pragma("unroll") for (int k_ = 0; k_ < 4; ++k_) { const int e_ = td + 256 * k_, ip_ = e_ >> 4, pc_ = e_ & 15; const size_t rg_ = r0_ + (dir ? 63 - ip_ : ip_); \
      pq[k_] = *(const u32x4*)(P + rg_ * ODD_LD + hd * 128 + pc_ * 8); pk[k_] = *(const u32x4*)(P + rg_ * ODD_LD + 1024 + hd * 128 + pc_ * 8); } \
    _Pragma("unroll") for (int k_ = 0; k_ < 2; ++k_) { const int e_ = td + 256 * k_; pt[k_] = *(const u32x4*)(Tg + ((size_t)((ckb + cn_) * 8 + hd) * 2 + dir) * 4096 + e_ * 8); } \
    { const int ip_ = td >> 2, pc_ = td & 3; const size_t rg_ = r0_ + (dir ? 63 - ip_ : ip_); pv = *(const u32x4*)(P + rg_ * ODD_LD + 2048 + hd * 128 + slab * 32 + pc_ * 8); } \
    if (w4 == 0) { const float* gcb_ = gcbase + ((size_t)((ckb + cn_) * 8 + hd) * 2 + dir) * 128; pa0 = gcb_[lane]; pa1 = gcb_[64 + lane]; } } while (0)
  DN2_PREFETCH(0);
  f32x16 o1 = zero16();
  for (int s = 0; s < nch; ++s) {
    const int c = dir ? nch - 1 - s : s;
    const int row0c = seqrow + c * 64;
#pragma unroll
    for (int k = 0; k < 4; ++k) { const int e = td + 256 * k, ip = e >> 4, pc = e & 15; *(LAS u32x4*)(Qn + ip * 136 + pc * 8) = pq[k]; *(LAS u32x4*)(Kn + ip * 136 + pc * 8) = pk[k]; }
#pragma unroll
    for (int k = 0; k < 2; ++k) { const int e = td + 256 * k; *(LAS u32x4*)(Tm + (e >> 3) * 72 + (e & 7) * 8) = pt[k]; }
    { const int ip = td >> 2, pc = td & 3;
      Vt[(pc * 8 + 0) * 72 + ip] = (bf16_t)(pv.x & 0xffffu); Vt[(pc * 8 + 1) * 72 + ip] = (bf16_t)(pv.x >> 16);
      Vt[(pc * 8 + 2) * 72 + ip] = (bf16_t)(pv.y & 0xffffu); Vt[(pc * 8 + 3) * 72 + ip] = (bf16_t)(pv.y >> 16);
      Vt[(pc * 8 + 4) * 72 + ip] = (bf16_t)(pv.z & 0xffffu); Vt[(pc * 8 + 5) * 72 + ip] = (bf16_t)(pv.z >> 16);
      Vt[(pc * 8 + 6) * 72 + ip] = (bf16_t)(pv.w & 0xffffu); Vt[(pc * 8 + 7) * 72 + ip] = (bf16_t)(pv.w >> 16); }
    if (w4 == 0) { gcs[lane] = pa0; bts[lane] = pa1; egs[lane] = __expf(pa0); dds[lane] = __expf(__shfl(pa0, 63) - pa0); }
    __syncthreads();
    if (s + 1 < nch) DN2_PREFETCH(s + 1);
    bf16_t* const orow = O + (size_t)(row0c + (dir ? 63 - (td >> 2) : (td >> 2))) * 1024 + hd * 128 + slab * 32 + (td & 3) * 8;
    u32x4 po = (u32x4){0u, 0u, 0u, 0u};
    if (2 * s >= nch) po = *(const u32x4*)orow;
    {
      const int jt = w4 >> 1, it = w4 & 1;
      const LAS bf16_t* a2 = w4 < 2 ? Qn + w4 * 32 * 136 : Kn + (w4 - 2) * 32 * 136;
      f32x16 acc = zero16(), acc2 = zero16();
      {
        const LAS bf16_t* ap = Kn + jt * 32 * 136 + r * 136 + 8 * hh; const LAS bf16_t* bp = Qn + it * 32 * 136 + r * 136 + 8 * hh;
        const LAS bf16_t* cp = a2 + r * 136 + 8 * hh; const LAS bf16_t* dp = St + r * 136 + 8 * hh;
#pragma unroll 4
        for (int k0 = 0; k0 < 128; k0 += 16) {
          const bf16x8 fa = *(const LAS bf16x8*)(ap + k0), fb = *(const LAS bf16x8*)(bp + k0), fc = *(const LAS bf16x8*)(cp + k0), fd = *(const LAS bf16x8*)(dp + k0);
          acc = MFMA32(fa, fb, acc); acc2 = MFMA32(fc, fd, acc2);
        }
      }
      const int i = it * 32 + r; const float gi = gcs[i];
#pragma unroll
      for (int g = 0; g < 4; ++g) {
        const int j0 = jt * 32 + 8 * g + 4 * hh; float v[4];
        const f32x4 gj = *(const LAS f32x4*)(gcs + j0);
#pragma unroll
        for (int e = 0; e < 4; ++e) { const float w = acc[4 * g + e] * __expf(fminf(gi - gj[e], 0.f)); v[e] = (i >= j0 + e) ? w : 0.f; }
        *(LAS u32x2*)(QK + i * 72 + j0) = (u32x2){pack2(v[0], v[1]), pack2(v[2], v[3])};
      }
      if (w4 < 2) {
        o1 = acc2;
      } else {
        const int jt2 = w4 - 2;
#pragma unroll
        for (int g = 0; g < 4; ++g) {
          const int j0 = jt2 * 32 + 8 * g + 4 * hh;
          const u32x2 vv = *(const LAS u32x2*)(Vt + r * 72 + j0);
          const float ve[4] = {lo2f(vv.x), hi2f(vv.x), lo2f(vv.y), hi2f(vv.y)}; float rv[4];
          const f32x4 gj4 = *(const LAS f32x4*)(egs + j0), bj4 = *(const LAS f32x4*)(bts + j0);
#pragma unroll
          for (int e = 0; e < 4; ++e) rv[e] = bj4[e] * (ve[e] - gj4[e] * acc2[4 * g + e]);
          *(LAS u32x2*)(Rt + r * 72 + j0) = (u32x2){pack2(rv[0], rv[1]), pack2(rv[2], rv[3])};
        }
      }
    }
    __syncthreads();
    if (w4 >= 2) {
      const int it = w4 - 2;
      const f32x16 acc = mm32(Tm + it * 32 * 72, 72, Rt, 72, 64, zero16(), lane);
      const float gl = gcs[63];
#pragma unroll
      for (int g = 0; g < 4; ++g) {
        const int i0 = it * 32 + 8 * g + 4 * hh; float dv[4];
        const f32x4 gi4 = *(const LAS f32x4*)(dds + i0);
#pragma unroll
        for (int e = 0; e < 4; ++e) dv[e] = acc[4 * g + e] * gi4[e];
        *(LAS u32x2*)(Vn + r * 72 + i0) = (u32x2){pack2(acc[4 * g], acc[4 * g + 1]), pack2(acc[4 * g + 2], acc[4 * g + 3])};
        *(LAS u32x2*)(Vd + r * 72 + i0) = (u32x2){pack2(dv[0], dv[1]), pack2(dv[2], dv[3])};
      }
    }
    __syncthreads();
    if (w4 < 2) {
      const int it = w4;
#pragma unroll
      for (int g = 0; g < 4; ++g) { const f32x4 gi4 = *(const LAS f32x4*)(egs + it * 32 + 8 * g + 4 * hh);
#pragma unroll
        for (int e = 0; e < 4; ++e) o1[4 * g + e] *= gi4[e]; }
      o1 = mm32(QK + it * 32 * 72, 72, Vn, 72, 64, o1, lane);
#pragma unroll
      for (int ii = 0; ii < 16; ++ii) Rt[(it * 32 + crow(ii, hh)) * 32 + r] = f2bf(o1[ii]);
    }
    {
      const float gl = egs[63];
#pragma unroll
      for (int ii = 0; ii < 16; ++ii) S[ii] *= gl;
#pragma unroll
      for (int jt = 0; jt < 2; ++jt) {
        unsigned x[16];
#pragma unroll
        for (int ii = 0; ii < 16; ++ii) x[ii] = Kn[(jt * 32 + crow(ii, hh)) * 136 + 32 * w4 + r];
#pragma unroll
        for (int s2 = 0; s2 < 2; ++s2) {
          const u32x4 aw = (u32x4){x[8 * s2] | (x[8 * s2 + 1] << 16), x[8 * s2 + 2] | (x[8 * s2 + 3] << 16), x[8 * s2 + 4] | (x[8 * s2 + 5] << 16), x[8 * s2 + 6] | (x[8 * s2 + 7] << 16)};
          const LAS bf16_t* bp = Vd + r * 72 + jt * 32 + 16 * s2 + 4 * hh;
          const u32x2 lo = *(const LAS u32x2*)bp, hi = *(const LAS u32x2*)(bp + 8);
          S = MFMA32(__builtin_bit_cast(bf16x8, aw), __builtin_bit_cast(bf16x8, ((u32x4){lo.x, lo.y, hi.x, hi.y})), S);
        }
      }
#pragma unroll
      for (int g = 0; g < 4; ++g) *(LAS u32x2*)(St + r * 136 + 32 * w4 + 8 * g + 4 * hh) = (u32x2){pack2(S[4 * g], S[4 * g + 1]), pack2(S[4 * g + 2], S[4 * g + 3])};
    }
    __syncthreads();
    {
      u32x4 ov = *(const LAS u32x4*)(Rt + (td >> 2) * 32 + (td & 3) * 8);
      if (2 * s >= nch) {
        ov.x = pack2(lo2f(ov.x) + lo2f(po.x), hi2f(ov.x) + hi2f(po.x)); ov.y = pack2(lo2f(ov.y) + lo2f(po.y), hi2f(ov.y) + hi2f(po.y));
        ov.z = pack2(lo2f(ov.z) + lo2f(po.z), hi2f(ov.z) + hi2f(po.z)); ov.w = pack2(lo2f(ov.w) + lo2f(po.w), hi2f(ov.w) + hi2f(po.w));
      }
      *(u32x4*)orow = ov;
    }
  }
#undef DN2_PREFETCH
  if (!samp) {
    const size_t oidx = (size_t)OFF_DN + ((((size_t)(b * 2 + i2) * 2 + dir) * 8 + hd) * 128 + 32 * w4) * 128 + slab * 32 + r;
#pragma unroll
    for (int ii = 0; ii < 16; ++ii) p.out[oidx + (size_t)crow(ii, hh) * 128] = S[ii];
  }
}

DI void phase_dn3(const Params& p, int l) {
  const int i2 = l >> 1;
  bf16_t* Y = (bf16_t*)(p.ws + WS_H);
  const bf16_t* P = (const bf16_t*)(p.ws + WS_P);
  const float* gain = p.in[27] + i2 * 128;
  const int tstride = gridDim.x * 512, ntask = M_TOT * 128;
  u32x4 ov[2], zv[2], nov[2], nzv[2];
  int task0 = bid_opaque() * 512 + tid_opaque();
#define DN3_LOAD(ovv, zvv, t0_) do { _Pragma("unroll") for (int q_ = 0; q_ < 2; ++q_) { \
      int task_ = (t0_) + q_ * tstride; if (task_ >= ntask) task_ = bid_opaque() * 512 + tid_opaque(); \
      const int pc_ = task_ & 15, rh_ = task_ >> 4, hd_ = rh_ & 7, row_ = rh_ >> 3, col_ = hd_ * 128 + pc_ * 8; \
      ovv[q_] = *(const u32x4*)(Y + (size_t)row_ * 1024 + col_); zvv[q_] = *(const u32x4*)(P + (size_t)row_ * ODD_LD + 3072 + col_); } } while (0)
  if (task0 < ntask) DN3_LOAD(ov, zv, task0);
  const f32x4 g0 = *(const f32x4*)(gain + (tid_opaque() & 15) * 8), g1 = *(const f32x4*)(gain + (tid_opaque() & 15) * 8 + 4);
  const float gg[8] = {g0[0], g0[1], g0[2], g0[3], g1[0], g1[1], g1[2], g1[3]};
  for (; task0 < ntask; task0 += 2 * tstride) {
    if (task0 + 2 * tstride < ntask) DN3_LOAD(nov, nzv, task0 + 2 * tstride);
#pragma unroll
    for (int q = 0; q < 2; ++q) {
      const int task = task0 + q * tstride;
      const int pc = task & 15, rh = task >> 4, hd = rh & 7, row = rh >> 3, col = hd * 128 + pc * 8;
      float o[8] = {lo2f(ov[q].x), hi2f(ov[q].x), lo2f(ov[q].y), hi2f(ov[q].y), lo2f(ov[q].z), hi2f(ov[q].z), lo2f(ov[q].w), hi2f(ov[q].w)};
      const float z[8] = {lo2f(zv[q].x), hi2f(zv[q].x), lo2f(zv[q].y), hi2f(zv[q].y), lo2f(zv[q].z), hi2f(zv[q].z), lo2f(zv[q].w), hi2f(zv[q].w)};
      float ss = 0.f;
#pragma unroll
      for (int e = 0; e < 8; ++e) ss += o[e] * o[e];
      ss += __shfl_xor(ss, 1); ss += __shfl_xor(ss, 2); ss += __shfl_xor(ss, 4); ss += __shfl_xor(ss, 8);
      const float rstd = rsqrtf(ss * (1.f / 128.f) + 1e-6f);
#pragma unroll
      for (int e = 0; e < 8; ++e) o[e] = o[e] * rstd * gg[e] * siluf_(z[e]);
      if (task < ntask) *(u32x4*)(Y + (size_t)row * 1024 + col) = (u32x4){pack2(o[0], o[1]), pack2(o[2], o[3]), pack2(o[4], o[5]), pack2(o[6], o[7])};
    }
#pragma unroll
    for (int q = 0; q < 2; ++q) { ov[q] = nov[q]; zv[q] = nzv[q]; }
  }
#undef DN3_LOAD
}

constexpr int ROWS_A = 32768;
constexpr int N_PHASES = 1 + 11 + 11 + 10 + 11;
enum { ST_N1, ST_IN, ST_M0, ST_M1, ST_M2, ST_OUTA, ST_OUTB, ST_N2T, ST_GU, ST_DNA, ST_DNB, ST_N1T };
DI void run_phase(const Params& p, lptr lds, int ph) {
  const int G = gridDim.x, bid = bid_opaque();
  if (ph == 0) { phase_pre(p, lds, 0, G == 256 ? 2 : 4, bid, G, true); return; }
  int l, k; { int q = ph - 1; if (q < 11) { l = 0; k = q; } else if (q < 22) { l = 1; k = q - 11; } else if (q < 32) { l = 2; k = q - 22; } else { l = 3; k = q - 32; } }
  const bool odd = l & 1; const int i2 = l >> 1;
  int st;
  if (l == 0) { const int tab[11] = {ST_N1, ST_IN, ST_M0, ST_M1, ST_OUTA, ST_OUTB, ST_N2T, ST_GU, ST_DNA, ST_DNB, ST_N1T}; st = tab[k]; }
  else if (odd) { const int tab[11] = {ST_IN, ST_M0, ST_M1, ST_M2, ST_OUTA, ST_OUTB, ST_N2T, ST_GU, ST_DNA, ST_DNB, ST_N1T}; st = tab[k]; }
  else { const int tab[10] = {ST_IN, ST_M0, ST_M1, ST_OUTA, ST_OUTB, ST_N2T, ST_GU, ST_DNA, ST_DNB, ST_N1T}; st = tab[k]; }
  float* mod = (float*)(p.ws + WS_MOD);
  bf16_t* H = (bf16_t*)(p.ws + WS_H); bf16_t* Pb = (bf16_t*)(p.ws + WS_P);
  if (st == ST_N1) { phase_norm(p, lds, l, 0); return; }
  if (st == ST_IN) {
    pg8::EpiIn E; E.P = Pb; E.ldp = odd ? ODD_LD : EVEN_IN; E.odd = odd ? 1 : 0;
    E.kout = p.out + OFF_K + (size_t)i2 * 256 * 128; E.vout = p.out + OFF_V + (size_t)i2 * 256 * 128;
    E.ab = (float*)(p.ws + WS_AB); E.halo = (bf16_t*)(p.ws + WS_HALO);
    run_gemm(lds, H, (const bf16_t*)(p.ws + WS_WIN), odd ? ODD_NP : EVEN_IN, 1024, E); return;
  }
  if (st == ST_M0 || st == ST_M1 || st == ST_M2) {
    const int ms = st - ST_M0;
    if (ms == 0 && l > 0) { cvt_layer(p, lds, l, 4, bid, G); __syncthreads(); }
    if (!odd) {
      if (ms == 0) {
        for (int it = bid; it < 1152; it += G) att_item(p, lds, l, it);
        rg_phase(p, lds, l, 0);
      } else { rg_phase(p, lds, l, 1); }
    } else {
      if (ms == 0) dn1_phase(p, lds, l);
      else if (ms == 1) {
        for (int it = bid; it < 768; it += G) {
          const int grp = it >> 8, j = it & 255, xcd = j & 7, idx = j >> 3;
          dn2_item(p, lds, l, grp * 256 + ((xcd * 8 + (idx >> 2)) * 4 + (idx & 3))); __syncthreads();
        }
      }
      else phase_dn3(p, l);
    }
    return;
  }
  if (st == ST_OUTA || st == ST_OUTB) {
    pg8::EpiRes E; E.x = p.out; E.ga_base = mod + (size_t)l * 9 * 6144 + 2048;
    if (st == ST_OUTA) { E.rbase = 0; run_gemm_sub(lds, H, (const bf16_t*)(p.ws + WS_WOUT), ROWS_A, 1024, 1024, E, bid, G); return; }
    if (bid < 64) { E.rbase = ROWS_A; run_gemm_sub(lds, H + (size_t)ROWS_A * 1024, (const bf16_t*)(p.ws + WS_WOUT), M_TOT - ROWS_A, 1024, 1024, E, bid, 64); }
    else norm_rows(p, l, 1, 0, ROWS_A, bid - 64, G - 64);
    return;
  }
  if (st == ST_N2T) { norm_rows(p, l, 1, ROWS_A, M_TOT, bid, G); return; }
  if (st == ST_GU) { pg8::EpiGU E; E.act = Pb; run_gemm(lds, H, (const bf16_t*)(p.ws + WS_WGU), 5632, 1024, E); return; }
  if (st == ST_DNA || st == ST_DNB) {
    pg8::EpiRes E; E.x = p.out; E.ga_base = mod + (size_t)l * 9 * 6144 + 5120;
    if (st == ST_DNA) { E.rbase = 0; run_gemm_sub(lds, Pb, (const bf16_t*)(p.ws + WS_WDN), ROWS_A, 1024, DFF, E, bid, G); return; }
    if (bid < 64) { E.rbase = ROWS_A; run_gemm_sub(lds, Pb + (size_t)ROWS_A * DFF, (const bf16_t*)(p.ws + WS_WDN), M_TOT - ROWS_A, 1024, DFF, E, bid, 64); }
    else {
      if (l < 3) { norm_rows(p, l + 1, 0, 0, ROWS_A, bid - 64, G - 64); cvt_layer(p, lds, l + 1, 3, bid - 64, G - 64); if (l == 0 && G == 256) { __syncthreads(); phase_pre(p, lds, 2, 4, bid - 64, G - 64, false); } }
      else norm_rows(p, 0, 2, 0, ROWS_A, bid - 64, G - 64);
    }
    return;
  }
  if (l < 3) norm_rows(p, l + 1, 0, ROWS_A, M_TOT, bid, G); else norm_rows(p, 0, 2, ROWS_A, M_TOT, bid, G);
}

#define XB_TMO      128
#define XB_XCNT(j)  (256  + 64 * (j))
#define XB_XSUB(j)  (1280 + 64 * (j))
#define XB_XGEN(j)  (2304 + 64 * (j))
#define XB_TOP      3328
#define XB_TOPGEN   3392
#define XCD_BAR_WORDS 3456
#define XB_SPIN_CAP (1u << 20)
DI unsigned xb_ld(unsigned* p) { return __hip_atomic_load(p, __ATOMIC_RELAXED, __HIP_MEMORY_SCOPE_AGENT); }
DI unsigned xb_add(unsigned* p, unsigned v) { return __hip_atomic_fetch_add(p, v, __ATOMIC_RELAXED, __HIP_MEMORY_SCOPE_AGENT); }
DI unsigned xb_xcc_id() { return (unsigned)__builtin_amdgcn_s_getreg((3 << 11) | 20) & 0xFu; }
#define XB_SPIN(cond, bar) do { unsigned _sp = 0; while (cond) { __builtin_amdgcn_s_sleep(1); \
    if ((++_sp & 255u) == 0u) { if (xb_ld(&(bar)[XB_TMO])) break; if (_sp > XB_SPIN_CAP) { atomicAdd(&(bar)[XB_TMO], 1u); break; } } } } while (0)
struct XcdBarrier { unsigned* bar; unsigned x; volatile LAS unsigned* st; };
DI XcdBarrier xcd_barrier_post(unsigned* bar, volatile LAS unsigned* st) {
  XcdBarrier b; b.bar = bar; b.x = xb_xcc_id(); b.st = st;
  if (threadIdx.x == 0) (void)xb_add(&bar[XB_XCNT(b.x)], 1u);
  return b;
}
DI void xcd_barrier_complete(unsigned* bar, unsigned x, unsigned& nloc, unsigned& nx) {
  const unsigned G = gridDim.x;
  unsigned sum, cnt, mine, sp = 0u;
  for (;;) {
    sum = 0u; cnt = 0u; mine = 0u;
#pragma unroll
    for (unsigned j = 0; j < 16; ++j) { const unsigned c = xb_ld(&bar[XB_XCNT(j)]); sum += c; cnt += (c > 0u) ? 1u : 0u; mine = (j == x) ? c : mine; }
    if (sum == G) break;
    __builtin_amdgcn_s_sleep(1);
    if ((++sp & 255u) == 0u) { if (xb_ld(&bar[XB_TMO])) break; if (sp > XB_SPIN_CAP) { atomicAdd(&bar[XB_TMO], 1u); break; } }
  }
  nloc = mine > 0u ? mine : 1u; nx = cnt > 0u ? cnt : 1u;
}
DI void xcd_barrier(const XcdBarrier& b) {
  asm volatile("s_waitcnt vmcnt(0)" ::: "memory");
  __syncthreads();
  if (threadIdx.x == 0) {
    unsigned* bar = b.bar;
    __builtin_amdgcn_s_waitcnt(0);
    unsigned nloc = b.st[0], nx = b.st[1];
    if (nloc == 0u) { xcd_barrier_complete(bar, b.x, nloc, nx); b.st[0] = nloc; b.st[1] = nx; }
    const unsigned old = xb_add(&bar[XB_XSUB(b.x)], 1u);
    const unsigned gen = old / nloc;
    if (old + 1u == (gen + 1u) * nloc) {
      __builtin_amdgcn_fence(__ATOMIC_RELEASE, "agent");
      asm volatile("s_waitcnt vmcnt(0)" ::: "memory");
      const unsigned og = xb_add(&bar[XB_TOP], 1u);
      const unsigned tg = og / nx;
      if (og + 1u == (tg + 1u) * nx) xb_add(&bar[XB_TOPGEN], 1u);
      else XB_SPIN(xb_ld(&bar[XB_TOPGEN]) == tg, bar);
      __builtin_amdgcn_fence(__ATOMIC_ACQUIRE, "agent");
      xb_add(&bar[XB_XGEN(b.x)], 1u);
      asm volatile("s_waitcnt vmcnt(0)" ::: "memory");
    } else {
      XB_SPIN(xb_ld(&bar[XB_XGEN(b.x)]) == gen, bar);
      __builtin_amdgcn_fence(__ATOMIC_ACQUIRE, "agent");
      asm volatile("s_waitcnt vmcnt(0)" ::: "memory");
    }
  }
  __syncthreads();
}

__global__ void __launch_bounds__(512, 2) fwd_kernel(Params p) {
  extern __shared__ __attribute__((aligned(16))) unsigned char smem[];
  lptr lds = (lptr)smem;
  cg::grid_group grid = cg::this_grid();
  volatile LAS unsigned* xst = (volatile LAS unsigned*)(lds + LDS_BYTES - 16);
  if (threadIdx.x == 0) { xst[0] = 0u; xst[1] = 0u; }
  __syncthreads();
  const XcdBarrier xb = xcd_barrier_post((unsigned*)(p.ws + WS_BAR), xst);
  const int p_lo = p.p_lo, p_hi = p.p_hi, coop = p.coop;
  for (int ph = p_lo; ph < p_hi; ++ph) {
    unsigned long long kav = (unsigned long long)__builtin_amdgcn_kernarg_segment_ptr();
    asm volatile("" : "+s"(kav));
    const __attribute__((address_space(4))) Params* kp = (const __attribute__((address_space(4))) Params*)kav;
    run_phase(*(const Params*)kp, lds, ph);
    if (coop && ph + 1 < p_hi) {
      if (ph == p_lo) grid.sync();
      else xcd_barrier(xb);
    }
  }
}

extern "C" void kernel_launch(void* const* d_in, const int* in_sizes, int n_in, void* d_out, int out_size, void* d_ws, size_t ws_size, hipStream_t stream) {
  static int grid = 0;
  if (grid == 0) {
    if (n_in != 31 || ws_size < WS_TOTAL) { fprintf(stderr, "kernel_launch: unexpected n_in %d or ws_size %zu (need %zu)\n", n_in, ws_size, (size_t)WS_END); grid = -1; return; }
    int dev = 0, cus = 0, per_cu = 0;
    hipGetDevice(&dev);
    hipDeviceGetAttribute(&cus, hipDeviceAttributeMultiprocessorCount, dev);
    if (hipFuncSetAttribute((const void*)fwd_kernel, hipFuncAttributeMaxDynamicSharedMemorySize, LDS_BYTES) != hipSuccess) { fprintf(stderr, "kernel_launch: hipFuncSetAttribute failed\n"); }
    hipOccupancyMaxActiveBlocksPerMultiprocessor(&per_cu, (const void*)fwd_kernel, 512, LDS_BYTES);
    (void)hipGetLastError();
    if (per_cu < 1) per_cu = 1;
    grid = cus * per_cu;
    if (grid > 256) grid = 256;
    fprintf(stderr, "kernel_launch: cus %d per_cu %d grid %d ws %zu need %zu\n", cus, per_cu, grid, ws_size, (size_t)WS_END);
  }
  if (grid < 0) return;
  if (hipMemsetAsync((char*)d_ws + WS_BAR, 0, 16384, stream) != hipSuccess) fprintf(stderr, "kernel_launch: memset failed\n");
  Params p{};
  for (int i = 0; i < 31; ++i) p.in[i] = (const float*)d_in[i];
  p.out = (float*)d_out; p.ws = (unsigned char*)d_ws; p.p_lo = 0; p.p_hi = N_PHASES; p.coop = 1; p.pad = 0;
  void* args[] = {&p};
  hipError_t e = hipLaunchCooperativeKernel((const void*)fwd_kernel, dim3(grid), dim3(512), args, LDS_BYTES, stream);
  if (e != hipSuccess) fprintf(stderr, "cooperative launch failed: %s (grid %d)\n", hipGetErrorString(e), grid);
}
```

```cpp
#include <hip/hip_runtime.h>
#include <hip/hip_cooperative_groups.h>
#include <cstdio>
namespace cg = cooperative_groups;
#define DI __device__ __forceinline__
#define LAS __attribute__((address_space(3)))
typedef unsigned short bf16_t;
typedef short bf16x8 __attribute__((ext_vector_type(8)));
typedef float f32x4 __attribute__((ext_vector_type(4)));
typedef float f32x16 __attribute__((ext_vector_type(16)));
typedef unsigned u32x4 __attribute__((ext_vector_type(4)));
typedef unsigned u32x2 __attribute__((ext_vector_type(2)));
typedef LAS unsigned char* lptr;

constexpr int M_TOT = 36864, M_P = 4096, DM = 1024;
constexpr int EVEN_IN = 1792, ODD_NP = 4352, ODD_LD = 4096, DFF = 2816;
constexpr int OFF_K = M_TOT * DM, OFF_V = OFF_K + 1048576, OFF_RG = OFF_V + 1048576, OFF_DN = OFF_RG + 32768;
constexpr size_t WS_MOD = 0;
constexpr size_t WS_ROPE = WS_MOD + 884736;
constexpr size_t WS_WIN = WS_ROPE + 1048576;
constexpr size_t WS_WOUT = WS_WIN + (size_t)ODD_NP * 1024 * 2;
constexpr size_t WS_WGU = WS_WOUT + 1024 * 1024 * 2;
constexpr size_t WS_WDN = WS_WGU + (size_t)5632 * 1024 * 2;
constexpr size_t WS_RGW = WS_WDN + (size_t)1024 * 2816 * 2;
constexpr size_t WS_H = WS_RGW + 262144;
constexpr size_t WS_P = WS_H + (size_t)M_TOT * 1024 * 2;
constexpr size_t WS_AB = WS_P + (size_t)M_TOT * 4096 * 2;
constexpr size_t WS_HALO = WS_AB + (size_t)M_TOT * 32 * 4;
constexpr size_t WS_T = WS_HALO + (size_t)576 * 3 * 3072 * 2;
constexpr size_t WS_CARRY = WS_T + (size_t)576 * 8 * 2 * 4096 * 2;
constexpr size_t WS_END = WS_CARRY + (size_t)576 * 2 * 2 * 512 * 4;
constexpr size_t WS_BAR = WS_END;
constexpr size_t WS_TOTAL = WS_BAR + 16384;
constexpr int LDS_BYTES = 160 * 1024;

struct Params {
  const float* in[31];
  float* out;
  unsigned char* ws;
  int p_lo, p_hi, coop, pad;
};

DI int tid_opaque() { int t = threadIdx.x; asm volatile("" : "+v"(t)); return t; }
DI int bid_opaque() { int t = blockIdx.x; asm volatile("" : "+s"(t)); return t; }

typedef __bf16 hwbf16x2 __attribute__((ext_vector_type(2)));
typedef float f32x2v __attribute__((ext_vector_type(2)));
DI unsigned pack2(float lo, float hi) { const f32x2v v = {lo, hi}; return __builtin_bit_cast(unsigned, __builtin_convertvector(v, hwbf16x2)); }
DI bf16_t f2bf(float f) { return (bf16_t)(pack2(f, 0.f) & 0xffffu); }
DI float bf2f(bf16_t b) { return __uint_as_float(((unsigned)b) << 16); }
DI float lo2f(unsigned u) { return __uint_as_float(u << 16); }
DI float hi2f(unsigned u) { return __uint_as_float(u & 0xffff0000u); }
DI float sigmoidf_(float x) { return __builtin_amdgcn_rcpf(1.f + __expf(-x)); }
DI float siluf_(float x) { return x * __builtin_amdgcn_rcpf(1.f + __expf(-x)); }
DI float softplusf_(float x) { return x > 20.f ? x : log1pf(__expf(x)); }
DI int crow(int reg, int h) { return (reg & 3) + 8 * (reg >> 2) + 4 * h; }
DI int row_group(int r) { return r < M_P ? 0 : 1 + ((r - M_P) >> 12); }
DI float wave_sum(float v) {
#pragma unroll
  for (int o = 32; o > 0; o >>= 1) v += __shfl_xor(v, o);
  return v;
}
#define MFMA32(a, b, c) __builtin_amdgcn_mfma_f32_32x32x16_bf16((a), (b), (c), 0, 0, 0)
DI f32x16 mm32(const LAS bf16_t* A, int lda, const LAS bf16_t* Bt, int ldb, int K, f32x16 acc, int lane) {
  const int r = lane & 31, h = lane >> 5;
  const LAS bf16_t* ap = A + r * lda + 8 * h;
  const LAS bf16_t* bp = Bt + r * ldb + 8 * h;
_Pragma("unroll 4")
  for (int k0 = 0; k0 < K; k0 += 16) {
    bf16x8 a = *(const LAS bf16x8*)(ap + k0);
    bf16x8 b = *(const LAS bf16x8*)(bp + k0);
    acc = MFMA32(a, b, acc);
  }
  return acc;
}
DI f32x16 zero16() { f32x16 z; for (int i = 0; i < 16; ++i) z[i] = 0.f; return z; }

DI void phase_pre(const Params& p, lptr lds, int l_lo, int l_hi, int vb, int nb, bool rope) {
  const int tid = tid_opaque(), wid = tid >> 6, lane = tid & 63;
  float* rc = (float*)(p.ws + WS_ROPE); float* rs = rc + 4096 * 32;
  if (rope)
  for (int e = bid_opaque() * 512 + tid; e < 4096 * 32; e += gridDim.x * 512) {
    const int t = e >> 5, f = e & 31, fr = f & 15;
    const float inv = exp2f(-(float)fr * 0.83048202372184058696f);
    const float pos = (f < 16) ? (float)(t >> 6) : (float)(t & 63);
    float x = pos * inv * 0.15915494309189533577f; x -= floorf(x);
    rc[e] = __builtin_amdgcn_cosf(x); rs[e] = __builtin_amdgcn_sinf(x);
  }
  LAS float* sc = (LAS float*)lds;
  LAS float* red = sc + 9 * 1024;
  for (int e = tid; e < 9 * 1024; e += 512) { const int g = e >> 10, k = e & 1023; const float v = g == 0 ? p.in[7][k] : p.in[2][(g - 1) * 1024 + k]; sc[e] = siluf_(v); }
  __syncthreads();
  float* mod = (float*)(p.ws + WS_MOD);
  for (int it = vb; it < (l_hi - l_lo) * 96; it += nb) {
    const int l = l_lo + it / 96, n0 = (it % 96) * 64;
    const float* w = p.in[8] + (size_t)l * 1024 * 6144 + n0 + lane;
    float acc[9];
#pragma unroll
    for (int g = 0; g < 9; ++g) acc[g] = 0.f;
#pragma unroll 16
    for (int k = wid * 128; k < wid * 128 + 128; ++k) {
      const float wv = w[(size_t)k * 6144];
#pragma unroll
      for (int g = 0; g < 9; ++g) acc[g] += sc[g * 1024 + k] * wv;
    }
#pragma unroll
    for (int g = 0; g < 9; ++g) red[(wid * 9 + g) * 64 + lane] = acc[g];
    __syncthreads();
    for (int e = tid; e < 9 * 64; e += 512) {
      const int g = e >> 6, c = e & 63; float s = 0.f;
#pragma unroll
      for (int w8 = 0; w8 < 8; ++w8) s += red[(w8 * 9 + g) * 64 + c];
      mod[((size_t)l * 9 + g) * 6144 + n0 + c] = s + p.in[9][l * 6144 + n0 + c];
    }
    __syncthreads();
  }
}

DI void cvt_tile(const float* src, int lds_src, int nvalid, bf16_t* dst, int ldd, int k0, int n0, int mode, LAS float* buf) {
  const int tid = tid_opaque();
  for (int e = tid; e < 4096; e += 512) { const int i = e >> 6, j = e & 63; buf[i * 65 + j] = (j < nvalid) ? src[(size_t)i * lds_src + j] : 0.f; }
  __syncthreads();
  for (int e = tid; e < 2048; e += 512) {
    const int j = e >> 5, i2 = (e & 31) * 2;
    if (j < nvalid) {
      int n = n0 + j, row = n;
      if (mode == 1) { const int up = n >= DFF ? 1 : 0; const int jj = n - up * DFF; row = 256 * (jj >> 7) + 128 * up + (jj & 127); }
      *(unsigned*)(dst + (size_t)row * ldd + k0 + i2) = pack2(buf[i2 * 65 + j], buf[(i2 + 1) * 65 + j]);
    }
  }
  __syncthreads();
}
DI void cvt_matrix(const float* W, int K, int N, bf16_t* dst, int mode, LAS float* buf, int vb, int nb) {
  const int nk = K / 64, nn = (N + 63) / 64;
  for (int t = vb; t < nk * nn; t += nb) {
    const int tk = t % nk, tn = t / nk, k0 = tk * 64, n0 = tn * 64;
    const int nvalid = (N - n0) < 64 ? (N - n0) : 64;
    cvt_tile(W + (size_t)k0 * N + n0, N, nvalid, dst, K, k0, n0, mode, buf);
  }
}

DI void cvt_layer(const Params& p, lptr lds, int l, int what, int vb, int nb) {
  const int tid = tid_opaque();
  const int i2 = l >> 1;
  LAS float* buf = (LAS float*)lds;
  if (what & 1) {
    if ((l & 1) == 0) {
      cvt_matrix(p.in[13] + (size_t)i2 * 1024 * EVEN_IN, 1024, EVEN_IN, (bf16_t*)(p.ws + WS_WIN), 0, buf, vb, nb);
      cvt_matrix(p.in[22] + (size_t)i2 * 1024 * 1024, 1024, 1024, (bf16_t*)(p.ws + WS_WOUT), 0, buf, vb, nb);
      for (int t = vb; t < 32; t += nb) {
        const int gate = t >> 4, dir = (t >> 3) & 1, n = t & 7;
        const float* srcp = (gate ? p.in[18] : p.in[16]) + ((size_t)(i2 * 2 + dir) * 8 + n) * 4096;
        cvt_tile(srcp, 64, 64, (bf16_t*)(p.ws + WS_RGW) + ((size_t)(dir * 2 + gate) * 8 + n) * 4096, 64, 0, 0, 0, buf);
      }
    } else {
      cvt_matrix(p.in[23] + (size_t)i2 * 1024 * 4128, 1024, 4128, (bf16_t*)(p.ws + WS_WIN), 0, buf, vb, nb);
      cvt_matrix(p.in[28] + (size_t)i2 * 1024 * 1024, 1024, 1024, (bf16_t*)(p.ws + WS_WOUT), 0, buf, vb, nb);
      u32x4* z = (u32x4*)((bf16_t*)(p.ws + WS_WIN) + (size_t)4128 * 1024);
      for (int e = vb * 512 + tid; e < 224 * 1024 / 8; e += nb * 512) z[e] = (u32x4){0u, 0u, 0u, 0u};
    }
  }
  if (what & 2) cvt_matrix(p.in[29] + (size_t)l * 1024 * 5632, 1024, 5632, (bf16_t*)(p.ws + WS_WGU), 1, buf, vb, nb);
  if (what & 4) cvt_matrix(p.in[30] + (size_t)l * DFF * 1024, DFF, 1024, (bf16_t*)(p.ws + WS_WDN), 0, buf, vb, nb);
}

DI void phase_norm(const Params& p, lptr lds, int l, int which) {
  const int tid = tid_opaque(), wid = tid >> 6, lane = tid & 63;
  const int i2 = l >> 1;
  if (which == 0) { if (l == 0) cvt_layer(p, lds, 0, 7, bid_opaque(), gridDim.x); else cvt_layer(p, lds, l, gridDim.x == 256 ? 4 : 7, bid_opaque(), gridDim.x); }
  const bool first = (l == 0 && which == 0);
  const float* mod = (const float*)(p.ws + WS_MOD);
  bf16_t* h = (bf16_t*)(p.ws + WS_H);
  const float* gn = (which ? p.in[11] : p.in[10]) + l * 1024;
  const int rstride = gridDim.x * 8;
  for (int row0 = bid_opaque() * 8 + wid; row0 < M_TOT; row0 += 6 * rstride) {
    f32x4 v[6][4]; float ss[6];
#pragma unroll
    for (int q = 0; q < 6; ++q) {
      const int row = row0 + q * rstride < M_TOT ? row0 + q * rstride : row0;
      const float* xs = first ? (row < M_P ? p.in[0] + (size_t)row * 1024 : p.in[1] + (size_t)(row - M_P) * 1024) : p.out + (size_t)row * 1024;
#pragma unroll
      for (int i = 0; i < 4; ++i) v[q][i] = *(const f32x4*)(xs + lane * 4 + 256 * i);
    }
#pragma unroll
    for (int q = 0; q < 6; ++q) {
      float s = 0.f;
#pragma unroll
      for (int i = 0; i < 4; ++i) s += v[q][i][0] * v[q][i][0] + v[q][i][1] * v[q][i][1] + v[q][i][2] * v[q][i][2] + v[q][i][3] * v[q][i][3];
      ss[q] = wave_sum(s);
    }
#pragma unroll
    for (int q = 0; q < 6; ++q) {
      const int row = row0 + q * rstride;
      if (row < M_TOT) {
        const float rstd = rsqrtf(ss[q] * (1.f / 1024.f) + 1e-6f);
        const float* md = mod + ((size_t)l * 9 + row_group(row)) * 6144 + (which ? 3072 : 0);
#pragma unroll
        for (int i = 0; i < 4; ++i) {
          const int c = lane * 4 + 256 * i;
          const f32x4 gg = *(const f32x4*)(gn + c), sh = *(const f32x4*)(md + c), sc = *(const f32x4*)(md + 1024 + c);
          f32x4 y;
#pragma unroll
          for (int j = 0; j < 4; ++j) y[j] = v[q][i][j] * rstd * gg[j] * (1.f + sc[j]) + sh[j];
          *(u32x2*)(h + (size_t)row * 1024 + c) = (u32x2){pack2(y[0], y[1]), pack2(y[2], y[3])};
        }
      }
    }
    if (first) {
#pragma unroll
      for (int q = 0; q < 6; ++q) {
        const int row = row0 + q * rstride;
        if (row < M_TOT) {
#pragma unroll
          for (int i = 0; i < 4; ++i) *(f32x4*)(p.out + (size_t)row * 1024 + lane * 4 + 256 * i) = v[q][i];
        }
      }
    }
  }
}

DI void phase_final(const Params& p) {
  const int tid = tid_opaque(), wid = tid >> 6, lane = tid & 63;
  const float* gn = p.in[12];
  const int rstride = gridDim.x * 8;
  for (int row0 = bid_opaque() * 8 + wid; row0 < M_TOT; row0 += 3 * rstride) {
    f32x4 v[3][4]; float ss[3];
#pragma unroll
    for (int q = 0; q < 3; ++q) {
      const int row = row0 + q * rstride < M_TOT ? row0 + q * rstride : row0;
      const float* xs = p.out + (size_t)row * 1024;
#pragma unroll
      for (int i = 0; i < 4; ++i) v[q][i] = *(const f32x4*)(xs + lane * 4 + 256 * i);
    }
#pragma unroll
    for (int q = 0; q < 3; ++q) {
      float s = 0.f;
#pragma unroll
      for (int i = 0; i < 4; ++i) s += v[q][i][0] * v[q][i][0] + v[q][i][1] * v[q][i][1] + v[q][i][2] * v[q][i][2] + v[q][i][3] * v[q][i][3];
      ss[q] = wave_sum(s);
    }
#pragma unroll
    for (int q = 0; q < 3; ++q) {
      const int row = row0 + q * rstride;
      if (row < M_TOT) {
        const float rstd = rsqrtf(ss[q] * (1.f / 1024.f) + 1e-6f);
#pragma unroll
        for (int i = 0; i < 4; ++i) {
          const int c = lane * 4 + 256 * i;
          const f32x4 gg = *(const f32x4*)(gn + c);
          f32x4 y;
#pragma unroll
          for (int j = 0; j < 4; ++j) y[j] = v[q][i][j] * rstd * gg[j];
          *(f32x4*)(p.out + (size_t)row * 1024 + c) = y;
        }
      }
    }
  }
}

namespace pg8 {
constexpr int BM = 256, BK = 64, HALF = 128, HTB = HALF * BK * 2, STAGE_BYTES = 8 * HTB, NXCD = 8, WGM = 8;
DI int lds_byte(int r, int c) { const int st = (r >> 4) * 2 + (c >> 5), rr = r & 15, cc = c & 31, ob = rr * 64 + cc * 2; return st * 1024 + (ob ^ (((ob >> 9) & 1) << 5)); }
DI void stage_rc(int b, int& R, int& C) { const int st = b / 1024, sb = b % 1024, swz = sb ^ (((sb >> 9) & 1) << 5); R = (st >> 1) * 16 + swz / 64; C = (st & 1) * 32 + (swz % 64) / 2; }
DI int perm32(int rho) { const int n = rho >> 4, i = rho & 15; return 8 * (i >> 2) + 4 * n + (i & 3); }
struct Unit { int pm, pn; };
struct Gemm { const bf16_t* A; const bf16_t* Bt; int M, N, K; };
struct StaticOrder {
  int nM, nN, nwg, G, c;
  DI void init(int M, int N, int G_, int c_) { nM = M / BM; nN = N / BM; nwg = nM * nN; G = G_; c = c_; }
  DI bool next(int i, Unit& u) const {
    const long L = (long)i * G + c; if (L >= nwg) return false;
    int wgid = (int)L; { const int q = nwg / NXCD, r = nwg % NXCD, xcd = wgid % NXCD, off = wgid / NXCD; wgid = (xcd < r ? xcd * (q + 1) : r * (q + 1) + (xcd - r) * q) + off; }
    const int nig = WGM * nN, gid = wgid / nig, fm = gid * WGM, gsz = (nM - fm) < WGM ? (nM - fm) : WGM;
    u.pm = fm + ((wgid % nig) % gsz); u.pn = (wgid % nig) / gsz; return true;
  }
};
DI unsigned cvt_pk_bf16(float lo, float hi) { unsigned r; asm volatile("v_cvt_pk_bf16_f32 %0, %1, %2" : "=v"(r) : "v"(lo), "v"(hi)); return r; }

template <class Epi>
DI void gemm_phase(lptr lds, const Gemm g, const StaticOrder& S, const Epi& E) {
  const int tid = tid_opaque(), wid = __builtin_amdgcn_readfirstlane(tid >> 6), lane = tid & 63, wr = wid >> 2, wc = wid & 3, fr = lane & 15, fq = lane >> 4;
  const int K = g.K, nt = K / BK;
  unsigned voffA[2], voffB[2];
#pragma unroll
  for (int i = 0; i < 2; ++i) { int R, C; stage_rc(tid * 16 + i * 8192, R, C); const int Rb = Epi::PERM ? ((R & ~31) + perm32(R & 31)) : R;
    voffA[i] = (unsigned)(R * K + C) * 2u; voffB[i] = (unsigned)(Rb * K + C) * 2u; }
  const size_t kstep = (size_t)(BK * 2);
  const size_t hstep = (size_t)HALF * K * 2;
  const size_t tstep = 2 * hstep;
  const unsigned ldsw = (unsigned)wid * 1024u;
  const int aoff = lds_byte(wr * 64 + fr, fq * 8), boff = lds_byte(wc * 32 + fr, fq * 8);
#define PG8_SA(b, h) (((b) * 2 + (h)) * HTB)
#define PG8_SB(b, h) ((4 + (b) * 2 + (h)) * HTB)
#define PG8_STAGE(bufoff, gbase, voff) do { _Pragma("unroll") for (int _i = 0; _i < 2; ++_i) \
    __builtin_amdgcn_global_load_lds((const unsigned*)((const char*)(gbase) + (voff)[_i]), (LAS unsigned*)(lds + (bufoff) + ldsw + _i * 8192), 16, 0, 0); } while (0)
#define PG8_LDA(dst, b, h) do { _Pragma("unroll") for (int m = 0; m < 4; ++m) _Pragma("unroll") for (int k = 0; k < 2; ++k) dst[m][k] = *(const LAS bf16x8*)(lds + PG8_SA(b, h) + aoff + m * 2048 + k * 1024); } while (0)
#define PG8_LDB(dst, b, h) do { _Pragma("unroll") for (int n = 0; n < 2; ++n) _Pragma("unroll") for (int k = 0; k < 2; ++k) dst[n][k] = *(const LAS bf16x8*)(lds + PG8_SB(b, h) + boff + n * 2048 + k * 1024); } while (0)
#define PG8_MMA(ai, bj, At, Bt) do { __builtin_amdgcn_s_setprio(1); _Pragma("unroll") for (int m = 0; m < 4; ++m) _Pragma("unroll") for (int n = 0; n < 2; ++n) _Pragma("unroll") for (int k = 0; k < 2; ++k) \
    acc[ai][bj][m][n] = __builtin_amdgcn_mfma_f32_16x16x32_bf16(Bt[n][k], At[m][k], acc[ai][bj][m][n], 0, 0, 0); __builtin_amdgcn_s_setprio(0); } while (0)
#define PG8_WAIT_V(n) asm volatile("s_waitcnt vmcnt(" #n ")" ::: "memory")
#define PG8_WAIT_L(n) asm volatile("s_waitcnt lgkmcnt(" #n ")" ::: "memory")
#define PG8_BAR __builtin_amdgcn_s_barrier()
#define PG8_SCHED __builtin_amdgcn_sched_barrier(0)
  Unit cur, nxt; int ui = 0;
  if (!S.next(0, cur)) return;
  f32x4 acc[2][2][4][2];
#pragma unroll
  for (int a = 0; a < 2; ++a)
#pragma unroll
    for (int b = 0; b < 2; ++b)
#pragma unroll
      for (int m = 0; m < 4; ++m)
#pragma unroll
        for (int n = 0; n < 2; ++n) acc[a][b][m][n] = (f32x4){0.f, 0.f, 0.f, 0.f};
  bf16x8 At[4][2], B0[2][2], B1[2][2];
  const char* cA = (const char*)g.A + (size_t)cur.pm * tstep; const char* cB = (const char*)g.Bt + (size_t)cur.pn * tstep;
  PG8_STAGE(PG8_SB(0, 0), cB, voffB); PG8_STAGE(PG8_SA(0, 0), cA, voffA); PG8_STAGE(PG8_SB(0, 1), cB + hstep, voffB); PG8_STAGE(PG8_SA(0, 1), cA + hstep, voffA);
  if (wr == 1) PG8_BAR;
  PG8_WAIT_V(4); PG8_BAR;
  PG8_STAGE(PG8_SB(1, 0), cB + kstep, voffB); PG8_STAGE(PG8_SA(1, 0), cA + kstep, voffA); PG8_STAGE(PG8_SB(1, 1), cB + hstep + kstep, voffB);
  PG8_WAIT_V(6); PG8_BAR;
  for (;;) {
    const bool has_next = S.next(ui + 1, nxt);
    const char* nA = has_next ? (const char*)g.A + (size_t)nxt.pm * tstep : cA; const char* nB = has_next ? (const char*)g.Bt + (size_t)nxt.pn * tstep : cB;
    for (int t = 0; t < nt; t += 2) {
      const bool last = (t == nt - 2);
      const char* a1 = cA + (size_t)(t + 1) * kstep;
      const char* a2 = last ? nA : cA + (size_t)(t + 2) * kstep; const char* b2 = last ? nB : cB + (size_t)(t + 2) * kstep;
      const char* a3 = a2 + kstep; const char* b3 = b2 + kstep;
      PG8_LDB(B0, 0, 0); PG8_SCHED; PG8_LDA(At, 0, 0); PG8_STAGE(PG8_SA(1, 1), a1 + hstep, voffA);
      PG8_WAIT_L(8); PG8_BAR; PG8_WAIT_L(0); PG8_MMA(0, 0, At, B0); PG8_BAR; PG8_SCHED;
      PG8_LDB(B1, 0, 1); PG8_STAGE(PG8_SB(0, 0), b2, voffB);
      PG8_BAR; PG8_WAIT_L(0); PG8_MMA(0, 1, At, B1); PG8_BAR;
      PG8_LDA(At, 0, 1); PG8_STAGE(PG8_SA(0, 0), a2, voffA);
      PG8_BAR; PG8_WAIT_L(0); PG8_MMA(1, 0, At, B0); PG8_BAR; PG8_SCHED;
      PG8_STAGE(PG8_SB(0, 1), b2 + hstep, voffB);
      PG8_WAIT_V(6); PG8_BAR; PG8_MMA(1, 1, At, B1); PG8_BAR;
      PG8_LDB(B0, 1, 0); PG8_SCHED; PG8_LDA(At, 1, 0); PG8_STAGE(PG8_SA(0, 1), a2 + hstep, voffA);
      PG8_WAIT_L(8); PG8_BAR; PG8_WAIT_L(0); PG8_MMA(0, 0, At, B0); PG8_BAR; PG8_SCHED;
      PG8_LDB(B1, 1, 1); PG8_STAGE(PG8_SB(1, 0), b3, voffB);
      PG8_BAR; PG8_WAIT_L(0); PG8_MMA(0, 1, At, B1); PG8_BAR;
      PG8_LDA(At, 1, 1); PG8_STAGE(PG8_SA(1, 0), a3, voffA);
      PG8_BAR; PG8_WAIT_L(0); PG8_MMA(1, 0, At, B0); PG8_BAR; PG8_SCHED;
      PG8_STAGE(PG8_SB(1, 1), b3 + hstep, voffB);
      PG8_WAIT_V(6); PG8_BAR; PG8_MMA(1, 1, At, B1); PG8_BAR;
    }
    E(acc, cur, wr, wc, fr, fq);
    if (!has_next) break;
#pragma unroll
    for (int a = 0; a < 2; ++a)
#pragma unroll
      for (int b = 0; b < 2; ++b)
#pragma unroll
        for (int m = 0; m < 4; ++m)
#pragma unroll
          for (int n = 0; n < 2; ++n) acc[a][b][m][n] = (f32x4){0.f, 0.f, 0.f, 0.f};
    cur = nxt; cA = nA; cB = nB; ++ui;
  }
  PG8_WAIT_V(0);
  if (wr == 0) PG8_BAR;
  PG8_BAR;
#undef PG8_SA
#undef PG8_SB
#undef PG8_STAGE
#undef PG8_LDA
#undef PG8_LDB
#undef PG8_MMA
#undef PG8_WAIT_V
#undef PG8_WAIT_L
#undef PG8_BAR
#undef PG8_SCHED
}

struct EpiIn {
  static constexpr bool PERM = true;
  bf16_t* P; int ldp; int odd; float* kout; float* vout; float* ab; bf16_t* halo;
  DI void operator()(const f32x4 (&acc)[2][2][4][2], const Unit& u, int wr, int wc, int fr, int fq) const {
    const int row0 = u.pm * BM + wr * 64 + fr;
    if (odd && u.pn == 16) {
      if (wc == 0) {
#pragma unroll
        for (int ai = 0; ai < 2; ++ai)
#pragma unroll
          for (int m = 0; m < 4; ++m) { const int r = row0 + ai * HALF + m * 16;
#pragma unroll
            for (int n = 0; n < 2; ++n) *(f32x4*)(ab + (size_t)r * 32 + 8 * fq + 4 * n) = acc[ai][0][m][n]; }
      }
      return;
    }
    const int col0 = u.pn * BM + wc * 32 + 8 * fq;
#pragma unroll
    for (int ai = 0; ai < 2; ++ai)
#pragma unroll
      for (int m = 0; m < 4; ++m) {
        const int r = row0 + ai * HALF + m * 16; bf16_t* rowp = P + (size_t)r * ldp + col0;
#pragma unroll
        for (int bj = 0; bj < 2; ++bj) {
          const f32x4 v0 = acc[ai][bj][m][0], v1 = acc[ai][bj][m][1];
          u32x4 w; w.x = cvt_pk_bf16(v0[0], v0[1]); w.y = cvt_pk_bf16(v0[2], v0[3]); w.z = cvt_pk_bf16(v1[0], v1[1]); w.w = cvt_pk_bf16(v1[2], v1[3]);
          *(u32x4*)(rowp + bj * HALF) = w;
          if (odd) {
            const int rc = m * 16 + fr, c = col0 + bj * HALF;
            if (c < 3072 && (rc == 0 || rc >= 62)) { const int slot = rc == 0 ? 0 : rc - 61; *(u32x4*)(halo + ((size_t)(r >> 6) * 3 + slot) * 3072 + c) = w; }
          } else if (u.pn == 6 && r < M_P) {
            float* dst = (bj ? vout : kout) + ((size_t)(r >> 8) * 512 + (r & 255)) * 128 + wc * 32 + 8 * fq;
            *(f32x4*)dst = v0; *(f32x4*)(dst + 4) = v1;
          }
        }
      }
  }
};
struct EpiRes {
  static constexpr bool PERM = false;
  float* x; const float* ga_base; int rbase;
  DI void operator()(const f32x4 (&acc)[2][2][4][2], const Unit& u, int wr, int wc, int fr, int fq) const {
    const int row0 = rbase + u.pm * BM + wr * 64 + fr, col0 = u.pn * BM + wc * 32 + 4 * fq;
    const float* ga = ga_base + (size_t)row_group(rbase + u.pm * BM) * 6144;
    f32x4 gv[2][2];
#pragma unroll
    for (int bj = 0; bj < 2; ++bj)
#pragma unroll
      for (int n = 0; n < 2; ++n) gv[bj][n] = *(const f32x4*)(ga + col0 + bj * HALF + n * 16);
#pragma unroll
    for (int ai = 0; ai < 2; ++ai) {
      f32x4 xv[4][2][2];
#pragma unroll
      for (int m = 0; m < 4; ++m) { const float* rowp = x + (size_t)(row0 + ai * HALF + m * 16) * 1024 + col0;
#pragma unroll
        for (int bj = 0; bj < 2; ++bj)
#pragma unroll
          for (int n = 0; n < 2; ++n) xv[m][bj][n] = *(const f32x4*)(rowp + bj * HALF + n * 16); }
#pragma unroll
      for (int m = 0; m < 4; ++m) { float* rowp = x + (size_t)(row0 + ai * HALF + m * 16) * 1024 + col0;
#pragma unroll
        for (int bj = 0; bj < 2; ++bj)
#pragma unroll
          for (int n = 0; n < 2; ++n) *(f32x4*)(rowp + bj * HALF + n * 16) = xv[m][bj][n] + gv[bj][n] * acc[ai][bj][m][n]; }
    }
  }
};
struct EpiGU {
  static constexpr bool PERM = true;
  bf16_t* act;
  DI void operator()(const f32x4 (&acc)[2][2][4][2], const Unit& u, int wr, int wc, int fr, int fq) const {
    const int row0 = u.pm * BM + wr * 64 + fr, col0 = u.pn * HALF + wc * 32 + 8 * fq;
#pragma unroll
    for (int ai = 0; ai < 2; ++ai)
#pragma unroll
      for (int m = 0; m < 4; ++m) {
        bf16_t* rowp = act + (size_t)(row0 + ai * HALF + m * 16) * DFF + col0;
        float o[8];
#pragma unroll
        for (int n = 0; n < 2; ++n)
#pragma unroll
          for (int j = 0; j < 4; ++j) { const float gt = acc[ai][0][m][n][j], up = acc[ai][1][m][n][j]; o[n * 4 + j] = siluf_(gt) * up; }
        u32x4 w; w.x = cvt_pk_bf16(o[0], o[1]); w.y = cvt_pk_bf16(o[2], o[3]); w.z = cvt_pk_bf16(o[4], o[5]); w.w = cvt_pk_bf16(o[6], o[7]);
        *(u32x4*)rowp = w;
      }
  }
};
}

template <class Epi> DI void run_gemm(lptr lds, const bf16_t* A, const bf16_t* Bt, int N, int K, const Epi& E) {
  pg8::Gemm g; g.A = A; g.Bt = Bt; g.M = M_TOT; g.N = N; g.K = K;
  pg8::StaticOrder S; S.init(M_TOT, N, (int)gridDim.x, (int)bid_opaque());
  pg8::gemm_phase<Epi>(lds, g, S, E);
}
template <class Epi> DI void run_gemm_sub(lptr lds, const bf16_t* A, const bf16_t* Bt, int mrows, int N, int K, const Epi& E, int vb, int nb) {
  pg8::Gemm g; g.A = A; g.Bt = Bt; g.M = mrows; g.N = N; g.K = K;
  pg8::StaticOrder S; S.init(mrows, N, nb, vb);
  pg8::gemm_phase<Epi>(lds, g, S, E);
}
DI void norm_rows(const Params& p, int l, int mode, int row_lo, int row_hi, int vb, int nb) {
  const int tid = tid_opaque(), wid = tid >> 6, lane = tid & 63;
  const float* mod = (const float*)(p.ws + WS_MOD);
  bf16_t* h = (bf16_t*)(p.ws + WS_H);
  const float* gn = mode == 2 ? p.in[12] : (mode ? p.in[11] : p.in[10]) + l * 1024;
  const int rstride = nb * 8;
  f32x4 ggv[4];
#pragma unroll
  for (int i = 0; i < 4; ++i) ggv[i] = *(const f32x4*)(gn + lane * 4 + 256 * i);
  for (int row0 = row_lo + vb * 8 + wid; row0 < row_hi; row0 += 6 * rstride) {
    f32x4 v[6][4]; float ss[6];
#pragma unroll
    for (int q = 0; q < 6; ++q) {
      const int row = row0 + q * rstride < row_hi ? row0 + q * rstride : row0;
      const float* xs = p.out + (size_t)row * 1024;
#pragma unroll
      for (int i = 0; i < 4; ++i) v[q][i] = *(const f32x4*)(xs + lane * 4 + 256 * i);
    }
#pragma unroll
    for (int q = 0; q < 6; ++q) {
      float s = 0.f;
#pragma unroll
      for (int i = 0; i < 4; ++i) s += v[q][i][0] * v[q][i][0] + v[q][i][1] * v[q][i][1] + v[q][i][2] * v[q][i][2] + v[q][i][3] * v[q][i][3];
      ss[q] = wave_sum(s);
    }
#pragma unroll
    for (int q = 0; q < 6; ++q) {
      const int row = row0 + q * rstride;
      if (row < row_hi) {
        const float rstd = rsqrtf(ss[q] * (1.f / 1024.f) + 1e-6f);
        const float* md = mod + ((size_t)l * 9 + row_group(row)) * 6144 + (mode ? 3072 : 0);
#pragma unroll
        for (int i = 0; i < 4; ++i) {
          const int c = lane * 4 + 256 * i;
          const f32x4 gg = ggv[i];
          f32x4 y;
          if (mode == 2) {
#pragma unroll
            for (int j = 0; j < 4; ++j) y[j] = v[q][i][j] * rstd * gg[j];
            *(f32x4*)(p.out + (size_t)row * 1024 + c) = y;
          } else {
            const f32x4 sh = *(const f32x4*)(md + c), sc = *(const f32x4*)(md + 1024 + c);
#pragma unroll
            for (int j = 0; j < 4; ++j) y[j] = v[q][i][j] * rstd * gg[j] * (1.f + sc[j]) + sh[j];
            *(u32x2*)(h + (size_t)row * 1024 + c) = (u32x2){pack2(y[0], y[1]), pack2(y[2], y[3])};
          }
        }
      }
    }
  }
}

DI float gelu_tanh(float x) { const float u = 0.7978845608028654f * (x + 0.044715f * x * x * x); const float t = 1.f - 2.f * __builtin_amdgcn_rcpf(1.f + __expf(2.f * u)); return 0.5f * x * (1.f + t); }
DI void rg_phase(const Params& p, lptr lds, int l, int mode) {
  const int tid = tid_opaque(), wid = tid >> 6, lane = tid & 63;
  const int i2 = l >> 1, bid = bid_opaque(), G = gridDim.x;
  const int n = bid & 7;
  const bf16_t* P = (const bf16_t*)(p.ws + WS_P);
  bf16_t* Y = (bf16_t*)(p.ws + WS_H);
  float* carry = (float*)(p.ws + WS_CARRY);
  constexpr int SUB = 74752;
  LAS float* Pf = (LAS float*)(lds + 2 * SUB);
  const int ct = tid >> 3, c8 = (tid & 7) * 8, chc = n * 64 + c8;
  LAS float* cwl = (LAS float*)(lds + 2 * SUB + 8192);
  if (tid < 320) { const int j = tid >> 6, c = tid & 63; cwl[tid] = j < 4 ? p.in[14][((size_t)i2 * 4 + j) * 512 + n * 64 + c] : p.in[15][i2 * 512 + n * 64 + c]; }
  __syncthreads();
  const int gdir = wid >> 2, gdt = (wid >> 1) & 1, gt2 = wid & 1, r = lane & 31, hh = lane >> 5;
  bf16x8 wa[4], wx[4];
  {
    const bf16_t* rgw = (const bf16_t*)(p.ws + WS_RGW);
    const bf16_t* wap = rgw + ((size_t)(gdir * 2 + 0) * 8 + n) * 4096 + (gdt * 32 + r) * 64 + 8 * hh;
    const bf16_t* wxp = rgw + ((size_t)(gdir * 2 + 1) * 8 + n) * 4096 + (gdt * 32 + r) * 64 + 8 * hh;
#pragma unroll
    for (int s = 0; s < 4; ++s) { wa[s] = *(const bf16x8*)(wap + 16 * s); wx[s] = *(const bf16x8*)(wxp + 16 * s); }
  }
  const int gd = gdt * 32 + r, gpi = (i2 * 2 + gdir) * 512 + n * 64 + gd;
  const float ba = p.in[17][gpi], bx = p.in[19][gpi], sp8 = -8.f * softplusf_(-p.in[20][gpi]);
  u32x4 praw[2][4], pgr[2];
  pgr[0] = pgr[1] = (u32x4){0u, 0u, 0u, 0u};
#define RG_PREFETCH(s_, item_) do { const int tt_ = (item_) >> 3; const int row0_ = tt_ * 64; \
    const int ti_ = tt_ < 64 ? (tt_ & 3) : ((tt_ - 64) & 63); const int nt_ = tt_ < 64 ? 4 : 64; \
    _Pragma("unroll") for (int j_ = 0; j_ < 4; ++j_) { const int tl_ = ti_ * 64 + ct + j_ - 2; const bool ok_ = tl_ >= 0 && tl_ < nt_ * 64; \
      const u32x4 v_ = *(const u32x4*)(P + (size_t)(row0_ + (ok_ ? ct + j_ - 2 : ct)) * EVEN_IN + chc); praw[s_][j_] = ok_ ? v_ : (u32x4){0u, 0u, 0u, 0u}; } \
    if (mode == 1) pgr[s_] = *(const u32x4*)(P + (size_t)(row0_ + ct) * EVEN_IN + 512 + chc); } while (0)
  if (bid < 4608) RG_PREFETCH(0, bid);
  if (bid + G < 4608) RG_PREFETCH(1, bid + G);
  for (int item0 = bid; item0 < 4608; item0 += 2 * G) {
    const int nsub = item0 + G < 4608 ? 2 : 1;
    u32x4 gr_cur[2];
#pragma unroll
    for (int s = 0; s < 2; ++s) {
      if (s < nsub) {
        const int tt = (item0 + s * G) >> 3;
        const int ti = tt < 64 ? (tt & 3) : ((tt - 64) & 63), ntile = tt < 64 ? 4 : 64;
        LAS bf16_t* Xc = (LAS bf16_t*)(lds + s * SUB);
        float ca[16], cbv[16];
        if (mode == 1) {
          const int q4 = tid >> 7, dir = (tid >> 6) & 1, d = tid & 63, ch = n * 64 + d, tbase = tt - ti;
#pragma unroll
          for (int jj = 0; jj < 16; ++jj) {
            const int j = dir ? (16 * q4 + 15 - jj) : (16 * q4 + jj);
            const bool valid = dir ? (j > ti && j < ntile) : (j < ti);
            const int jc = valid ? j : ti;
            const size_t o = ((size_t)((tbase + jc) * 2 + dir) * 2) * 512 + ch;
            const float va = carry[o], vb = carry[o + 512];
            ca[jj] = valid ? va : 1.f; cbv[jj] = valid ? vb : 0.f;
          }
        }
        {
          const f32x4 b0 = *(const LAS f32x4*)(cwl + 256 + c8), b1 = *(const LAS f32x4*)(cwl + 256 + c8 + 4);
          float a[8] = {b0[0], b0[1], b0[2], b0[3], b1[0], b1[1], b1[2], b1[3]};
#pragma unroll
          for (int j = 0; j < 4; ++j) {
            const u32x4 raw = praw[s][j];
            const f32x4 w0 = *(const LAS f32x4*)(cwl + j * 64 + c8), w1 = *(const LAS f32x4*)(cwl + j * 64 + c8 + 4);
            a[0] += w0[0] * lo2f(raw.x); a[1] += w0[1] * hi2f(raw.x); a[2] += w0[2] * lo2f(raw.y); a[3] += w0[3] * hi2f(raw.y);
            a[4] += w1[0] * lo2f(raw.z); a[5] += w1[1] * hi2f(raw.z); a[6] += w1[2] * lo2f(raw.w); a[7] += w1[3] * hi2f(raw.w);
          }
          *(LAS u32x4*)(Xc + ct * 72 + c8) = (u32x4){pack2(a[0], a[1]), pack2(a[2], a[3]), pack2(a[4], a[5]), pack2(a[6], a[7])};
        }
        gr_cur[s] = pgr[s];
        if (mode == 1) {
          const int q4 = tid >> 7, dir = (tid >> 6) & 1, d = tid & 63;
          float A = 1.f, B = 0.f;
#pragma unroll
          for (int jj = 0; jj < 16; ++jj) { B = ca[jj] * B + cbv[jj]; A = ca[jj] * A; }
          Pf[s * 1024 + (q4 * 2 + dir) * 64 + d] = A; Pf[s * 1024 + 512 + (q4 * 2 + dir) * 64 + d] = B;
        }
      }
      __builtin_amdgcn_sched_barrier(0);
    }
    __syncthreads();
#pragma unroll 1
    for (int s = 0; s < 2; ++s) {
      if (s < nsub) {
        LAS bf16_t* Xc = (LAS bf16_t*)(lds + s * SUB);
        LAS float* Aa = (LAS float*)(lds + s * SUB + 9216); LAS float* Bb = (LAS float*)(lds + s * SUB + 41984);
        f32x16 ga = zero16(), gx = zero16();
#pragma unroll
        for (int ks = 0; ks < 4; ++ks) {
          const bf16x8 a = *(const LAS bf16x8*)(Xc + (gt2 * 32 + r) * 72 + 16 * ks + 8 * hh);
          ga = MFMA32(a, wa[ks], ga); gx = MFMA32(a, wx[ks], gx);
        }
        float xcv[16];
#pragma unroll
        for (int ii = 0; ii < 16; ++ii) xcv[ii] = bf2f(Xc[(gt2 * 32 + crow(ii, hh)) * 72 + gd]);
#pragma unroll
        for (int ii = 0; ii < 16; ++ii) {
          const int t = gt2 * 32 + crow(ii, hh);
          const float rr = sigmoidf_(ga[ii] + ba), iv = sigmoidf_(gx[ii] + bx);
          const float la = rr * sp8, a = __expf(la), x2 = 2.f * la;
          const float om = x2 > -0.25f ? -x2 * (1.f + x2 * (0.5f + x2 * (0.16666667f + x2 * (0.041666668f + x2 * 0.0083333338f)))) : 1.f - __expf(x2);
          const float bb = __builtin_amdgcn_sqrtf(fmaxf(om, 0.f)) * (iv * xcv[ii]);
          Aa[(gdir * 64 + t) * 64 + gd] = a; Bb[(gdir * 64 + t) * 64 + gd] = bb;
        }
      }
    }
    __syncthreads();
    if (item0 + 2 * G < 4608) RG_PREFETCH(0, item0 + 2 * G);
    if (item0 + 3 * G < 4608) RG_PREFETCH(1, item0 + 3 * G);
    if (tid < 128 * nsub) {
      const int s = tid >> 7, dir = (tid >> 6) & 1, d = tid & 63, ch = n * 64 + d;
      const int tt = (item0 + s * G) >> 3;
      const int ti = tt < 64 ? (tt & 3) : ((tt - 64) & 63), ntile = tt < 64 ? 4 : 64;
      const int seq = tt < 64 ? (tt >> 2) : 16 + ((tt - 64) >> 6);
      LAS float* Aa = (LAS float*)(lds + s * SUB + 9216); LAS float* Bb = (LAS float*)(lds + s * SUB + 41984);
      if (mode == 0) {
        float A = 1.f, B = 0.f;
#pragma unroll 8
        for (int st = 0; st < 64; ++st) { const int t = dir ? 63 - st : st; const float a = Aa[(dir * 64 + t) * 64 + d], b = Bb[(dir * 64 + t) * 64 + d]; A *= a; B = a * B + b; }
        carry[((size_t)(tt * 2 + dir) * 2 + 0) * 512 + ch] = A; carry[((size_t)(tt * 2 + dir) * 2 + 1) * 512 + ch] = B;
      } else {
        float h = (tt < 64) ? 0.f : p.in[5][(((size_t)(seq - 16) * 2 + i2) * 2 + dir) * 512 + ch];
#pragma unroll
        for (int qq = 0; qq < 4; ++qq) { const int q4 = dir ? 3 - qq : qq; h = Pf[s * 1024 + (q4 * 2 + dir) * 64 + d] * h + Pf[s * 1024 + 512 + (q4 * 2 + dir) * 64 + d]; }
#pragma unroll 8
        for (int st = 0; st < 64; ++st) { const int t = dir ? 63 - st : st; h = Aa[(dir * 64 + t) * 64 + d] * h + Bb[(dir * 64 + t) * 64 + d]; Aa[(dir * 64 + t) * 64 + d] = h; }
        if (tt < 64 && ((dir == 0 && ti == ntile - 1) || (dir == 1 && ti == 0))) p.out[OFF_RG + (((size_t)seq * 2 + i2) * 2 + dir) * 512 + ch] = h;
      }
    }
    if (mode == 1) {
      __syncthreads();
#pragma unroll
      for (int s = 0; s < 2; ++s) {
        if (s < nsub) {
          const int row0 = ((item0 + s * G) >> 3) * 64;
          const LAS float* Hf = (const LAS float*)(lds + s * SUB + 9216); const LAS float* Hb = Hf + 4096;
          const u32x4 raw = gr_cur[s];
          float gr[8] = {lo2f(raw.x), hi2f(raw.x), lo2f(raw.y), hi2f(raw.y), lo2f(raw.z), hi2f(raw.z), lo2f(raw.w), hi2f(raw.w)};
          float y[8];
#pragma unroll
          for (int e = 0; e < 8; ++e) y[e] = (Hf[ct * 64 + c8 + e] + Hb[ct * 64 + c8 + e]) * gelu_tanh(gr[e]);
          *(u32x4*)(Y + (size_t)(row0 + ct) * 1024 + n * 64 + c8) = (u32x4){pack2(y[0], y[1]), pack2(y[2], y[3]), pack2(y[4], y[5]), pack2(y[6], y[7])};
        }
      }
    }
    __syncthreads();
  }
#undef RG_PREFETCH
}

DI void att_item(const Params& p, lptr lds, int l, int item) {
  const int tid = tid_opaque(), wid = tid >> 6, lane = tid & 63, q = lane & 31, hh = lane >> 5;
  const int i2 = l >> 1;
  const bool samp = item < 1024;
  int b, kvh, qt, rowbase;
  if (samp) { b = item >> 7; kvh = (item >> 6) & 1; qt = item & 63; rowbase = M_P + b * 4096; }
  else { const int j = item - 1024; b = j >> 3; kvh = (j >> 2) & 1; qt = j & 3; rowbase = b * 256; }
  const bf16_t* P = (const bf16_t*)(p.ws + WS_P);
  bf16_t* Y = (bf16_t*)(p.ws + WS_H);
  const float* rc = (const float*)(p.ws + WS_ROPE); const float* rs = rc + 4096 * 32;
  LAS bf16_t* Ks = (LAS bf16_t*)lds; LAS bf16_t* Vt = (LAS bf16_t*)(lds + 9216);
  const int head = kvh * 4 + (wid >> 1);
  const int qpos = qt * 64 + 32 * (wid & 1) + q;
  bf16x8 Qf[4];
  {
    const bf16_t* qp = P + (size_t)(rowbase + qpos) * EVEN_IN + 1024 + head * 64 + 8 * hh;
    float qv[4][8];
#pragma unroll
    for (int s = 0; s < 4; ++s) { const u32x4 raw = *(const u32x4*)(qp + 16 * s);
      qv[s][0] = lo2f(raw.x); qv[s][1] = hi2f(raw.x); qv[s][2] = lo2f(raw.y); qv[s][3] = hi2f(raw.y); qv[s][4] = lo2f(raw.z); qv[s][5] = hi2f(raw.z); qv[s][6] = lo2f(raw.w); qv[s][7] = hi2f(raw.w); }
    if (samp) {
#pragma unroll
      for (int pr = 0; pr < 2; ++pr)
#pragma unroll
        for (int j = 0; j < 8; ++j) { const int f = 16 * pr + 8 * hh + j; const float c = rc[qpos * 32 + f], sn = rs[qpos * 32 + f];
          const float x1 = qv[2 * pr][j], x2 = qv[2 * pr + 1][j]; qv[2 * pr][j] = x1 * c - x2 * sn; qv[2 * pr + 1][j] = x1 * sn + x2 * c; }
    }
#pragma unroll
    for (int s = 0; s < 4; ++s) { const float qs = 0.125f * 1.44269504088896341f;
      u32x4 w; w.x = pack2(qv[s][0] * qs, qv[s][1] * qs); w.y = pack2(qv[s][2] * qs, qv[s][3] * qs); w.z = pack2(qv[s][4] * qs, qv[s][5] * qs); w.w = pack2(qv[s][6] * qs, qv[s][7] * qs); Qf[s] = __builtin_bit_cast(bf16x8, w); }
  }
  float m_run = p.in[21][i2 * 8 + head] * 1.44269504088896341f, l_run = hh == 0 ? 1.f : 0.f;
  f32x16 o0 = zero16(), o1 = zero16();
  const int nctx = samp ? 8 : 0;
  int w0, w1; if (samp) { w0 = qt - 2 < 0 ? 0 : qt - 2; w1 = qt + 2 > 63 ? 63 : qt + 2; } else { w0 = 0; w1 = 3; }
  const int ntiles = nctx + (w1 - w0 + 1);
  const bool isK = tid < 256;
  const int skey = (tid & 255) >> 2, spc = tid & 3;
  const int sd0 = isK ? (spc & 1) * 8 + (spc >> 1) * 32 : spc * 16;
  const int so1 = isK ? 16 : 8;
  f32x4 pc4[4]; u32x4 pw2[2]; f32x4 prc[4];
#define ATT_PREFETCH(kt_) do { const bool ctx_ = (kt_) < nctx; const int wt_ = w0 + ((kt_) - nctx); \
    if (ctx_) { const float* sp_ = (isK ? p.in[3] : p.in[4]) + (((size_t)(b * 2 + i2) * 512 + (kt_) * 64 + skey) * 2 + kvh) * 64 + sd0; \
      pc4[0] = *(const f32x4*)sp_; pc4[1] = *(const f32x4*)(sp_ + 4); pc4[2] = *(const f32x4*)(sp_ + so1); pc4[3] = *(const f32x4*)(sp_ + so1 + 4); } \
    else { const bf16_t* sp_ = P + (size_t)(rowbase + wt_ * 64 + skey) * EVEN_IN + (isK ? 1536 : 1664) + kvh * 64 + sd0; \
      pw2[0] = *(const u32x4*)sp_; pw2[1] = *(const u32x4*)(sp_ + so1); \
      if (samp && isK) { const int kpos_ = wt_ * 64 + skey, fb_ = (sd0 & 8) + (sd0 >= 32 ? 16 : 0); \
        prc[0] = *(const f32x4*)(rc + kpos_ * 32 + fb_); prc[1] = *(const f32x4*)(rc + kpos_ * 32 + fb_ + 4); \
        prc[2] = *(const f32x4*)(rs + kpos_ * 32 + fb_); prc[3] = *(const f32x4*)(rs + kpos_ * 32 + fb_ + 4); } } } while (0)
  ATT_PREFETCH(0);
  for (int kt = 0; kt < ntiles; ++kt) {
    const bool ctx = kt < nctx; const int wt = w0 + (kt - nctx);
    __syncthreads();
    {
      float x1[8], x2[8];
      if (ctx) {
#pragma unroll
        for (int e = 0; e < 4; ++e) { x1[e] = pc4[0][e]; x1[4 + e] = pc4[1][e]; x2[e] = pc4[2][e]; x2[4 + e] = pc4[3][e]; }
      } else {
        const u32x4 r1 = pw2[0], r2 = pw2[1];
        x1[0] = lo2f(r1.x); x1[1] = hi2f(r1.x); x1[2] = lo2f(r1.y); x1[3] = hi2f(r1.y); x1[4] = lo2f(r1.z); x1[5] = hi2f(r1.z); x1[6] = lo2f(r1.w); x1[7] = hi2f(r1.w);
        x2[0] = lo2f(r2.x); x2[1] = hi2f(r2.x); x2[2] = lo2f(r2.y); x2[3] = hi2f(r2.y); x2[4] = lo2f(r2.z); x2[5] = hi2f(r2.z); x2[6] = lo2f(r2.w); x2[7] = hi2f(r2.w);
        if (samp && isK) {
#pragma unroll
          for (int j = 0; j < 8; ++j) { const float c = prc[j >> 2][j & 3], sn = prc[2 + (j >> 2)][j & 3]; const float a = x1[j], bb = x2[j]; x1[j] = a * c - bb * sn; x2[j] = a * sn + bb * c; }
        }
      }
      if (isK) {
        *(LAS u32x4*)(Ks + skey * 72 + sd0) = (u32x4){pack2(x1[0], x1[1]), pack2(x1[2], x1[3]), pack2(x1[4], x1[5]), pack2(x1[6], x1[7])};
        *(LAS u32x4*)(Ks + skey * 72 + sd0 + 16) = (u32x4){pack2(x2[0], x2[1]), pack2(x2[2], x2[3]), pack2(x2[4], x2[5]), pack2(x2[6], x2[7])};
      } else {
#pragma unroll
        for (int e = 0; e < 8; ++e) { Vt[(sd0 + e) * 72 + skey] = f2bf(x1[e]); Vt[(sd0 + 8 + e) * 72 + skey] = f2bf(x2[e]); }
      }
    }
    __syncthreads();
    if (kt + 1 < ntiles) ATT_PREFETCH(kt + 1);
#pragma unroll
    for (int ks = 0; ks < 2; ++ks) {
      f32x16 sacc = zero16();
#pragma unroll
      for (int s = 0; s < 4; ++s) { const bf16x8 a = *(const LAS bf16x8*)(Ks + (32 * ks + q) * 72 + 16 * s + 8 * hh); sacc = MFMA32(a, Qf[s], sacc); }
      if (!ctx && samp) {
        const int kbase = wt * 64 + 32 * ks;
#pragma unroll
        for (int ii = 0; ii < 16; ++ii) { const int dl = qpos - (kbase + crow(ii, hh)); if (dl > 128 || dl < -128) sacc[ii] = -1e30f; }
      }
      float mx = sacc[0];
#pragma unroll
      for (int ii = 1; ii < 16; ++ii) mx = fmaxf(mx, sacc[ii]);
      mx = fmaxf(mx, __shfl_xor(mx, 32));
      if (__any(mx > m_run)) {
        const float m_new = fmaxf(m_run, mx), alpha = __builtin_amdgcn_exp2f(m_run - m_new); m_run = m_new;
        l_run *= alpha;
#pragma unroll
        for (int ii = 0; ii < 16; ++ii) { o0[ii] *= alpha; o1[ii] *= alpha; }
      }
      float pv[16], ps = 0.f;
#pragma unroll
      for (int ii = 0; ii < 16; ++ii) { pv[ii] = __builtin_amdgcn_exp2f(sacc[ii] - m_run); ps += pv[ii]; }
      l_run += ps;
#pragma unroll
      for (int s2 = 0; s2 < 2; ++s2) {
        u32x4 pw; pw.x = pack2(pv[8 * s2], pv[8 * s2 + 1]); pw.y = pack2(pv[8 * s2 + 2], pv[8 * s2 + 3]); pw.z = pack2(pv[8 * s2 + 4], pv[8 * s2 + 5]); pw.w = pack2(pv[8 * s2 + 6], pv[8 * s2 + 7]);
        const bf16x8 bfrag = __builtin_bit_cast(bf16x8, pw);
        {
          const LAS bf16_t* vp = Vt + q * 72 + 32 * ks + 16 * s2 + 4 * hh;
          const u32x2 lo = *(const LAS u32x2*)vp, hi = *(const LAS u32x2*)(vp + 8);
          o0 = MFMA32(__builtin_bit_cast(bf16x8, ((u32x4){lo.x, lo.y, hi.x, hi.y})), bfrag, o0);
        }
        {
          const LAS bf16_t* vp = Vt + (32 + q) * 72 + 32 * ks + 16 * s2 + 4 * hh;
          const u32x2 lo = *(const LAS u32x2*)vp, hi = *(const LAS u32x2*)(vp + 8);
          o1 = MFMA32(__builtin_bit_cast(bf16x8, ((u32x4){lo.x, lo.y, hi.x, hi.y})), bfrag, o1);
        }
      }
    }
  }
#undef ATT_PREFETCH
  const float inv = 1.f / (l_run + __shfl_xor(l_run, 32));
  bf16_t* yp = Y + (size_t)(rowbase + qpos) * 1024 + 512 + head * 64;
#pragma unroll
  for (int g = 0; g < 4; ++g) {
    *(u32x2*)(yp + 8 * g + 4 * hh) = (u32x2){pack2(o0[4 * g] * inv, o0[4 * g + 1] * inv), pack2(o0[4 * g + 2] * inv, o0[4 * g + 3] * inv)};
    *(u32x2*)(yp + 32 + 8 * g + 4 * hh) = (u32x2){pack2(o1[4 * g] * inv, o1[4 * g + 1] * inv), pack2(o1[4 * g + 2] * inv, o1[4 * g + 3] * inv)};
  }
  __syncthreads();
}

DI float wave_incl_scan(float v, int lane) {
#pragma unroll
  for (int o = 1; o < 64; o <<= 1) { const float t = __shfl_up(v, o); if (lane >= o) v += t; }
  return v;
}
DI void dn1_phase(const Params& p, lptr lds, int l) {
  const int tid = tid_opaque(), wid = tid >> 6, lane = tid & 63;
  const int i2 = l >> 1, bid = bid_opaque(), G = gridDim.x, hd = bid & 7;
  bf16_t* P = (bf16_t*)(p.ws + WS_P);
  const bf16_t* halo = (const bf16_t*)(p.ws + WS_HALO);
  const float* ab = (const float*)(p.ws + WS_AB);
  LAS bf16_t* Raw = (LAS bf16_t*)lds;
  LAS float* X = (LAS float*)lds;
  LAS bf16_t* Kn = (LAS bf16_t*)(lds + 51456);
  LAS float* KK = (LAS float*)(lds + 68864);
  LAS float* Lm = (LAS float*)(lds + 85248);
  LAS float* gcs = (LAS float*)(lds + 118016);
  LAS float* bts = (LAS float*)(lds + 118528);
  const float alog0 = -__expf(p.in[25][(i2 * 2 + (wid & 1)) * 8 + hd]), dtb0 = p.in[26][(i2 * 2 + (wid & 1)) * 8 + hd];
  LAS float* cwl = (LAS float*)(lds + 131072);
  for (int e = tid; e < 1536; e += 512) { const int part = e >> 9, j = (e >> 7) & 3, c = e & 127; cwl[e] = p.in[24][((size_t)i2 * 4 + j) * 3072 + part * 1024 + hd * 128 + c]; }
  __syncthreads();
  u32x4 rv[7]; float pa0 = 0.f, pa1 = 0.f;
#define DN1_PREFETCH(item_) do { const int ck_ = (item_) >> 3; const int row0_ = ck_ * 64; \
    const int ci_ = ck_ < 64 ? (ck_ & 3) : ((ck_ - 64) & 63); const int nch_ = ck_ < 64 ? 4 : 64; \
    _Pragma("unroll") for (int k_ = 0; k_ < 7; ++k_) { \
      int e_ = tid + 512 * k_; if (e_ > 3215) e_ = 3215; \
      const int part_ = e_ / 1072, rem_ = e_ % 1072, rr_ = rem_ >> 4, pc_ = rem_ & 15, col_ = part_ * 1024 + hd * 128 + pc_ * 8; \
      const bool mid_ = rr_ >= 2 && rr_ < 66; \
      const bool zero_ = (rr_ < 2 && ci_ == 0) || (rr_ >= 66 && ci_ == nch_ - 1); \
      const bf16_t* srcp_ = mid_ ? P + (size_t)(row0_ + rr_ - 2) * ODD_LD + col_ \
                               : (rr_ < 2 ? halo + ((size_t)(ck_ - 1) * 3 + 1 + rr_) * 3072 + col_ : halo + ((size_t)(ck_ + 1) * 3) * 3072 + col_); \
      if (zero_) srcp_ = P + (size_t)row0_ * ODD_LD + col_; \
      u32x4 v_ = *(const u32x4*)srcp_; \
      if (zero_) v_ = (u32x4){0u, 0u, 0u, 0u}; \
      rv[k_] = v_; } \
    if (wid < 2) { const int t_ = wid ? 63 - lane : lane; pa0 = ab[(size_t)(row0_ + t_) * 32 + wid * 8 + hd]; pa1 = ab[(size_t)(row0_ + t_) * 32 + 16 + wid * 8 + hd]; } } while (0)
  if (bid < 4608) DN1_PREFETCH(bid);
  for (int item = bid; item < 4608; item += G) {
  const int ck = item >> 3;
  const int row0 = ck * 64;
  {
#pragma unroll
    for (int k = 0; k < 7; ++k) {
      int e = tid + 512 * k; if (e > 3215) e = 3215;
      const int part = e / 1072, rem = e % 1072, rr = rem >> 4, pc = rem & 15;
      *(LAS u32x4*)(Raw + (part * 67 + rr) * 128 + pc * 8) = rv[k];
    }
  }
  const float a0 = pa0, a1 = pa1;
  __syncthreads();
  if (item + G < 4608) DN1_PREFETCH(item + G);
#pragma unroll 2
  for (int tk = 0; tk < 6; ++tk) {
    const int task = tid + 512 * tk;
    const int c8i = task & 15, rp = task >> 4, part = tk >> 1, t = rp & 63, col = part * 1024 + hd * 128 + c8i * 8;
    float y[8];
#pragma unroll
    for (int e = 0; e < 8; ++e) y[e] = 0.f;
#pragma unroll
    for (int j = 0; j < 4; ++j) {
      const u32x4 raw = *(const LAS u32x4*)(Raw + (part * 67 + t + j) * 128 + c8i * 8);
      const f32x4 cw0 = *(const LAS f32x4*)(cwl + (part * 4 + j) * 128 + c8i * 8), cw1 = *(const LAS f32x4*)(cwl + (part * 4 + j) * 128 + c8i * 8 + 4);
      y[0] += cw0[0] * lo2f(raw.x); y[1] += cw0[1] * hi2f(raw.x); y[2] += cw0[2] * lo2f(raw.y); y[3] += cw0[3] * hi2f(raw.y);
      y[4] += cw1[0] * lo2f(raw.z); y[5] += cw1[1] * hi2f(raw.z); y[6] += cw1[2] * lo2f(raw.w); y[7] += cw1[3] * hi2f(raw.w);
    }
    float ss = 0.f;
#pragma unroll
    for (int e = 0; e < 8; ++e) { y[e] = siluf_(y[e]); ss += y[e] * y[e]; }
    if (part < 2) {
      ss += __shfl_xor(ss, 1); ss += __shfl_xor(ss, 2); ss += __shfl_xor(ss, 4); ss += __shfl_xor(ss, 8);
      const float sc = rsqrtf(ss + 1e-6f) * (part == 0 ? 0.08838834764831845f : 1.f);
#pragma unroll
      for (int e = 0; e < 8; ++e) y[e] *= sc;
    }
    const u32x4 w = (u32x4){pack2(y[0], y[1]), pack2(y[2], y[3]), pack2(y[4], y[5]), pack2(y[6], y[7])};
    *(u32x4*)(P + (size_t)(row0 + t) * ODD_LD + col) = w;
    if (part == 1) *(LAS u32x4*)(Kn + t * 136 + c8i * 8) = w;
  }
  if (wid < 2) {
    const int dir = wid;
    const float g = alog0 * softplusf_(a0 + dtb0);
    const float gcv = wave_incl_scan(g, lane), btv = sigmoidf_(a1);
    gcs[dir * 64 + lane] = gcv; bts[dir * 64 + lane] = btv;
    float* gcb = (float*)(p.ws + WS_CARRY) + ((size_t)(ck * 8 + hd) * 2 + dir) * 128;
    gcb[lane] = gcv; gcb[64 + lane] = btv;
  }
  __syncthreads();
  if (wid < 4) {
    const int it = wid >> 1, jt = wid & 1, hh = lane >> 5;
    const f32x16 acc = mm32(Kn + it * 32 * 136, 136, Kn + jt * 32 * 136, 136, 128, zero16(), lane);
#pragma unroll
    for (int ii = 0; ii < 16; ++ii) KK[(it * 32 + crow(ii, hh)) * 64 + jt * 32 + (lane & 31)] = acc[ii];
  }
  __syncthreads();
  for (int e0 = tid; e0 < 8192; e0 += 2048) {
    float wv[4];
#pragma unroll
    for (int k = 0; k < 4; ++k) {
      const int e = e0 + 512 * k, dir = e >> 12, ip = (e >> 6) & 63, jp = e & 63;
      const int ti = dir ? 63 - ip : ip, tj = dir ? 63 - jp : jp;
      const float w = bts[dir * 64 + ip] * KK[ti * 64 + tj] * __expf(fminf(gcs[dir * 64 + ip] - gcs[dir * 64 + jp], 0.f));
      wv[k] = (ip > jp) ? w : 0.f;
    }
#pragma unroll
    for (int k = 0; k < 4; ++k) Lm[e0 + 512 * k] = wv[k];
  }
  __syncthreads();
  for (int e = tid; e < 8192; e += 512) X[e] = 0.f;
  __syncthreads();
  {
    const int d = wid >> 2, bi = wid & 3;
    if (lane < 16) {
      const int c = lane; float x[16];
      const LAS float* L = Lm + d * 4096 + (16 * bi) * 64 + 16 * bi;
#pragma unroll
      for (int i = 0; i < 16; ++i) {
        float s = (c == i) ? 1.f : 0.f;
#pragma unroll
        for (int j = 0; j < i; ++j) s -= L[i * 64 + j] * x[j];
        x[i] = s;
      }
#pragma unroll
      for (int i = 0; i < 16; ++i) X[d * 4096 + (16 * bi + i) * 64 + 16 * bi + c] = x[i];
    }
  }
  __syncthreads();
  LAS float* Tm = (LAS float*)(lds + 119040) + wid * 256;
  for (int dd = 1; dd < 4; ++dd) {
    const int nb = 4 - dd; const bool act = wid < 2 * nb;
    const int d = act ? wid / nb : 0, bi = act ? dd + wid % nb : dd, bj = bi - dd;
    const int lr = lane & 15, lq = lane >> 4;
    if (act) {
      f32x4 acc = (f32x4){0.f, 0.f, 0.f, 0.f};
      for (int kb = bj; kb < bi; ++kb) {
#pragma unroll
        for (int kk = 0; kk < 4; ++kk) {
          const float a = Lm[d * 4096 + (16 * bi + lr) * 64 + 16 * kb + 4 * kk + lq];
          const float b = X[d * 4096 + (16 * kb + 4 * kk + lq) * 64 + 16 * bj + lr];
          acc = __builtin_amdgcn_mfma_f32_16x16x4f32(a, b, acc, 0, 0, 0);
        }
      }
#pragma unroll
      for (int rg = 0; rg < 4; ++rg) Tm[(lq * 4 + rg) * 16 + lr] = acc[rg];
    }
    __syncthreads();
    if (act) {
      f32x4 acc = (f32x4){0.f, 0.f, 0.f, 0.f};
#pragma unroll
      for (int kk = 0; kk < 4; ++kk) {
        const float a = X[d * 4096 + (16 * bi + lr) * 64 + 16 * bi + 4 * kk + lq];
        const float b = Tm[(4 * kk + lq) * 16 + lr];
        acc = __builtin_amdgcn_mfma_f32_16x16x4f32(a, b, acc, 0, 0, 0);
      }
#pragma unroll
      for (int rg = 0; rg < 4; ++rg) X[d * 4096 + (16 * bi + lq * 4 + rg) * 64 + 16 * bj + lr] = -acc[rg];
    }
    __syncthreads();
  }
  {
    bf16_t* Tg = (bf16_t*)(p.ws + WS_T) + ((size_t)(ck * 8 + hd) * 2) * 4096;
    for (int e = tid; e < 4096; e += 512) *(unsigned*)(Tg + 2 * e) = pack2(X[2 * e], X[2 * e + 1]);
  }
  __syncthreads();
  }
#undef DN1_PREFETCH
}

constexpr int DN2_DIR_BYTES = 80896;
DI void dn2_item(const Params& p, lptr lds, int l, int item) {
  const int tid = tid_opaque(), wid = tid >> 6, lane = tid & 63, r = lane & 31, hh = lane >> 5;
  const int i2 = l >> 1;
  const bool samp = item < 256;
  int b, hd, slab, nch, seqrow, ckb;
  if (samp) { b = item >> 5; hd = (item >> 2) & 7; slab = item & 3; nch = 64; seqrow = M_P + b * 4096; ckb = 64 + b * 64; }
  else { const int j = item - 256; b = j >> 5; hd = (j >> 2) & 7; slab = j & 3; nch = 4; seqrow = b * 256; ckb = b * 4; }
  const int dir = wid >> 2, w4 = wid & 3, td = tid & 255;
  const bf16_t* P = (const bf16_t*)(p.ws + WS_P);
  const bf16_t* Tg = (const bf16_t*)(p.ws + WS_T);
  const float* gcbase = (const float*)(p.ws + WS_CARRY);
  bf16_t* O = (bf16_t*)(p.ws + WS_H);
  lptr base = lds + dir * DN2_DIR_BYTES;
  LAS bf16_t* Qn = (LAS bf16_t*)base;
  LAS bf16_t* Kn = (LAS bf16_t*)(base + 17408);
  LAS bf16_t* Tm = (LAS bf16_t*)(base + 34816);
  LAS bf16_t* QK = (LAS bf16_t*)(base + 44032);
  LAS bf16_t* St = (LAS bf16_t*)(base + 53248);
  LAS bf16_t* Rt = (LAS bf16_t*)(base + 61952);
  LAS bf16_t* Vt = (LAS bf16_t*)(base + 66560);
  LAS bf16_t* Vn = (LAS bf16_t*)(base + 71168);
  LAS bf16_t* Vd = (LAS bf16_t*)(base + 75776);
  LAS float* gcs = (LAS float*)(base + 80384);
  LAS float* bts = gcs + 64;
  LAS float* egs = (LAS float*)(lds + 2 * DN2_DIR_BYTES) + dir * 128;
  LAS float* dds = egs + 64;
  f32x16 S;
  const size_t sidx = ((((size_t)(b * 2 + i2) * 2 + dir) * 8 + hd) * 128 + 32 * w4) * 128 + slab * 32 + r;
#pragma unroll
  for (int ii = 0; ii < 16; ++ii) S[ii] = samp ? p.in[6][sidx + (size_t)crow(ii, hh) * 128] : 0.f;
#pragma unroll
  for (int g = 0; g < 4; ++g) *(LAS u32x2*)(St + r * 136 + 32 * w4 + 8 * g + 4 * hh) = (u32x2){pack2(S[4 * g], S[4 * g + 1]), pack2(S[4 * g + 2], S[4 * g + 3])};
  u32x4 pq[4], pk[4], pt[2], pv; float pa0 = 0.f, pa1 = 0.f;
#define DN2_PREFETCH(sn) do { const int cn_ = dir ? nch - 1 - (sn) : (sn); const size_t r0_ = (size_t)seqrow + (size_t)cn_ * 64; \
    _Pragma("unroll") for (int k_ = 0; k_ < 4; ++k_) { const int e_ = td + 256 * k_, ip_ = e_ >> 4, pc_ = e_ & 15; const size_t rg_ = r0_ + (dir ? 63 - ip_ : ip_); \
      pq[k_] = *(const u32x4*)(P + rg_ * ODD_LD + hd * 128 + pc_ * 8); pk[k_] = *(const u32x4*)(P + rg_ * ODD_LD + 1024 + hd * 128 + pc_ * 8); } \
    _Pragma("unroll") for (int k_ = 0; k_ < 2; ++k_) { const int e_ = td + 256 * k_; pt[k_] = *(const u32x4*)(Tg + ((size_t)((ckb + cn_) * 8 + hd) * 2 + dir) * 4096 + e_ * 8); } \
    { const int ip_ = td >> 2, pc_ = td & 3; const size_t rg_ = r0_ + (dir ? 63 - ip_ : ip_); pv = *(const u32x4*)(P + rg_ * ODD_LD + 2048 + hd * 128 + slab * 32 + pc_ * 8); } \
    if (w4 == 0) { const float* gcb_ = gcbase + ((size_t)((ckb + cn_) * 8 + hd) * 2 + dir) * 128; pa0 = gcb_[lane]; pa1 = gcb_[64 + lane]; } } while (0)
  DN2_PREFETCH(0);
  f32x16 o1 = zero16();
  for (int s = 0; s < nch; ++s) {
    const int c = dir ? nch - 1 - s : s;
    const int row0c = seqrow + c * 64;
#pragma unroll
    for (int k = 0; k < 4; ++k) { const int e = td + 256 * k, ip = e >> 4, pc = e & 15; *(LAS u32x4*)(Qn + ip * 136 + pc * 8) = pq[k]; *(LAS u32x4*)(Kn + ip * 136 + pc * 8) = pk[k]; }
#pragma unroll
    for (int k = 0; k < 2; ++k) { const int e = td + 256 * k; *(LAS u32x4*)(Tm + (e >> 3) * 72 + (e & 7) * 8) = pt[k]; }
    { const int ip = td >> 2, pc = td & 3;
      Vt[(pc * 8 + 0) * 72 + ip] = (bf16_t)(pv.x & 0xffffu); Vt[(pc * 8 + 1) * 72 + ip] = (bf16_t)(pv.x >> 16);
      Vt[(pc * 8 + 2) * 72 + ip] = (bf16_t)(pv.y & 0xffffu); Vt[(pc * 8 + 3) * 72 + ip] = (bf16_t)(pv.y >> 16);
      Vt[(pc * 8 + 4) * 72 + ip] = (bf16_t)(pv.z & 0xffffu); Vt[(pc * 8 + 5) * 72 + ip] = (bf16_t)(pv.z >> 16);
      Vt[(pc * 8 + 6) * 72 + ip] = (bf16_t)(pv.w & 0xffffu); Vt[(pc * 8 + 7) * 72 + ip] = (bf16_t)(pv.w >> 16); }
    if (w4 == 0) { gcs[lane] = pa0; bts[lane] = pa1; egs[lane] = __expf(pa0); dds[lane] = __expf(__shfl(pa0, 63) - pa0); }
    __syncthreads();
    if (s + 1 < nch) DN2_PREFETCH(s + 1);
    bf16_t* const orow = O + (size_t)(row0c + (dir ? 63 - (td >> 2) : (td >> 2))) * 1024 + hd * 128 + slab * 32 + (td & 3) * 8;
    u32x4 po = (u32x4){0u, 0u, 0u, 0u};
    if (2 * s >= nch) po = *(const u32x4*)orow;
    {
      const int jt = w4 >> 1, it = w4 & 1;
      const LAS bf16_t* a2 = w4 < 2 ? Qn + w4 * 32 * 136 : Kn + (w4 - 2) * 32 * 136;
      f32x16 acc = zero16(), acc2 = zero16();
      {
        const LAS bf16_t* ap = Kn + jt * 32 * 136 + r * 136 + 8 * hh; const LAS bf16_t* bp = Qn + it * 32 * 136 + r * 136 + 8 * hh;
        const LAS bf16_t* cp = a2 + r * 136 + 8 * hh; const LAS bf16_t* dp = St + r * 136 + 8 * hh;
#pragma unroll 4
        for (int k0 = 0; k0 < 128; k0 += 16) {
          const bf16x8 fa = *(const LAS bf16x8*)(ap + k0), fb = *(const LAS bf16x8*)(bp + k0), fc = *(const LAS bf16x8*)(cp + k0), fd = *(const LAS bf16x8*)(dp + k0);
          acc = MFMA32(fa, fb, acc); acc2 = MFMA32(fc, fd, acc2);
        }
      }
      const int i = it * 32 + r; const float gi = gcs[i];
      f32x4 gjv[4];
#pragma unroll
      for (int g = 0; g < 4; ++g) gjv[g] = *(const LAS f32x4*)(gcs + jt * 32 + 8 * g + 4 * hh);
#pragma unroll
      for (int g = 0; g < 4; ++g) {
        const int j0 = jt * 32 + 8 * g + 4 * hh; float v[4];
        const f32x4 gj = gjv[g];
#pragma unroll
        for (int e = 0; e < 4; ++e) { const float w = acc[4 * g + e] * __expf(fminf(gi - gj[e], 0.f)); v[e] = (i >= j0 + e) ? w : 0.f; }
        *(LAS u32x2*)(QK + i * 72 + j0) = (u32x2){pack2(v[0], v[1]), pack2(v[2], v[3])};
      }
      if (w4 < 2) {
        o1 = acc2;
      } else {
        const int jt2 = w4 - 2;
#pragma unroll
        for (int g = 0; g < 4; ++g) {
          const int j0 = jt2 * 32 + 8 * g + 4 * hh;
          const u32x2 vv = *(const LAS u32x2*)(Vt + r * 72 + j0);
          const float ve[4] = {lo2f(vv.x), hi2f(vv.x), lo2f(vv.y), hi2f(vv.y)}; float rv[4];
          const f32x4 gj4 = *(const LAS f32x4*)(egs + j0), bj4 = *(const LAS f32x4*)(bts + j0);
#pragma unroll
          for (int e = 0; e < 4; ++e) rv[e] = bj4[e] * (ve[e] - gj4[e] * acc2[4 * g + e]);
          *(LAS u32x2*)(Rt + r * 72 + j0) = (u32x2){pack2(rv[0], rv[1]), pack2(rv[2], rv[3])};
        }
      }
    }
    __syncthreads();
    if (w4 >= 2) {
      const int it = w4 - 2;
      const f32x16 acc = mm32(Tm + it * 32 * 72, 72, Rt, 72, 64, zero16(), lane);
      f32x4 ddv[4];
#pragma unroll
      for (int g = 0; g < 4; ++g) ddv[g] = *(const LAS f32x4*)(dds + it * 32 + 8 * g + 4 * hh);
#pragma unroll
      for (int g = 0; g < 4; ++g) {
        const int i0 = it * 32 + 8 * g + 4 * hh; float dv[4];
        const f32x4 gi4 = ddv[g];
#pragma unroll
        for (int e = 0; e < 4; ++e) dv[e] = acc[4 * g + e] * gi4[e];
        *(LAS u32x2*)(Vn + r * 72 + i0) = (u32x2){pack2(acc[4 * g], acc[4 * g + 1]), pack2(acc[4 * g + 2], acc[4 * g + 3])};
        *(LAS u32x2*)(Vd + r * 72 + i0) = (u32x2){pack2(dv[0], dv[1]), pack2(dv[2], dv[3])};
      }
    }
    __syncthreads();
    if (w4 < 2) {
      const int it = w4;
#pragma unroll
      for (int g = 0; g < 4; ++g) { const f32x4 gi4 = *(const LAS f32x4*)(egs + it * 32 + 8 * g + 4 * hh);
#pragma unroll
        for (int e = 0; e < 4; ++e) o1[4 * g + e] *= gi4[e]; }
      o1 = mm32(QK + it * 32 * 72, 72, Vn, 72, 64, o1, lane);
#pragma unroll
      for (int ii = 0; ii < 16; ++ii) Rt[(it * 32 + crow(ii, hh)) * 32 + r] = f2bf(o1[ii]);
    }
    {
      const float gl = egs[63];
#pragma unroll
      for (int ii = 0; ii < 16; ++ii) S[ii] *= gl;
#pragma unroll
      for (int jt = 0; jt < 2; ++jt) {
        unsigned x[16];
#pragma unroll
        for (int ii = 0; ii < 16; ++ii) x[ii] = Kn[(jt * 32 + crow(ii, hh)) * 136 + 32 * w4 + r];
#pragma unroll
        for (int s2 = 0; s2 < 2; ++s2) {
          const u32x4 aw = (u32x4){x[8 * s2] | (x[8 * s2 + 1] << 16), x[8 * s2 + 2] | (x[8 * s2 + 3] << 16), x[8 * s2 + 4] | (x[8 * s2 + 5] << 16), x[8 * s2 + 6] | (x[8 * s2 + 7] << 16)};
          const LAS bf16_t* bp = Vd + r * 72 + jt * 32 + 16 * s2 + 4 * hh;
          const u32x2 lo = *(const LAS u32x2*)bp, hi = *(const LAS u32x2*)(bp + 8);
          S = MFMA32(__builtin_bit_cast(bf16x8, aw), __builtin_bit_cast(bf16x8, ((u32x4){lo.x, lo.y, hi.x, hi.y})), S);
        }
      }
#pragma unroll
      for (int g = 0; g < 4; ++g) *(LAS u32x2*)(St + r * 136 + 32 * w4 + 8 * g + 4 * hh) = (u32x2){pack2(S[4 * g], S[4 * g + 1]), pack2(S[4 * g + 2], S[4 * g + 3])};
    }
    __syncthreads();
    {
      u32x4 ov = *(const LAS u32x4*)(Rt + (td >> 2) * 32 + (td & 3) * 8);
      if (2 * s >= nch) {
        ov.x = pack2(lo2f(ov.x) + lo2f(po.x), hi2f(ov.x) + hi2f(po.x)); ov.y = pack2(lo2f(ov.y) + lo2f(po.y), hi2f(ov.y) + hi2f(po.y));
        ov.z = pack2(lo2f(ov.z) + lo2f(po.z), hi2f(ov.z) + hi2f(po.z)); ov.w = pack2(lo2f(ov.w) + lo2f(po.w), hi2f(ov.w) + hi2f(po.w));
      }
      *(u32x4*)orow = ov;
    }
  }
#undef DN2_PREFETCH
  if (!samp) {
    const size_t oidx = (size_t)OFF_DN + ((((size_t)(b * 2 + i2) * 2 + dir) * 8 + hd) * 128 + 32 * w4) * 128 + slab * 32 + r;
#pragma unroll
    for (int ii = 0; ii < 16; ++ii) p.out[oidx + (size_t)crow(ii, hh) * 128] = S[ii];
  }
}

DI void phase_dn3(const Params& p, int l) {
  const int i2 = l >> 1;
  bf16_t* Y = (bf16_t*)(p.ws + WS_H);
  const bf16_t* P = (const bf16_t*)(p.ws + WS_P);
  const float* gain = p.in[27] + i2 * 128;
  const int tstride = gridDim.x * 512, ntask = M_TOT * 128;
  u32x4 ov[2], zv[2], nov[2], nzv[2];
  int task0 = bid_opaque() * 512 + tid_opaque();
#define DN3_LOAD(ovv, zvv, t0_) do { _Pragma("unroll") for (int q_ = 0; q_ < 2; ++q_) { \
      int task_ = (t0_) + q_ * tstride; if (task_ >= ntask) task_ = bid_opaque() * 512 + tid_opaque(); \
      const int pc_ = task_ & 15, rh_ = task_ >> 4, hd_ = rh_ & 7, row_ = rh_ >> 3, col_ = hd_ * 128 + pc_ * 8; \
      ovv[q_] = *(const u32x4*)(Y + (size_t)row_ * 1024 + col_); zvv[q_] = *(const u32x4*)(P + (size_t)row_ * ODD_LD + 3072 + col_); } } while (0)
  if (task0 < ntask) DN3_LOAD(ov, zv, task0);
  const f32x4 g0 = *(const f32x4*)(gain + (tid_opaque() & 15) * 8), g1 = *(const f32x4*)(gain + (tid_opaque() & 15) * 8 + 4);
  const float gg[8] = {g0[0], g0[1], g0[2], g0[3], g1[0], g1[1], g1[2], g1[3]};
  for (; task0 < ntask; task0 += 2 * tstride) {
    if (task0 + 2 * tstride < ntask) DN3_LOAD(nov, nzv, task0 + 2 * tstride);
#pragma unroll
    for (int q = 0; q < 2; ++q) {
      const int task = task0 + q * tstride;
      const int pc = task & 15, rh = task >> 4, hd = rh & 7, row = rh >> 3, col = hd * 128 + pc * 8;
      float o[8] = {lo2f(ov[q].x), hi2f(ov[q].x), lo2f(ov[q].y), hi2f(ov[q].y), lo2f(ov[q].z), hi2f(ov[q].z), lo2f(ov[q].w), hi2f(ov[q].w)};
      const float z[8] = {lo2f(zv[q].x), hi2f(zv[q].x), lo2f(zv[q].y), hi2f(zv[q].y), lo2f(zv[q].z), hi2f(zv[q].z), lo2f(zv[q].w), hi2f(zv[q].w)};
      float ss = 0.f;
#pragma unroll
      for (int e = 0; e < 8; ++e) ss += o[e] * o[e];
      ss += __shfl_xor(ss, 1); ss += __shfl_xor(ss, 2); ss += __shfl_xor(ss, 4); ss += __shfl_xor(ss, 8);
      const float rstd = rsqrtf(ss * (1.f / 128.f) + 1e-6f);
#pragma unroll
      for (int e = 0; e < 8; ++e) o[e] = o[e] * rstd * gg[e] * siluf_(z[e]);
      if (task < ntask) *(u32x4*)(Y + (size_t)row * 1024 + col) = (u32x4){pack2(o[0], o[1]), pack2(o[2], o[3]), pack2(o[4], o[5]), pack2(o[6], o[7])};
    }
#pragma unroll
    for (int q = 0; q < 2; ++q) { ov[q] = nov[q]; zv[q] = nzv[q]; }
  }
#undef DN3_LOAD
}

constexpr int ROWS_A = 32768;
constexpr int N_PHASES = 1 + 11 + 11 + 10 + 11;
enum { ST_N1, ST_IN, ST_M0, ST_M1, ST_M2, ST_OUTA, ST_OUTB, ST_N2T, ST_GU, ST_DNA, ST_DNB, ST_N1T };
DI void run_phase(const Params& p, lptr lds, int ph) {
  const int G = gridDim.x, bid = bid_opaque();
  if (ph == 0) { phase_pre(p, lds, 0, G == 256 ? 2 : 4, bid, G, true); return; }
  int l, k; { int q = ph - 1; if (q < 11) { l = 0; k = q; } else if (q < 22) { l = 1; k = q - 11; } else if (q < 32) { l = 2; k = q - 22; } else { l = 3; k = q - 32; } }
  const bool odd = l & 1; const int i2 = l >> 1;
  int st;
  if (l == 0) { const int tab[11] = {ST_N1, ST_IN, ST_M0, ST_M1, ST_OUTA, ST_OUTB, ST_N2T, ST_GU, ST_DNA, ST_DNB, ST_N1T}; st = tab[k]; }
  else if (odd) { const int tab[11] = {ST_IN, ST_M0, ST_M1, ST_M2, ST_OUTA, ST_OUTB, ST_N2T, ST_GU, ST_DNA, ST_DNB, ST_N1T}; st = tab[k]; }
  else { const int tab[10] = {ST_IN, ST_M0, ST_M1, ST_OUTA, ST_OUTB, ST_N2T, ST_GU, ST_DNA, ST_DNB, ST_N1T}; st = tab[k]; }
  float* mod = (float*)(p.ws + WS_MOD);
  bf16_t* H = (bf16_t*)(p.ws + WS_H); bf16_t* Pb = (bf16_t*)(p.ws + WS_P);
  if (st == ST_N1) { phase_norm(p, lds, l, 0); return; }
  if (st == ST_IN) {
    pg8::EpiIn E; E.P = Pb; E.ldp = odd ? ODD_LD : EVEN_IN; E.odd = odd ? 1 : 0;
    E.kout = p.out + OFF_K + (size_t)i2 * 256 * 128; E.vout = p.out + OFF_V + (size_t)i2 * 256 * 128;
    E.ab = (float*)(p.ws + WS_AB); E.halo = (bf16_t*)(p.ws + WS_HALO);
    run_gemm(lds, H, (const bf16_t*)(p.ws + WS_WIN), odd ? ODD_NP : EVEN_IN, 1024, E); return;
  }
  if (st == ST_M0 || st == ST_M1 || st == ST_M2) {
    const int ms = st - ST_M0;
    if (ms == 0 && l > 0) { cvt_layer(p, lds, l, 4, bid, G); __syncthreads(); }
    if (!odd) {
      if (ms == 0) {
        for (int it = bid; it < 1152; it += G) att_item(p, lds, l, it);
        rg_phase(p, lds, l, 0);
      } else { rg_phase(p, lds, l, 1); }
    } else {
      if (ms == 0) dn1_phase(p, lds, l);
      else if (ms == 1) {
        for (int it = bid; it < 768; it += G) {
          const int grp = it >> 8, j = it & 255, xcd = j & 7, idx = j >> 3;
          dn2_item(p, lds, l, grp * 256 + ((xcd * 8 + (idx >> 2)) * 4 + (idx & 3))); __syncthreads();
        }
      }
      else phase_dn3(p, l);
    }
    return;
  }
  if (st == ST_OUTA || st == ST_OUTB) {
    pg8::EpiRes E; E.x = p.out; E.ga_base = mod + (size_t)l * 9 * 6144 + 2048;
    if (st == ST_OUTA) { E.rbase = 0; run_gemm_sub(lds, H, (const bf16_t*)(p.ws + WS_WOUT), ROWS_A, 1024, 1024, E, bid, G); return; }
    if (bid < 64) { E.rbase = ROWS_A; run_gemm_sub(lds, H + (size_t)ROWS_A * 1024, (const bf16_t*)(p.ws + WS_WOUT), M_TOT - ROWS_A, 1024, 1024, E, bid, 64); }
    else norm_rows(p, l, 1, 0, ROWS_A, bid - 64, G - 64);
    return;
  }
  if (st == ST_N2T) { norm_rows(p, l, 1, ROWS_A, M_TOT, bid, G); return; }
  if (st == ST_GU) { pg8::EpiGU E; E.act = Pb; run_gemm(lds, H, (const bf16_t*)(p.ws + WS_WGU), 5632, 1024, E); return; }
  if (st == ST_DNA || st == ST_DNB) {
    pg8::EpiRes E; E.x = p.out; E.ga_base = mod + (size_t)l * 9 * 6144 + 5120;
    if (st == ST_DNA) { E.rbase = 0; run_gemm_sub(lds, Pb, (const bf16_t*)(p.ws + WS_WDN), ROWS_A, 1024, DFF, E, bid, G); return; }
    if (bid < 64) { E.rbase = ROWS_A; run_gemm_sub(lds, Pb + (size_t)ROWS_A * DFF, (const bf16_t*)(p.ws + WS_WDN), M_TOT - ROWS_A, 1024, DFF, E, bid, 64); }
    else {
      if (l < 3) { norm_rows(p, l + 1, 0, 0, ROWS_A, bid - 64, G - 64); cvt_layer(p, lds, l + 1, 3, bid - 64, G - 64); if (l == 0 && G == 256) { __syncthreads(); phase_pre(p, lds, 2, 4, bid - 64, G - 64, false); } }
      else norm_rows(p, 0, 2, 0, ROWS_A, bid - 64, G - 64);
    }
    return;
  }
  if (l < 3) norm_rows(p, l + 1, 0, ROWS_A, M_TOT, bid, G); else norm_rows(p, 0, 2, ROWS_A, M_TOT, bid, G);
}

#define XB_TMO      128
#define XB_XCNT(j)  (256  + 64 * (j))
#define XB_XSUB(j)  (1280 + 64 * (j))
#define XB_XGEN(j)  (2304 + 64 * (j))
#define XB_TOP      3328
#define XB_TOPGEN   3392
#define XCD_BAR_WORDS 3456
#define XB_SPIN_CAP (1u << 20)
DI unsigned xb_ld(unsigned* p) { return __hip_atomic_load(p, __ATOMIC_RELAXED, __HIP_MEMORY_SCOPE_AGENT); }
DI unsigned xb_add(unsigned* p, unsigned v) { return __hip_atomic_fetch_add(p, v, __ATOMIC_RELAXED, __HIP_MEMORY_SCOPE_AGENT); }
DI unsigned xb_xcc_id() { return (unsigned)__builtin_amdgcn_s_getreg((3 << 11) | 20) & 0xFu; }
#define XB_SPIN(cond, bar) do { unsigned _sp = 0; while (cond) { __builtin_amdgcn_s_sleep(1); \
    if ((++_sp & 255u) == 0u) { if (xb_ld(&(bar)[XB_TMO])) break; if (_sp > XB_SPIN_CAP) { atomicAdd(&(bar)[XB_TMO], 1u); break; } } } } while (0)
struct XcdBarrier { unsigned* bar; unsigned x; volatile LAS unsigned* st; };
DI XcdBarrier xcd_barrier_post(unsigned* bar, volatile LAS unsigned* st) {
  XcdBarrier b; b.bar = bar; b.x = xb_xcc_id(); b.st = st;
  if (threadIdx.x == 0) (void)xb_add(&bar[XB_XCNT(b.x)], 1u);
  return b;
}
DI void xcd_barrier_complete(unsigned* bar, unsigned x, unsigned& nloc, unsigned& nx) {
  const unsigned G = gridDim.x;
  unsigned sum, cnt, mine, sp = 0u;
  for (;;) {
    sum = 0u; cnt = 0u; mine = 0u;
#pragma unroll
    for (unsigned j = 0; j < 16; ++j) { const unsigned c = xb_ld(&bar[XB_XCNT(j)]); sum += c; cnt += (c > 0u) ? 1u : 0u; mine = (j == x) ? c : mine; }
    if (sum == G) break;
    __builtin_amdgcn_s_sleep(1);
    if ((++sp & 255u) == 0u) { if (xb_ld(&bar[XB_TMO])) break; if (sp > XB_SPIN_CAP) { atomicAdd(&bar[XB_TMO], 1u); break; } }
  }
  nloc = mine > 0u ? mine : 1u; nx = cnt > 0u ? cnt : 1u;
}
DI void xcd_barrier(const XcdBarrier& b) {
  asm volatile("s_waitcnt vmcnt(0)" ::: "memory");
  __syncthreads();
  if (threadIdx.x == 0) {
    unsigned* bar = b.bar;
    __builtin_amdgcn_s_waitcnt(0);
    unsigned nloc = b.st[0], nx = b.st[1];
    if (nloc == 0u) { xcd_barrier_complete(bar, b.x, nloc, nx); b.st[0] = nloc; b.st[1] = nx; }
    const unsigned old = xb_add(&bar[XB_XSUB(b.x)], 1u);
    const unsigned gen = old / nloc;
    if (old + 1u == (gen + 1u) * nloc) {
      __builtin_amdgcn_fence(__ATOMIC_RELEASE, "agent");
      asm volatile("s_waitcnt vmcnt(0)" ::: "memory");
      const unsigned og = xb_add(&bar[XB_TOP], 1u);
      const unsigned tg = og / nx;
      if (og + 1u == (tg + 1u) * nx) xb_add(&bar[XB_TOPGEN], 1u);
      else XB_SPIN(xb_ld(&bar[XB_TOPGEN]) == tg, bar);
      __builtin_amdgcn_fence(__ATOMIC_ACQUIRE, "agent");
      xb_add(&bar[XB_XGEN(b.x)], 1u);
      asm volatile("s_waitcnt vmcnt(0)" ::: "memory");
    } else {
      XB_SPIN(xb_ld(&bar[XB_XGEN(b.x)]) == gen, bar);
      __builtin_amdgcn_fence(__ATOMIC_ACQUIRE, "agent");
      asm volatile("s_waitcnt vmcnt(0)" ::: "memory");
    }
  }
  __syncthreads();
}

__global__ void __launch_bounds__(512, 2) fwd_kernel(Params p) {
  extern __shared__ __attribute__((aligned(16))) unsigned char smem[];
  lptr lds = (lptr)smem;
  cg::grid_group grid = cg::this_grid();
  volatile LAS unsigned* xst = (volatile LAS unsigned*)(lds + LDS_BYTES - 16);
  if (threadIdx.x == 0) { xst[0] = 0u; xst[1] = 0u; }
  __syncthreads();
  const XcdBarrier xb = xcd_barrier_post((unsigned*)(p.ws + WS_BAR), xst);
  const int p_lo = p.p_lo, p_hi = p.p_hi, coop = p.coop;
  for (int ph = p_lo; ph < p_hi; ++ph) {
    unsigned long long kav = (unsigned long long)__builtin_amdgcn_kernarg_segment_ptr();
    asm volatile("" : "+s"(kav));
    const __attribute__((address_space(4))) Params* kp = (const __attribute__((address_space(4))) Params*)kav;
    run_phase(*(const Params*)kp, lds, ph);
    if (coop && ph + 1 < p_hi) {
      if (ph == p_lo) grid.sync();
      else xcd_barrier(xb);
    }
  }
}

extern "C" void kernel_launch(void* const* d_in, const int* in_sizes, int n_in, void* d_out, int out_size, void* d_ws, size_t ws_size, hipStream_t stream) {
  static int grid = 0;
  if (grid == 0) {
    if (n_in != 31 || ws_size < WS_TOTAL) { fprintf(stderr, "kernel_launch: unexpected n_in %d or ws_size %zu (need %zu)\n", n_in, ws_size, (size_t)WS_END); grid = -1; return; }
    int dev = 0, cus = 0, per_cu = 0;
    hipGetDevice(&dev);
    hipDeviceGetAttribute(&cus, hipDeviceAttributeMultiprocessorCount, dev);
    if (hipFuncSetAttribute((const void*)fwd_kernel, hipFuncAttributeMaxDynamicSharedMemorySize, LDS_BYTES) != hipSuccess) { fprintf(stderr, "kernel_launch: hipFuncSetAttribute failed\n"); }
    hipOccupancyMaxActiveBlocksPerMultiprocessor(&per_cu, (const void*)fwd_kernel, 512, LDS_BYTES);
    (void)hipGetLastError();
    if (per_cu < 1) per_cu = 1;
    grid = cus * per_cu;
    if (grid > 256) grid = 256;
    fprintf(stderr, "kernel_launch: cus %d per_cu %d grid %d ws %zu need %zu\n", cus, per_cu, grid, ws_size, (size_t)WS_END);
  }
  if (grid < 0) return;
  if (hipMemsetAsync((char*)d_ws + WS_BAR, 0, 16384, stream) != hipSuccess) fprintf(stderr, "kernel_launch: memset failed\n");
  Params p{};
  for (int i = 0; i < 31; ++i) p.in[i] = (const float*)d_in[i];
  p.out = (float*)d_out; p.ws = (unsigned char*)d_ws; p.p_lo = 0; p.p_hi = N_PHASES; p.coop = 1; p.pad = 0;
  void* args[] = {&p};
  hipError_t e = hipLaunchCooperativeKernel((const void*)fwd_kernel, dim3(grid), dim3(512), args, LDS_BYTES, stream);
  if (e != hipSuccess) fprintf(stderr, "cooperative launch failed: %s (grid %d)\n", hipGetErrorString(e), grid);
}
```

```cpp
#include <hip/hip_runtime.h>
#include <hip/hip_cooperative_groups.h>
#include <cstdio>
namespace cg = cooperative_groups;
#define DI __device__ __forceinline__
#define LAS __attribute__((address_space(3)))
typedef unsigned short bf16_t;
typedef short bf16x8 __attribute__((ext_vector_type(8)));
typedef float f32x4 __attribute__((ext_vector_type(4)));
typedef float f32x16 __attribute__((ext_vector_type(16)));
typedef unsigned u32x4 __attribute__((ext_vector_type(4)));
typedef unsigned u32x2 __attribute__((ext_vector_type(2)));
typedef LAS unsigned char* lptr;

constexpr int M_TOT = 36864, M_P = 4096, DM = 1024;
constexpr int EVEN_IN = 1792, ODD_NP = 4352, ODD_LD = 4096, DFF = 2816;
constexpr int OFF_K = M_TOT * DM, OFF_V = OFF_K + 1048576, OFF_RG = OFF_V + 1048576, OFF_DN = OFF_RG + 32768;
constexpr size_t WS_MOD = 0;
constexpr size_t WS_ROPE = WS_MOD + 884736;
constexpr size_t WS_WIN = WS_ROPE + 1048576;
constexpr size_t WS_WOUT = WS_WIN + (size_t)ODD_NP * 1024 * 2;
constexpr size_t WS_WGU = WS_WOUT + 1024 * 1024 * 2;
constexpr size_t WS_WDN = WS_WGU + (size_t)5632 * 1024 * 2;
constexpr size_t WS_RGW = WS_WDN + (size_t)1024 * 2816 * 2;
constexpr size_t WS_H = WS_RGW + 262144;
constexpr size_t WS_P = WS_H + (size_t)M_TOT * 1024 * 2;
constexpr size_t WS_AB = WS_P + (size_t)M_TOT * 4096 * 2;
constexpr size_t WS_HALO = WS_AB + (size_t)M_TOT * 32 * 4;
constexpr size_t WS_T = WS_HALO + (size_t)576 * 3 * 3072 * 2;
constexpr size_t WS_CARRY = WS_T + (size_t)576 * 8 * 2 * 4096 * 2;
constexpr size_t WS_END = WS_CARRY + (size_t)576 * 2 * 2 * 512 * 4;
constexpr size_t WS_BAR = WS_END;
constexpr size_t WS_TOTAL = WS_BAR + 16384;
constexpr int LDS_BYTES = 160 * 1024;

struct Params {
  const float* in[31];
  float* out;
  unsigned char* ws;
  int p_lo, p_hi, coop, pad;
};

DI int tid_opaque() { int t = threadIdx.x; asm volatile("" : "+v"(t)); return t; }
DI int bid_opaque() { int t = blockIdx.x; asm volatile("" : "+s"(t)); return t; }

typedef __bf16 hwbf16x2 __attribute__((ext_vector_type(2)));
typedef float f32x2v __attribute__((ext_vector_type(2)));
DI unsigned pack2(float lo, float hi) { const f32x2v v = {lo, hi}; return __builtin_bit_cast(unsigned, __builtin_convertvector(v, hwbf16x2)); }
DI bf16_t f2bf(float f) { return (bf16_t)(pack2(f, 0.f) & 0xffffu); }
DI float bf2f(bf16_t b) { return __uint_as_float(((unsigned)b) << 16); }
DI float lo2f(unsigned u) { return __uint_as_float(u << 16); }
DI float hi2f(unsigned u) { return __uint_as_float(u & 0xffff0000u); }
DI float sigmoidf_(float x) { return __builtin_amdgcn_rcpf(1.f + __expf(-x)); }
DI float siluf_(float x) { return x * __builtin_amdgcn_rcpf(1.f + __expf(-x)); }
DI float softplusf_(float x) { return x > 20.f ? x : log1pf(__expf(x)); }
DI int crow(int reg, int h) { return (reg & 3) + 8 * (reg >> 2) + 4 * h; }
DI int row_group(int r) { return r < M_P ? 0 : 1 + ((r - M_P) >> 12); }
DI float wave_sum(float v) {
#pragma unroll
  for (int o = 32; o > 0; o >>= 1) v += __shfl_xor(v, o);
  return v;
}
#define MFMA32(a, b, c) __builtin_amdgcn_mfma_f32_32x32x16_bf16((a), (b), (c), 0, 0, 0)
DI f32x16 mm32(const LAS bf16_t* A, int lda, const LAS bf16_t* Bt, int ldb, int K, f32x16 acc, int lane) {
  const int r = lane & 31, h = lane >> 5;
  const LAS bf16_t* ap = A + r * lda + 8 * h;
  const LAS bf16_t* bp = Bt + r * ldb + 8 * h;
_Pragma("unroll 4")
  for (int k0 = 0; k0 < K; k0 += 16) {
    bf16x8 a = *(const LAS bf16x8*)(ap + k0);
    bf16x8 b = *(const LAS bf16x8*)(bp + k0);
    acc = MFMA32(a, b, acc);
  }
  return acc;
}
DI f32x16 zero16() { f32x16 z; for (int i = 0; i < 16; ++i) z[i] = 0.f; return z; }

DI void phase_pre(const Params& p, lptr lds, int l_lo, int l_hi, int vb, int nb, bool rope) {
  const int tid = tid_opaque(), wid = tid >> 6, lane = tid & 63;
  float* rc = (float*)(p.ws + WS_ROPE); float* rs = rc + 4096 * 32;
  if (rope)
  for (int e = bid_opaque() * 512 + tid; e < 4096 * 32; e += gridDim.x * 512) {
    const int t = e >> 5, f = e & 31, fr = f & 15;
    const float inv = exp2f(-(float)fr * 0.83048202372184058696f);
    const float pos = (f < 16) ? (float)(t >> 6) : (float)(t & 63);
    float x = pos * inv * 0.15915494309189533577f; x -= floorf(x);
    rc[e] = __builtin_amdgcn_cosf(x); rs[e] = __builtin_amdgcn_sinf(x);
  }
  LAS float* sc = (LAS float*)lds;
  LAS float* red = sc + 9 * 1024;
  for (int e = tid; e < 9 * 1024; e += 512) { const int g = e >> 10, k = e & 1023; const float v = g == 0 ? p.in[7][k] : p.in[2][(g - 1) * 1024 + k]; sc[e] = siluf_(v); }
  __syncthreads();
  float* mod = (float*)(p.ws + WS_MOD);
  for (int it = vb; it < (l_hi - l_lo) * 96; it += nb) {
    const int l = l_lo + it / 96, n0 = (it % 96) * 64;
    const float* w = p.in[8] + (size_t)l * 1024 * 6144 + n0 + lane;
    float acc[9];
#pragma unroll
    for (int g = 0; g < 9; ++g) acc[g] = 0.f;
    for (int k0 = wid * 128; k0 < wid * 128 + 128; k0 += 16) {
      float wv[16];
#pragma unroll
      for (int j = 0; j < 16; ++j) wv[j] = w[(size_t)(k0 + j) * 6144];
#pragma unroll
      for (int j = 0; j < 16; ++j)
#pragma unroll
        for (int g = 0; g < 9; ++g) acc[g] += sc[g * 1024 + k0 + j] * wv[j];
    }
#pragma unroll
    for (int g = 0; g < 9; ++g) red[(wid * 9 + g) * 64 + lane] = acc[g];
    __syncthreads();
    for (int e = tid; e < 9 * 64; e += 512) {
      const int g = e >> 6, c = e & 63; float s = 0.f;
#pragma unroll
      for (int w8 = 0; w8 < 8; ++w8) s += red[(w8 * 9 + g) * 64 + c];
      mod[((size_t)l * 9 + g) * 6144 + n0 + c] = s + p.in[9][l * 6144 + n0 + c];
    }
    __syncthreads();
  }
}

DI void cvt_tile(const float* src, int lds_src, int nvalid, bf16_t* dst, int ldd, int k0, int n0, int mode, LAS float* buf) {
  const int tid = tid_opaque();
  {
    float v[8];
#pragma unroll
    for (int k = 0; k < 8; ++k) { const int e = tid + 512 * k, i = e >> 6, j = e & 63; v[k] = src[(size_t)i * lds_src + (j < nvalid ? j : nvalid - 1)]; }
#pragma unroll
    for (int k = 0; k < 8; ++k) { const int e = tid + 512 * k, i = e >> 6, j = e & 63; buf[i * 65 + j] = (j < nvalid) ? v[k] : 0.f; }
  }
  __syncthreads();
  for (int e = tid; e < 2048; e += 512) {
    const int j = e >> 5, i2 = (e & 31) * 2;
    if (j < nvalid) {
      int n = n0 + j, row = n;
      if (mode == 1) { const int up = n >= DFF ? 1 : 0; const int jj = n - up * DFF; row = 256 * (jj >> 7) + 128 * up + (jj & 127); }
      *(unsigned*)(dst + (size_t)row * ldd + k0 + i2) = pack2(buf[i2 * 65 + j], buf[(i2 + 1) * 65 + j]);
    }
  }
  __syncthreads();
}
DI void cvt_matrix(const float* W, int K, int N, bf16_t* dst, int mode, LAS float* buf, int vb, int nb) {
  const int nk = K / 64, nn = (N + 63) / 64;
  for (int t = vb; t < nk * nn; t += nb) {
    const int tk = t % nk, tn = t / nk, k0 = tk * 64, n0 = tn * 64;
    const int nvalid = (N - n0) < 64 ? (N - n0) : 64;
    cvt_tile(W + (size_t)k0 * N + n0, N, nvalid, dst, K, k0, n0, mode, buf);
  }
}

DI void cvt_layer(const Params& p, lptr lds, int l, int what, int vb, int nb) {
  const int tid = tid_opaque();
  const int i2 = l >> 1;
  LAS float* buf = (LAS float*)lds;
  if (what & 1) {
    if ((l & 1) == 0) {
      cvt_matrix(p.in[13] + (size_t)i2 * 1024 * EVEN_IN, 1024, EVEN_IN, (bf16_t*)(p.ws + WS_WIN), 0, buf, vb, nb);
      cvt_matrix(p.in[22] + (size_t)i2 * 1024 * 1024, 1024, 1024, (bf16_t*)(p.ws + WS_WOUT), 0, buf, vb, nb);
      for (int t = vb; t < 32; t += nb) {
        const int gate = t >> 4, dir = (t >> 3) & 1, n = t & 7;
        const float* srcp = (gate ? p.in[18] : p.in[16]) + ((size_t)(i2 * 2 + dir) * 8 + n) * 4096;
        cvt_tile(srcp, 64, 64, (bf16_t*)(p.ws + WS_RGW) + ((size_t)(dir * 2 + gate) * 8 + n) * 4096, 64, 0, 0, 0, buf);
      }
    } else {
      cvt_matrix(p.in[23] + (size_t)i2 * 1024 * 4128, 1024, 4128, (bf16_t*)(p.ws + WS_WIN), 0, buf, vb, nb);
      cvt_matrix(p.in[28] + (size_t)i2 * 1024 * 1024, 1024, 1024, (bf16_t*)(p.ws + WS_WOUT), 0, buf, vb, nb);
      u32x4* z = (u32x4*)((bf16_t*)(p.ws + WS_WIN) + (size_t)4128 * 1024);
      for (int e = vb * 512 + tid; e < 224 * 1024 / 8; e += nb * 512) z[e] = (u32x4){0u, 0u, 0u, 0u};
    }
  }
  if (what & 2) cvt_matrix(p.in[29] + (size_t)l * 1024 * 5632, 1024, 5632, (bf16_t*)(p.ws + WS_WGU), 1, buf, vb, nb);
  if (what & 4) cvt_matrix(p.in[30] + (size_t)l * DFF * 1024, DFF, 1024, (bf16_t*)(p.ws + WS_WDN), 0, buf, vb, nb);
}

DI void norm_core(const Params& p, int l, int mode, bool first, int row_lo, int row_hi, int vb, int nb) {
  const int tid = tid_opaque(), wid = tid >> 6, lane = tid & 63;
  const float* mod = (const float*)(p.ws + WS_MOD);
  bf16_t* h = (bf16_t*)(p.ws + WS_H);
  const float* gn = mode == 2 ? p.in[12] : (mode ? p.in[11] : p.in[10]) + l * 1024;
  f32x4 ggv[4];
#pragma unroll
  for (int i = 0; i < 4; ++i) ggv[i] = *(const f32x4*)(gn + lane * 4 + 256 * i);
  const int nchunk = (row_hi - row_lo + 5) / 6;
  for (int c = vb * 8 + wid; c < nchunk; c += nb * 8) {
    const int r0 = row_lo + 6 * c;
    f32x4 v[6][4]; float ss[6];
#pragma unroll
    for (int q = 0; q < 6; ++q) {
      const int row = r0 + q < row_hi ? r0 + q : r0;
      const float* xs = first ? (row < M_P ? p.in[0] + (size_t)row * 1024 : p.in[1] + (size_t)(row - M_P) * 1024) : p.out + (size_t)row * 1024;
#pragma unroll
      for (int i = 0; i < 4; ++i) v[q][i] = *(const f32x4*)(xs + lane * 4 + 256 * i);
    }
    int gcur = row_group(r0);
    f32x4 shv[4], scv[4];
    if (mode != 2) {
      const float* md = mod + ((size_t)l * 9 + gcur) * 6144 + (mode ? 3072 : 0);
#pragma unroll
      for (int i = 0; i < 4; ++i) { shv[i] = *(const f32x4*)(md + lane * 4 + 256 * i); scv[i] = *(const f32x4*)(md + 1024 + lane * 4 + 256 * i); }
    }
#pragma unroll
    for (int q = 0; q < 6; ++q) {
      float s = 0.f;
#pragma unroll
      for (int i = 0; i < 4; ++i) s += v[q][i][0] * v[q][i][0] + v[q][i][1] * v[q][i][1] + v[q][i][2] * v[q][i][2] + v[q][i][3] * v[q][i][3];
      ss[q] = wave_sum(s);
    }
#pragma unroll
    for (int q = 0; q < 6; ++q) {
      const int row = r0 + q;
      if (row < row_hi) {
        if (mode != 2 && row_group(row) != gcur) {
          gcur = row_group(row);
          const float* md = mod + ((size_t)l * 9 + gcur) * 6144 + (mode ? 3072 : 0);
#pragma unroll
          for (int i = 0; i < 4; ++i) { shv[i] = *(const f32x4*)(md + lane * 4 + 256 * i); scv[i] = *(const f32x4*)(md + 1024 + lane * 4 + 256 * i); }
        }
        const float rstd = rsqrtf(ss[q] * (1.f / 1024.f) + 1e-6f);
#pragma unroll
        for (int i = 0; i < 4; ++i) {
          const int cc = lane * 4 + 256 * i;
          f32x4 y;
          if (mode == 2) {
#pragma unroll
            for (int j = 0; j < 4; ++j) y[j] = v[q][i][j] * rstd * ggv[i][j];
            *(f32x4*)(p.out + (size_t)row * 1024 + cc) = y;
          } else {
#pragma unroll
            for (int j = 0; j < 4; ++j) y[j] = v[q][i][j] * rstd * ggv[i][j] * (1.f + scv[i][j]) + shv[i][j];
            *(u32x2*)(h + (size_t)row * 1024 + cc) = (u32x2){pack2(y[0], y[1]), pack2(y[2], y[3])};
          }
        }
      }
    }
    if (first) {
#pragma unroll
      for (int q = 0; q < 6; ++q) {
        const int row = r0 + q;
        if (row < row_hi) {
#pragma unroll
          for (int i = 0; i < 4; ++i) *(f32x4*)(p.out + (size_t)row * 1024 + lane * 4 + 256 * i) = v[q][i];
        }
      }
    }
  }
}

DI void phase_norm(const Params& p, lptr lds, int l, int which) {
  const int tid = tid_opaque(), wid = tid >> 6, lane = tid & 63;
  const int i2 = l >> 1;
  if (which == 0) { if (l == 0) cvt_layer(p, lds, 0, 7, bid_opaque(), gridDim.x); else cvt_layer(p, lds, l, gridDim.x == 256 ? 4 : 7, bid_opaque(), gridDim.x); }
  norm_core(p, l, which, l == 0 && which == 0, 0, M_TOT, bid_opaque(), gridDim.x);
}

DI void phase_final(const Params& p) {
  const int tid = tid_opaque(), wid = tid >> 6, lane = tid & 63;
  const float* gn = p.in[12];
  const int rstride = gridDim.x * 8;
  for (int row0 = bid_opaque() * 8 + wid; row0 < M_TOT; row0 += 3 * rstride) {
    f32x4 v[3][4]; float ss[3];
#pragma unroll
    for (int q = 0; q < 3; ++q) {
      const int row = row0 + q * rstride < M_TOT ? row0 + q * rstride : row0;
      const float* xs = p.out + (size_t)row * 1024;
#pragma unroll
      for (int i = 0; i < 4; ++i) v[q][i] = *(const f32x4*)(xs + lane * 4 + 256 * i);
    }
#pragma unroll
    for (int q = 0; q < 3; ++q) {
      float s = 0.f;
#pragma unroll
      for (int i = 0; i < 4; ++i) s += v[q][i][0] * v[q][i][0] + v[q][i][1] * v[q][i][1] + v[q][i][2] * v[q][i][2] + v[q][i][3] * v[q][i][3];
      ss[q] = wave_sum(s);
    }
#pragma unroll
    for (int q = 0; q < 3; ++q) {
      const int row = row0 + q * rstride;
      if (row < M_TOT) {
        const float rstd = rsqrtf(ss[q] * (1.f / 1024.f) + 1e-6f);
#pragma unroll
        for (int i = 0; i < 4; ++i) {
          const int c = lane * 4 + 256 * i;
          const f32x4 gg = *(const f32x4*)(gn + c);
          f32x4 y;
#pragma unroll
          for (int j = 0; j < 4; ++j) y[j] = v[q][i][j] * rstd * gg[j];
          *(f32x4*)(p.out + (size_t)row * 1024 + c) = y;
        }
      }
    }
  }
}

namespace pg8 {
constexpr int BM = 256, BK = 64, HALF = 128, HTB = HALF * BK * 2, STAGE_BYTES = 8 * HTB, NXCD = 8, WGM = 8;
DI int lds_byte(int r, int c) { const int st = (r >> 4) * 2 + (c >> 5), rr = r & 15, cc = c & 31, ob = rr * 64 + cc * 2; return st * 1024 + (ob ^ (((ob >> 9) & 1) << 5)); }
DI void stage_rc(int b, int& R, int& C) { const int st = b / 1024, sb = b % 1024, swz = sb ^ (((sb >> 9) & 1) << 5); R = (st >> 1) * 16 + swz / 64; C = (st & 1) * 32 + (swz % 64) / 2; }
DI int perm32(int rho) { const int n = rho >> 4, i = rho & 15; return 8 * (i >> 2) + 4 * n + (i & 3); }
struct Unit { int pm, pn; };
struct Gemm { const bf16_t* A; const bf16_t* Bt; int M, N, K; };
struct StaticOrder {
  int nM, nN, nwg, G, c;
  DI void init(int M, int N, int G_, int c_) { nM = M / BM; nN = N / BM; nwg = nM * nN; G = G_; c = c_; }
  DI bool next(int i, Unit& u) const {
    const long L = (long)i * G + c; if (L >= nwg) return false;
    int wgid = (int)L; { const int q = nwg / NXCD, r = nwg % NXCD, xcd = wgid % NXCD, off = wgid / NXCD; wgid = (xcd < r ? xcd * (q + 1) : r * (q + 1) + (xcd - r) * q) + off; }
    const int nig = WGM * nN, gid = wgid / nig, fm = gid * WGM, gsz = (nM - fm) < WGM ? (nM - fm) : WGM;
    u.pm = fm + ((wgid % nig) % gsz); u.pn = (wgid % nig) / gsz; return true;
  }
};
DI unsigned cvt_pk_bf16(float lo, float hi) { unsigned r; asm volatile("v_cvt_pk_bf16_f32 %0, %1, %2" : "=v"(r) : "v"(lo), "v"(hi)); return r; }

template <class Epi>
DI void gemm_phase(lptr lds, const Gemm g, const StaticOrder& S, const Epi& E) {
  const int tid = tid_opaque(), wid = __builtin_amdgcn_readfirstlane(tid >> 6), lane = tid & 63, wr = wid >> 2, wc = wid & 3, fr = lane & 15, fq = lane >> 4;
  const int K = g.K, nt = K / BK;
  unsigned voffA[2], voffB[2];
#pragma unroll
  for (int i = 0; i < 2; ++i) { int R, C; stage_rc(tid * 16 + i * 8192, R, C); const int Rb = Epi::PERM ? ((R & ~31) + perm32(R & 31)) : R;
    voffA[i] = (unsigned)(R * K + C) * 2u; voffB[i] = (unsigned)(Rb * K + C) * 2u; }
  const size_t kstep = (size_t)(BK * 2);
  const size_t hstep = (size_t)HALF * K * 2;
  const size_t tstep = 2 * hstep;
  const unsigned ldsw = (unsigned)wid * 1024u;
  const int aoff = lds_byte(wr * 64 + fr, fq * 8), boff = lds_byte(wc * 32 + fr, fq * 8);
#define PG8_SA(b, h) (((b) * 2 + (h)) * HTB)
#define PG8_SB(b, h) ((4 + (b) * 2 + (h)) * HTB)
#define PG8_STAGE(bufoff, gbase, voff) do { _Pragma("unroll") for (int _i = 0; _i < 2; ++_i) \
    __builtin_amdgcn_global_load_lds((const unsigned*)((const char*)(gbase) + (voff)[_i]), (LAS unsigned*)(lds + (bufoff) + ldsw + _i * 8192), 16, 0, 0); } while (0)
#define PG8_LDA(dst, b, h) do { _Pragma("unroll") for (int m = 0; m < 4; ++m) _Pragma("unroll") for (int k = 0; k < 2; ++k) dst[m][k] = *(const LAS bf16x8*)(lds + PG8_SA(b, h) + aoff + m * 2048 + k * 1024); } while (0)
#define PG8_LDB(dst, b, h) do { _Pragma("unroll") for (int n = 0; n < 2; ++n) _Pragma("unroll") for (int k = 0; k < 2; ++k) dst[n][k] = *(const LAS bf16x8*)(lds + PG8_SB(b, h) + boff + n * 2048 + k * 1024); } while (0)
#define PG8_MMA(ai, bj, At, Bt) do { __builtin_amdgcn_s_setprio(1); _Pragma("unroll") for (int m = 0; m < 4; ++m) _Pragma("unroll") for (int n = 0; n < 2; ++n) _Pragma("unroll") for (int k = 0; k < 2; ++k) \
    acc[ai][bj][m][n] = __builtin_amdgcn_mfma_f32_16x16x32_bf16(Bt[n][k], At[m][k], acc[ai][bj][m][n], 0, 0, 0); __builtin_amdgcn_s_setprio(0); } while (0)
#define PG8_WAIT_V(n) asm volatile("s_waitcnt vmcnt(" #n ")" ::: "memory")
#define PG8_WAIT_L(n) asm volatile("s_waitcnt lgkmcnt(" #n ")" ::: "memory")
#define PG8_BAR __builtin_amdgcn_s_barrier()
#define PG8_SCHED __builtin_amdgcn_sched_barrier(0)
  Unit cur, nxt; int ui = 0;
  if (!S.next(0, cur)) return;
  f32x4 acc[2][2][4][2];
#pragma unroll
  for (int a = 0; a < 2; ++a)
#pragma unroll
    for (int b = 0; b < 2; ++b)
#pragma unroll
      for (int m = 0; m < 4; ++m)
#pragma unroll
        for (int n = 0; n < 2; ++n) acc[a][b][m][n] = (f32x4){0.f, 0.f, 0.f, 0.f};
  bf16x8 At[4][2], B0[2][2], B1[2][2];
  const char* cA = (const char*)g.A + (size_t)cur.pm * tstep; const char* cB = (const char*)g.Bt + (size_t)cur.pn * tstep;
  PG8_STAGE(PG8_SB(0, 0), cB, voffB); PG8_STAGE(PG8_SA(0, 0), cA, voffA); PG8_STAGE(PG8_SB(0, 1), cB + hstep, voffB); PG8_STAGE(PG8_SA(0, 1), cA + hstep, voffA);
  if (wr == 1) PG8_BAR;
  PG8_WAIT_V(4); PG8_BAR;
  PG8_STAGE(PG8_SB(1, 0), cB + kstep, voffB); PG8_STAGE(PG8_SA(1, 0), cA + kstep, voffA); PG8_STAGE(PG8_SB(1, 1), cB + hstep + kstep, voffB);
  PG8_WAIT_V(6); PG8_BAR;
  for (;;) {
    const bool has_next = S.next(ui + 1, nxt);
    const char* nA = has_next ? (const char*)g.A + (size_t)nxt.pm * tstep : cA; const char* nB = has_next ? (const char*)g.Bt + (size_t)nxt.pn * tstep : cB;
    for (int t = 0; t < nt; t += 2) {
      const bool last = (t == nt - 2);
      const char* a1 = cA + (size_t)(t + 1) * kstep;
      const char* a2 = last ? nA : cA + (size_t)(t + 2) * kstep; const char* b2 = last ? nB : cB + (size_t)(t + 2) * kstep;
      const char* a3 = a2 + kstep; const char* b3 = b2 + kstep;
      PG8_LDB(B0, 0, 0); PG8_SCHED; PG8_LDA(At, 0, 0); PG8_STAGE(PG8_SA(1, 1), a1 + hstep, voffA);
      PG8_WAIT_L(8); PG8_BAR; PG8_WAIT_L(0); PG8_MMA(0, 0, At, B0); PG8_BAR; PG8_SCHED;
      PG8_LDB(B1, 0, 1); PG8_STAGE(PG8_SB(0, 0), b2, voffB);
      PG8_BAR; PG8_WAIT_L(0); PG8_MMA(0, 1, At, B1); PG8_BAR;
      PG8_LDA(At, 0, 1); PG8_STAGE(PG8_SA(0, 0), a2, voffA);
      PG8_BAR; PG8_WAIT_L(0); PG8_MMA(1, 0, At, B0); PG8_BAR; PG8_SCHED;
      PG8_STAGE(PG8_SB(0, 1), b2 + hstep, voffB);
      PG8_WAIT_V(6); PG8_BAR; PG8_MMA(1, 1, At, B1); PG8_BAR;
      PG8_LDB(B0, 1, 0); PG8_SCHED; PG8_LDA(At, 1, 0); PG8_STAGE(PG8_SA(0, 1), a2 + hstep, voffA);
      PG8_WAIT_L(8); PG8_BAR; PG8_WAIT_L(0); PG8_MMA(0, 0, At, B0); PG8_BAR; PG8_SCHED;
      PG8_LDB(B1, 1, 1); PG8_STAGE(PG8_SB(1, 0), b3, voffB);
      PG8_BAR; PG8_WAIT_L(0); PG8_MMA(0, 1, At, B1); PG8_BAR;
      PG8_LDA(At, 1, 1); PG8_STAGE(PG8_SA(1, 0), a3, voffA);
      PG8_BAR; PG8_WAIT_L(0); PG8_MMA(1, 0, At, B0); PG8_BAR; PG8_SCHED;
      PG8_STAGE(PG8_SB(1, 1), b3 + hstep, voffB);
      PG8_WAIT_V(6); PG8_BAR; PG8_MMA(1, 1, At, B1); PG8_BAR;
    }
    E(acc, cur, wr, wc, fr, fq);
    if (!has_next) break;
#pragma unroll
    for (int a = 0; a < 2; ++a)
#pragma unroll
      for (int b = 0; b < 2; ++b)
#pragma unroll
        for (int m = 0; m < 4; ++m)
#pragma unroll
          for (int n = 0; n < 2; ++n) acc[a][b][m][n] = (f32x4){0.f, 0.f, 0.f, 0.f};
    cur = nxt; cA = nA; cB = nB; ++ui;
  }
  PG8_WAIT_V(0);
  if (wr == 0) PG8_BAR;
  PG8_BAR;
#undef PG8_SA
#undef PG8_SB
#undef PG8_STAGE
#undef PG8_LDA
#undef PG8_LDB
#undef PG8_MMA
#undef PG8_WAIT_V
#undef PG8_WAIT_L
#undef PG8_BAR
#undef PG8_SCHED
}

struct EpiIn {
  static constexpr bool PERM = true;
  bf16_t* P; int ldp; int odd; float* kout; float* vout; float* ab; bf16_t* halo;
  DI void operator()(const f32x4 (&acc)[2][2][4][2], const Unit& u, int wr, int wc, int fr, int fq) const {
    const int row0 = u.pm * BM + wr * 64 + fr;
    if (odd && u.pn == 16) {
      if (wc == 0) {
#pragma unroll
        for (int ai = 0; ai < 2; ++ai)
#pragma unroll
          for (int m = 0; m < 4; ++m) { const int r = row0 + ai * HALF + m * 16;
#pragma unroll
            for (int n = 0; n < 2; ++n) *(f32x4*)(ab + (size_t)r * 32 + 8 * fq + 4 * n) = acc[ai][0][m][n]; }
      }
      return;
    }
    const int col0 = u.pn * BM + wc * 32 + 8 * fq;
#pragma unroll
    for (int ai = 0; ai < 2; ++ai)
#pragma unroll
      for (int m = 0; m < 4; ++m) {
        const int r = row0 + ai * HALF + m * 16; bf16_t* rowp = P + (size_t)r * ldp + col0;
#pragma unroll
        for (int bj = 0; bj < 2; ++bj) {
          const f32x4 v0 = acc[ai][bj][m][0], v1 = acc[ai][bj][m][1];
          u32x4 w; w.x = cvt_pk_bf16(v0[0], v0[1]); w.y = cvt_pk_bf16(v0[2], v0[3]); w.z = cvt_pk_bf16(v1[0], v1[1]); w.w = cvt_pk_bf16(v1[2], v1[3]);
          *(u32x4*)(rowp + bj * HALF) = w;
          if (odd) {
            const int rc = m * 16 + fr, c = col0 + bj * HALF;
            if (c < 3072 && (rc == 0 || rc >= 62)) { const int slot = rc == 0 ? 0 : rc - 61; *(u32x4*)(halo + ((size_t)(r >> 6) * 3 + slot) * 3072 + c) = w; }
          } else if (u.pn == 6 && r < M_P) {
            float* dst = (bj ? vout : kout) + ((size_t)(r >> 8) * 512 + (r & 255)) * 128 + wc * 32 + 8 * fq;
            *(f32x4*)dst = v0; *(f32x4*)(dst + 4) = v1;
          }
        }
      }
  }
};
struct EpiRes {
  static constexpr bool PERM = false;
  float* x; const float* ga_base; int rbase;
  DI void operator()(const f32x4 (&acc)[2][2][4][2], const Unit& u, int wr, int wc, int fr, int fq) const {
    const int row0 = rbase + u.pm * BM + wr * 64 + fr, col0 = u.pn * BM + wc * 32 + 4 * fq;
    const float* ga = ga_base + (size_t)row_group(rbase + u.pm * BM) * 6144;
    f32x4 gv[2][2];
#pragma unroll
    for (int bj = 0; bj < 2; ++bj)
#pragma unroll
      for (int n = 0; n < 2; ++n) gv[bj][n] = *(const f32x4*)(ga + col0 + bj * HALF + n * 16);
#pragma unroll
    for (int ai = 0; ai < 2; ++ai) {
      f32x4 xv[4][2][2];
#pragma unroll
      for (int m = 0; m < 4; ++m) { const float* rowp = x + (size_t)(row0 + ai * HALF + m * 16) * 1024 + col0;
#pragma unroll
        for (int bj = 0; bj < 2; ++bj)
#pragma unroll
          for (int n = 0; n < 2; ++n) xv[m][bj][n] = *(const f32x4*)(rowp + bj * HALF + n * 16); }
#pragma unroll
      for (int m = 0; m < 4; ++m) { float* rowp = x + (size_t)(row0 + ai * HALF + m * 16) * 1024 + col0;
#pragma unroll
        for (int bj = 0; bj < 2; ++bj)
#pragma unroll
          for (int n = 0; n < 2; ++n) *(f32x4*)(rowp + bj * HALF + n * 16) = xv[m][bj][n] + gv[bj][n] * acc[ai][bj][m][n]; }
    }
  }
};
struct EpiGU {
  static constexpr bool PERM = true;
  bf16_t* act;
  DI void operator()(const f32x4 (&acc)[2][2][4][2], const Unit& u, int wr, int wc, int fr, int fq) const {
    const int row0 = u.pm * BM + wr * 64 + fr, col0 = u.pn * HALF + wc * 32 + 8 * fq;
#pragma unroll
    for (int ai = 0; ai < 2; ++ai)
#pragma unroll
      for (int m = 0; m < 4; ++m) {
        bf16_t* rowp = act + (size_t)(row0 + ai * HALF + m * 16) * DFF + col0;
        float o[8];
#pragma unroll
        for (int n = 0; n < 2; ++n)
#pragma unroll
          for (int j = 0; j < 4; ++j) { const float gt = acc[ai][0][m][n][j], up = acc[ai][1][m][n][j]; o[n * 4 + j] = siluf_(gt) * up; }
        u32x4 w; w.x = cvt_pk_bf16(o[0], o[1]); w.y = cvt_pk_bf16(o[2], o[3]); w.z = cvt_pk_bf16(o[4], o[5]); w.w = cvt_pk_bf16(o[6], o[7]);
        *(u32x4*)rowp = w;
      }
  }
};
}

template <class Epi> DI void run_gemm(lptr lds, const bf16_t* A, const bf16_t* Bt, int N, int K, const Epi& E) {
  pg8::Gemm g; g.A = A; g.Bt = Bt; g.M = M_TOT; g.N = N; g.K = K;
  pg8::StaticOrder S; S.init(M_TOT, N, (int)gridDim.x, (int)bid_opaque());
  pg8::gemm_phase<Epi>(lds, g, S, E);
}
template <class Epi> DI void run_gemm_sub(lptr lds, const bf16_t* A, const bf16_t* Bt, int mrows, int N, int K, const Epi& E, int vb, int nb) {
  pg8::Gemm g; g.A = A; g.Bt = Bt; g.M = mrows; g.N = N; g.K = K;
  pg8::StaticOrder S; S.init(mrows, N, nb, vb);
  pg8::gemm_phase<Epi>(lds, g, S, E);
}
DI void norm_rows(const Params& p, int l, int mode, int row_lo, int row_hi, int vb, int nb) { norm_core(p, l, mode, false, row_lo, row_hi, vb, nb); }

DI float gelu_tanh(float x) { const float u = 0.7978845608028654f * (x + 0.044715f * x * x * x); const float t = 1.f - 2.f * __builtin_amdgcn_rcpf(1.f + __expf(2.f * u)); return 0.5f * x * (1.f + t); }
DI void rg_phase(const Params& p, lptr lds, int l, int mode) {
  const int tid = tid_opaque(), wid = tid >> 6, lane = tid & 63;
  const int i2 = l >> 1, bid = bid_opaque(), G = gridDim.x;
  const int n = bid & 7;
  const bf16_t* P = (const bf16_t*)(p.ws + WS_P);
  bf16_t* Y = (bf16_t*)(p.ws + WS_H);
  float* carry = (float*)(p.ws + WS_CARRY);
  constexpr int SUB = 74752;
  LAS float* Pf = (LAS float*)(lds + 2 * SUB);
  const int ct = tid >> 3, c8 = (tid & 7) * 8, chc = n * 64 + c8;
  LAS float* cwl = (LAS float*)(lds + 2 * SUB + 8192);
  if (tid < 320) { const int j = tid >> 6, c = tid & 63; cwl[tid] = j < 4 ? p.in[14][((size_t)i2 * 4 + j) * 512 + n * 64 + c] : p.in[15][i2 * 512 + n * 64 + c]; }
  __syncthreads();
  const int gdir = wid >> 2, gdt = (wid >> 1) & 1, gt2 = wid & 1, r = lane & 31, hh = lane >> 5;
  bf16x8 wa[4], wx[4];
  {
    const bf16_t* rgw = (const bf16_t*)(p.ws + WS_RGW);
    const bf16_t* wap = rgw + ((size_t)(gdir * 2 + 0) * 8 + n) * 4096 + (gdt * 32 + r) * 64 + 8 * hh;
    const bf16_t* wxp = rgw + ((size_t)(gdir * 2 + 1) * 8 + n) * 4096 + (gdt * 32 + r) * 64 + 8 * hh;
#pragma unroll
    for (int s = 0; s < 4; ++s) { wa[s] = *(const bf16x8*)(wap + 16 * s); wx[s] = *(const bf16x8*)(wxp + 16 * s); }
  }
  const int gd = gdt * 32 + r, gpi = (i2 * 2 + gdir) * 512 + n * 64 + gd;
  const float ba = p.in[17][gpi], bx = p.in[19][gpi], sp8 = -8.f * softplusf_(-p.in[20][gpi]);
  u32x4 praw[2][4], pgr[2];
  pgr[0] = pgr[1] = (u32x4){0u, 0u, 0u, 0u};
#define RG_PREFETCH(s_, item_) do { const int tt_ = (item_) >> 3; const int row0_ = tt_ * 64; \
    const int ti_ = tt_ < 64 ? (tt_ & 3) : ((tt_ - 64) & 63); const int nt_ = tt_ < 64 ? 4 : 64; \
    _Pragma("unroll") for (int j_ = 0; j_ < 4; ++j_) { const int tl_ = ti_ * 64 + ct + j_ - 2; const bool ok_ = tl_ >= 0 && tl_ < nt_ * 64; \
      const u32x4 v_ = *(const u32x4*)(P + (size_t)(row0_ + (ok_ ? ct + j_ - 2 : ct)) * EVEN_IN + chc); praw[s_][j_] = ok_ ? v_ : (u32x4){0u, 0u, 0u, 0u}; } \
    if (mode == 1) pgr[s_] = *(const u32x4*)(P + (size_t)(row0_ + ct) * EVEN_IN + 512 + chc); } while (0)
  if (bid < 4608) RG_PREFETCH(0, bid);
  if (bid + G < 4608) RG_PREFETCH(1, bid + G);
  for (int item0 = bid; item0 < 4608; item0 += 2 * G) {
    const int nsub = item0 + G < 4608 ? 2 : 1;
    u32x4 gr_cur[2];
#pragma unroll
    for (int s = 0; s < 2; ++s) {
      if (s < nsub) {
        const int tt = (item0 + s * G) >> 3;
        const int ti = tt < 64 ? (tt & 3) : ((tt - 64) & 63), ntile = tt < 64 ? 4 : 64;
        LAS bf16_t* Xc = (LAS bf16_t*)(lds + s * SUB);
        float ca[16], cbv[16];
        if (mode == 1) {
          const int q4 = tid >> 7, dir = (tid >> 6) & 1, d = tid & 63, ch = n * 64 + d, tbase = tt - ti;
#pragma unroll
          for (int jj = 0; jj < 16; ++jj) {
            const int j = dir ? (16 * q4 + 15 - jj) : (16 * q4 + jj);
            const bool valid = dir ? (j > ti && j < ntile) : (j < ti);
            const int jc = valid ? j : ti;
            const size_t o = ((size_t)((tbase + jc) * 2 + dir) * 2) * 512 + ch;
            const float va = carry[o], vb = carry[o + 512];
            ca[jj] = valid ? va : 1.f; cbv[jj] = valid ? vb : 0.f;
          }
        }
        {
          const f32x4 b0 = *(const LAS f32x4*)(cwl + 256 + c8), b1 = *(const LAS f32x4*)(cwl + 256 + c8 + 4);
          float a[8] = {b0[0], b0[1], b0[2], b0[3], b1[0], b1[1], b1[2], b1[3]};
#pragma unroll
          for (int j = 0; j < 4; ++j) {
            const u32x4 raw = praw[s][j];
            const f32x4 w0 = *(const LAS f32x4*)(cwl + j * 64 + c8), w1 = *(const LAS f32x4*)(cwl + j * 64 + c8 + 4);
            a[0] += w0[0] * lo2f(raw.x); a[1] += w0[1] * hi2f(raw.x); a[2] += w0[2] * lo2f(raw.y); a[3] += w0[3] * hi2f(raw.y);
            a[4] += w1[0] * lo2f(raw.z); a[5] += w1[1] * hi2f(raw.z); a[6] += w1[2] * lo2f(raw.w); a[7] += w1[3] * hi2f(raw.w);
          }
          *(LAS u32x4*)(Xc + ct * 72 + c8) = (u32x4){pack2(a[0], a[1]), pack2(a[2], a[3]), pack2(a[4], a[5]), pack2(a[6], a[7])};
        }
        gr_cur[s] = pgr[s];
        if (mode == 1) {
          const int q4 = tid >> 7, dir = (tid >> 6) & 1, d = tid & 63;
          float A = 1.f, B = 0.f;
#pragma unroll
          for (int jj = 0; jj < 16; ++jj) { B = ca[jj] * B + cbv[jj]; A = ca[jj] * A; }
          Pf[s * 1024 + (q4 * 2 + dir) * 64 + d] = A; Pf[s * 1024 + 512 + (q4 * 2 + dir) * 64 + d] = B;
        }
      }
      __builtin_amdgcn_sched_barrier(0);
    }
    __syncthreads();
#pragma unroll 1
    for (int s = 0; s < 2; ++s) {
      if (s < nsub) {
        LAS bf16_t* Xc = (LAS bf16_t*)(lds + s * SUB);
        LAS float* Aa = (LAS float*)(lds + s * SUB + 9216); LAS float* Bb = (LAS float*)(lds + s * SUB + 41984);
        f32x16 ga = zero16(), gx = zero16();
#pragma unroll
        for (int ks = 0; ks < 4; ++ks) {
          const bf16x8 a = *(const LAS bf16x8*)(Xc + (gt2 * 32 + r) * 72 + 16 * ks + 8 * hh);
          ga = MFMA32(a, wa[ks], ga); gx = MFMA32(a, wx[ks], gx);
        }
        float xcv[16];
#pragma unroll
        for (int ii = 0; ii < 16; ++ii) xcv[ii] = bf2f(Xc[(gt2 * 32 + crow(ii, hh)) * 72 + gd]);
#pragma unroll
        for (int ii = 0; ii < 16; ++ii) {
          const int t = gt2 * 32 + crow(ii, hh);
          const float rr = sigmoidf_(ga[ii] + ba), iv = sigmoidf_(gx[ii] + bx);
          const float la = rr * sp8, a = __expf(la), x2 = 2.f * la;
          const float om = x2 > -0.25f ? -x2 * (1.f + x2 * (0.5f + x2 * (0.16666667f + x2 * (0.041666668f + x2 * 0.0083333338f)))) : 1.f - __expf(x2);
          const float bb = __builtin_amdgcn_sqrtf(fmaxf(om, 0.f)) * (iv * xcv[ii]);
          Aa[(gdir * 64 + t) * 64 + gd] = a; Bb[(gdir * 64 + t) * 64 + gd] = bb;
        }
      }
    }
    __syncthreads();
    if (item0 + 2 * G < 4608) RG_PREFETCH(0, item0 + 2 * G);
    if (item0 + 3 * G < 4608) RG_PREFETCH(1, item0 + 3 * G);
    if (tid < 128 * nsub) {
      const int s = tid >> 7, dir = (tid >> 6) & 1, d = tid & 63, ch = n * 64 + d;
      const int tt = (item0 + s * G) >> 3;
      const int ti = tt < 64 ? (tt & 3) : ((tt - 64) & 63), ntile = tt < 64 ? 4 : 64;
      const int seq = tt < 64 ? (tt >> 2) : 16 + ((tt - 64) >> 6);
      LAS float* Aa = (LAS float*)(lds + s * SUB + 9216); LAS float* Bb = (LAS float*)(lds + s * SUB + 41984);
      if (mode == 0) {
        float A = 1.f, B = 0.f;
#pragma unroll 8
        for (int st = 0; st < 64; ++st) { const int t = dir ? 63 - st : st; const float a = Aa[(dir * 64 + t) * 64 + d], b = Bb[(dir * 64 + t) * 64 + d]; A *= a; B = a * B + b; }
        carry[((size_t)(tt * 2 + dir) * 2 + 0) * 512 + ch] = A; carry[((size_t)(tt * 2 + dir) * 2 + 1) * 512 + ch] = B;
      } else {
        float h = (tt < 64) ? 0.f : p.in[5][(((size_t)(seq - 16) * 2 + i2) * 2 + dir) * 512 + ch];
#pragma unroll
        for (int qq = 0; qq < 4; ++qq) { const int q4 = dir ? 3 - qq : qq; h = Pf[s * 1024 + (q4 * 2 + dir) * 64 + d] * h + Pf[s * 1024 + 512 + (q4 * 2 + dir) * 64 + d]; }
#pragma unroll 8
        for (int st = 0; st < 64; ++st) { const int t = dir ? 63 - st : st; h = Aa[(dir * 64 + t) * 64 + d] * h + Bb[(dir * 64 + t) * 64 + d]; Aa[(dir * 64 + t) * 64 + d] = h; }
        if (tt < 64 && ((dir == 0 && ti == ntile - 1) || (dir == 1 && ti == 0))) p.out[OFF_RG + (((size_t)seq * 2 + i2) * 2 + dir) * 512 + ch] = h;
      }
    }
    if (mode == 1) {
      __syncthreads();
#pragma unroll
      for (int s = 0; s < 2; ++s) {
        if (s < nsub) {
          const int row0 = ((item0 + s * G) >> 3) * 64;
          const LAS float* Hf = (const LAS float*)(lds + s * SUB + 9216); const LAS float* Hb = Hf + 4096;
          const u32x4 raw = gr_cur[s];
          float gr[8] = {lo2f(raw.x), hi2f(raw.x), lo2f(raw.y), hi2f(raw.y), lo2f(raw.z), hi2f(raw.z), lo2f(raw.w), hi2f(raw.w)};
          float y[8];
#pragma unroll
          for (int e = 0; e < 8; ++e) y[e] = (Hf[ct * 64 + c8 + e] + Hb[ct * 64 + c8 + e]) * gelu_tanh(gr[e]);
          *(u32x4*)(Y + (size_t)(row0 + ct) * 1024 + n * 64 + c8) = (u32x4){pack2(y[0], y[1]), pack2(y[2], y[3]), pack2(y[4], y[5]), pack2(y[6], y[7])};
        }
      }
    }
    __syncthreads();
  }
#undef RG_PREFETCH
}

DI void att_item(const Params& p, lptr lds, int l, int item) {
  const int tid = tid_opaque(), wid = tid >> 6, lane = tid & 63, q = lane & 31, hh = lane >> 5;
  const int i2 = l >> 1;
  const bool samp = item < 1024;
  int b, kvh, qt, rowbase;
  if (samp) { b = item >> 7; kvh = (item >> 6) & 1; qt = item & 63; rowbase = M_P + b * 4096; }
  else { const int j = item - 1024; b = j >> 3; kvh = (j >> 2) & 1; qt = j & 3; rowbase = b * 256; }
  const bf16_t* P = (const bf16_t*)(p.ws + WS_P);
  bf16_t* Y = (bf16_t*)(p.ws + WS_H);
  const float* rc = (const float*)(p.ws + WS_ROPE); const float* rs = rc + 4096 * 32;
  LAS bf16_t* Ks = (LAS bf16_t*)lds; LAS bf16_t* Vt = (LAS bf16_t*)(lds + 9216);
  const int head = kvh * 4 + (wid >> 1);
  const int qpos = qt * 64 + 32 * (wid & 1) + q;
  bf16x8 Qf[4];
  {
    const bf16_t* qp = P + (size_t)(rowbase + qpos) * EVEN_IN + 1024 + head * 64 + 8 * hh;
    float qv[4][8];
#pragma unroll
    for (int s = 0; s < 4; ++s) { const u32x4 raw = *(const u32x4*)(qp + 16 * s);
      qv[s][0] = lo2f(raw.x); qv[s][1] = hi2f(raw.x); qv[s][2] = lo2f(raw.y); qv[s][3] = hi2f(raw.y); qv[s][4] = lo2f(raw.z); qv[s][5] = hi2f(raw.z); qv[s][6] = lo2f(raw.w); qv[s][7] = hi2f(raw.w); }
    if (samp) {
#pragma unroll
      for (int pr = 0; pr < 2; ++pr)
#pragma unroll
        for (int j = 0; j < 8; ++j) { const int f = 16 * pr + 8 * hh + j; const float c = rc[qpos * 32 + f], sn = rs[qpos * 32 + f];
          const float x1 = qv[2 * pr][j], x2 = qv[2 * pr + 1][j]; qv[2 * pr][j] = x1 * c - x2 * sn; qv[2 * pr + 1][j] = x1 * sn + x2 * c; }
    }
#pragma unroll
    for (int s = 0; s < 4; ++s) { const float qs = 0.125f * 1.44269504088896341f;
      u32x4 w; w.x = pack2(qv[s][0] * qs, qv[s][1] * qs); w.y = pack2(qv[s][2] * qs, qv[s][3] * qs); w.z = pack2(qv[s][4] * qs, qv[s][5] * qs); w.w = pack2(qv[s][6] * qs, qv[s][7] * qs); Qf[s] = __builtin_bit_cast(bf16x8, w); }
  }
  float m_run = p.in[21][i2 * 8 + head] * 1.44269504088896341f, l_run = hh == 0 ? 1.f : 0.f;
  f32x16 o0 = zero16(), o1 = zero16();
  const int nctx = samp ? 8 : 0;
  int w0, w1; if (samp) { w0 = qt - 2 < 0 ? 0 : qt - 2; w1 = qt + 2 > 63 ? 63 : qt + 2; } else { w0 = 0; w1 = 3; }
  const int ntiles = nctx + (w1 - w0 + 1);
  const bool isK = tid < 256;
  const int skey = (tid & 255) >> 2, spc = tid & 3;
  const int sd0 = isK ? (spc & 1) * 8 + (spc >> 1) * 32 : spc * 16;
  const int so1 = isK ? 16 : 8;
  f32x4 pc4[4]; u32x4 pw2[2]; f32x4 prc[4];
#define ATT_PREFETCH(kt_) do { const bool ctx_ = (kt_) < nctx; const int wt_ = w0 + ((kt_) - nctx); \
    if (ctx_) { const float* sp_ = (isK ? p.in[3] : p.in[4]) + (((size_t)(b * 2 + i2) * 512 + (kt_) * 64 + skey) * 2 + kvh) * 64 + sd0; \
      pc4[0] = *(const f32x4*)sp_; pc4[1] = *(const f32x4*)(sp_ + 4); pc4[2] = *(const f32x4*)(sp_ + so1); pc4[3] = *(const f32x4*)(sp_ + so1 + 4); } \
    else { const bf16_t* sp_ = P + (size_t)(rowbase + wt_ * 64 + skey) * EVEN_IN + (isK ? 1536 : 1664) + kvh * 64 + sd0; \
      pw2[0] = *(const u32x4*)sp_; pw2[1] = *(const u32x4*)(sp_ + so1); \
      if (samp && isK) { const int kpos_ = wt_ * 64 + skey, fb_ = (sd0 & 8) + (sd0 >= 32 ? 16 : 0); \
        prc[0] = *(const f32x4*)(rc + kpos_ * 32 + fb_); prc[1] = *(const f32x4*)(rc + kpos_ * 32 + fb_ + 4); \
        prc[2] = *(const f32x4*)(rs + kpos_ * 32 + fb_); prc[3] = *(const f32x4*)(rs + kpos_ * 32 + fb_ + 4); } } } while (0)
  ATT_PREFETCH(0);
  for (int kt = 0; kt < ntiles; ++kt) {
    const bool ctx = kt < nctx; const int wt = w0 + (kt - nctx);
    __syncthreads();
    {
      float x1[8], x2[8];
      if (ctx) {
#pragma unroll
        for (int e = 0; e < 4; ++e) { x1[e] = pc4[0][e]; x1[4 + e] = pc4[1][e]; x2[e] = pc4[2][e]; x2[4 + e] = pc4[3][e]; }
      } else {
        const u32x4 r1 = pw2[0], r2 = pw2[1];
        x1[0] = lo2f(r1.x); x1[1] = hi2f(r1.x); x1[2] = lo2f(r1.y); x1[3] = hi2f(r1.y); x1[4] = lo2f(r1.z); x1[5] = hi2f(r1.z); x1[6] = lo2f(r1.w); x1[7] = hi2f(r1.w);
        x2[0] = lo2f(r2.x); x2[1] = hi2f(r2.x); x2[2] = lo2f(r2.y); x2[3] = hi2f(r2.y); x2[4] = lo2f(r2.z); x2[5] = hi2f(r2.z); x2[6] = lo2f(r2.w); x2[7] = hi2f(r2.w);
        if (samp && isK) {
#pragma unroll
          for (int j = 0; j < 8; ++j) { const float c = prc[j >> 2][j & 3], sn = prc[2 + (j >> 2)][j & 3]; const float a = x1[j], bb = x2[j]; x1[j] = a * c - bb * sn; x2[j] = a * sn + bb * c; }
        }
      }
      if (isK) {
        *(LAS u32x4*)(Ks + skey * 72 + sd0) = (u32x4){pack2(x1[0], x1[1]), pack2(x1[2], x1[3]), pack2(x1[4], x1[5]), pack2(x1[6], x1[7])};
        *(LAS u32x4*)(Ks + skey * 72 + sd0 + 16) = (u32x4){pack2(x2[0], x2[1]), pack2(x2[2], x2[3]), pack2(x2[4], x2[5]), pack2(x2[6], x2[7])};
      } else {
#pragma unroll
        for (int e = 0; e < 8; ++e) { Vt[(sd0 + e) * 72 + skey] = f2bf(x1[e]); Vt[(sd0 + 8 + e) * 72 + skey] = f2bf(x2[e]); }
      }
    }
    __syncthreads();
    if (kt + 1 < ntiles) ATT_PREFETCH(kt + 1);
#pragma unroll
    for (int ks = 0; ks < 2; ++ks) {
      f32x16 sacc = zero16();
#pragma unroll
      for (int s = 0; s < 4; ++s) { const bf16x8 a = *(const LAS bf16x8*)(Ks + (32 * ks + q) * 72 + 16 * s + 8 * hh); sacc = MFMA32(a, Qf[s], sacc); }
      if (!ctx && samp) {
        const int kbase = wt * 64 + 32 * ks;
#pragma unroll
        for (int ii = 0; ii < 16; ++ii) { const int dl = qpos - (kbase + crow(ii, hh)); if (dl > 128 || dl < -128) sacc[ii] = -1e30f; }
      }
      float mx = sacc[0];
#pragma unroll
      for (int ii = 1; ii < 16; ++ii) mx = fmaxf(mx, sacc[ii]);
      mx = fmaxf(mx, __shfl_xor(mx, 32));
      if (__any(mx > m_run)) {
        const float m_new = fmaxf(m_run, mx), alpha = __builtin_amdgcn_exp2f(m_run - m_new); m_run = m_new;
        l_run *= alpha;
#pragma unroll
        for (int ii = 0; ii < 16; ++ii) { o0[ii] *= alpha; o1[ii] *= alpha; }
      }
      float pv[16], ps = 0.f;
#pragma unroll
      for (int ii = 0; ii < 16; ++ii) { pv[ii] = __builtin_amdgcn_exp2f(sacc[ii] - m_run); ps += pv[ii]; }
      l_run += ps;
#pragma unroll
      for (int s2 = 0; s2 < 2; ++s2) {
        u32x4 pw; pw.x = pack2(pv[8 * s2], pv[8 * s2 + 1]); pw.y = pack2(pv[8 * s2 + 2], pv[8 * s2 + 3]); pw.z = pack2(pv[8 * s2 + 4], pv[8 * s2 + 5]); pw.w = pack2(pv[8 * s2 + 6], pv[8 * s2 + 7]);
        const bf16x8 bfrag = __builtin_bit_cast(bf16x8, pw);
        {
          const LAS bf16_t* vp = Vt + q * 72 + 32 * ks + 16 * s2 + 4 * hh;
          const u32x2 lo = *(const LAS u32x2*)vp, hi = *(const LAS u32x2*)(vp + 8);
          o0 = MFMA32(__builtin_bit_cast(bf16x8, ((u32x4){lo.x, lo.y, hi.x, hi.y})), bfrag, o0);
        }
        {
          const LAS bf16_t* vp = Vt + (32 + q) * 72 + 32 * ks + 16 * s2 + 4 * hh;
          const u32x2 lo = *(const LAS u32x2*)vp, hi = *(const LAS u32x2*)(vp + 8);
          o1 = MFMA32(__builtin_bit_cast(bf16x8, ((u32x4){lo.x, lo.y, hi.x, hi.y})), bfrag, o1);
        }
      }
    }
  }
#undef ATT_PREFETCH
  const float inv = 1.f / (l_run + __shfl_xor(l_run, 32));
  bf16_t* yp = Y + (size_t)(rowbase + qpos) * 1024 + 512 + head * 64;
#pragma unroll
  for (int g = 0; g < 4; ++g) {
    *(u32x2*)(yp + 8 * g + 4 * hh) = (u32x2){pack2(o0[4 * g] * inv, o0[4 * g + 1] * inv), pack2(o0[4 * g + 2] * inv, o0[4 * g + 3] * inv)};
    *(u32x2*)(yp + 32 + 8 * g + 4 * hh) = (u32x2){pack2(o1[4 * g] * inv, o1[4 * g + 1] * inv), pack2(o1[4 * g + 2] * inv, o1[4 * g + 3] * inv)};
  }
  __syncthreads();
}

DI float wave_incl_scan(float v, int lane) {
#pragma unroll
  for (int o = 1; o < 64; o <<= 1) { const float t = __shfl_up(v, o); if (lane >= o) v += t; }
  return v;
}
DI void dn1_phase(const Params& p, lptr lds, int l) {
  const int tid = tid_opaque(), wid = tid >> 6, lane = tid & 63;
  const int i2 = l >> 1, bid = bid_opaque(), G = gridDim.x, hd = bid & 7;
  bf16_t* P = (bf16_t*)(p.ws + WS_P);
  const bf16_t* halo = (const bf16_t*)(p.ws + WS_HALO);
  const float* ab = (const float*)(p.ws + WS_AB);
  LAS bf16_t* Raw = (LAS bf16_t*)lds;
  LAS float* X = (LAS float*)lds;
  LAS bf16_t* Kn = (LAS bf16_t*)(lds + 51456);
  LAS float* KK = (LAS float*)(lds + 68864);
  LAS float* Lm = (LAS float*)(lds + 85248);
  LAS float* gcs = (LAS float*)(lds + 118016);
  LAS float* bts = (LAS float*)(lds + 118528);
  const float alog0 = -__expf(p.in[25][(i2 * 2 + (wid & 1)) * 8 + hd]), dtb0 = p.in[26][(i2 * 2 + (wid & 1)) * 8 + hd];
  LAS float* cwl = (LAS float*)(lds + 131072);
  for (int e = tid; e < 1536; e += 512) { const int part = e >> 9, j = (e >> 7) & 3, c = e & 127; cwl[e] = p.in[24][((size_t)i2 * 4 + j) * 3072 + part * 1024 + hd * 128 + c]; }
  __syncthreads();
  u32x4 rv[7]; float pa0 = 0.f, pa1 = 0.f;
#define DN1_PREFETCH(item_) do { const int ck_ = (item_) >> 3; const int row0_ = ck_ * 64; \
    const int ci_ = ck_ < 64 ? (ck_ & 3) : ((ck_ - 64) & 63); const int nch_ = ck_ < 64 ? 4 : 64; \
    _Pragma("unroll") for (int k_ = 0; k_ < 7; ++k_) { \
      int e_ = tid + 512 * k_; if (e_ > 3215) e_ = 3215; \
      const int part_ = e_ / 1072, rem_ = e_ % 1072, rr_ = rem_ >> 4, pc_ = rem_ & 15, col_ = part_ * 1024 + hd * 128 + pc_ * 8; \
      const bool mid_ = rr_ >= 2 && rr_ < 66; \
      const bool zero_ = (rr_ < 2 && ci_ == 0) || (rr_ >= 66 && ci_ == nch_ - 1); \
      const bf16_t* srcp_ = mid_ ? P + (size_t)(row0_ + rr_ - 2) * ODD_LD + col_ \
                               : (rr_ < 2 ? halo + ((size_t)(ck_ - 1) * 3 + 1 + rr_) * 3072 + col_ : halo + ((size_t)(ck_ + 1) * 3) * 3072 + col_); \
      if (zero_) srcp_ = P + (size_t)row0_ * ODD_LD + col_; \
      u32x4 v_ = *(const u32x4*)srcp_; \
      if (zero_) v_ = (u32x4){0u, 0u, 0u, 0u}; \
      rv[k_] = v_; } \
    if (wid < 2) { const int t_ = wid ? 63 - lane : lane; pa0 = ab[(size_t)(row0_ + t_) * 32 + wid * 8 + hd]; pa1 = ab[(size_t)(row0_ + t_) * 32 + 16 + wid * 8 + hd]; } } while (0)
  if (bid < 4608) DN1_PREFETCH(bid);
  for (int item = bid; item < 4608; item += G) {
  const int ck = item >> 3;
  const int row0 = ck * 64;
  {
#pragma unroll
    for (int k = 0; k < 7; ++k) {
      int e = tid + 512 * k; if (e > 3215) e = 3215;
      const int part = e / 1072, rem = e % 1072, rr = rem >> 4, pc = rem & 15;
      *(LAS u32x4*)(Raw + (part * 67 + rr) * 128 + pc * 8) = rv[k];
    }
  }
  const float a0 = pa0, a1 = pa1;
  __syncthreads();
  if (item + G < 4608) DN1_PREFETCH(item + G);
#pragma unroll 2
  for (int tk = 0; tk < 6; ++tk) {
    const int task = tid + 512 * tk;
    const int c8i = task & 15, rp = task >> 4, part = tk >> 1, t = rp & 63, col = part * 1024 + hd * 128 + c8i * 8;
    float y[8];
#pragma unroll
    for (int e = 0; e < 8; ++e) y[e] = 0.f;
#pragma unroll
    for (int j = 0; j < 4; ++j) {
      const u32x4 raw = *(const LAS u32x4*)(Raw + (part * 67 + t + j) * 128 + c8i * 8);
      const f32x4 cw0 = *(const LAS f32x4*)(cwl + (part * 4 + j) * 128 + c8i * 8), cw1 = *(const LAS f32x4*)(cwl + (part * 4 + j) * 128 + c8i * 8 + 4);
      y[0] += cw0[0] * lo2f(raw.x); y[1] += cw0[1] * hi2f(raw.x); y[2] += cw0[2] * lo2f(raw.y); y[3] += cw0[3] * hi2f(raw.y);
      y[4] += cw1[0] * lo2f(raw.z); y[5] += cw1[1] * hi2f(raw.z); y[6] += cw1[2] * lo2f(raw.w); y[7] += cw1[3] * hi2f(raw.w);
    }
    float ss = 0.f;
#pragma unroll
    for (int e = 0; e < 8; ++e) { y[e] = siluf_(y[e]); ss += y[e] * y[e]; }
    if (part < 2) {
      ss += __shfl_xor(ss, 1); ss += __shfl_xor(ss, 2); ss += __shfl_xor(ss, 4); ss += __shfl_xor(ss, 8);
      const float sc = rsqrtf(ss + 1e-6f) * (part == 0 ? 0.08838834764831845f : 1.f);
#pragma unroll
      for (int e = 0; e < 8; ++e) y[e] *= sc;
    }
    const u32x4 w = (u32x4){pack2(y[0], y[1]), pack2(y[2], y[3]), pack2(y[4], y[5]), pack2(y[6], y[7])};
    *(u32x4*)(P + (size_t)(row0 + t) * ODD_LD + col) = w;
    if (part == 1) *(LAS u32x4*)(Kn + t * 136 + c8i * 8) = w;
  }
  if (wid < 2) {
    const int dir = wid;
    const float g = alog0 * softplusf_(a0 + dtb0);
    const float gcv = wave_incl_scan(g, lane), btv = sigmoidf_(a1);
    gcs[dir * 64 + lane] = gcv; bts[dir * 64 + lane] = btv;
    float* gcb = (float*)(p.ws + WS_CARRY) + ((size_t)(ck * 8 + hd) * 2 + dir) * 128;
    gcb[lane] = gcv; gcb[64 + lane] = btv;
  }
  __syncthreads();
  if (wid < 4) {
    const int it = wid >> 1, jt = wid & 1, hh = lane >> 5;
    const f32x16 acc = mm32(Kn + it * 32 * 136, 136, Kn + jt * 32 * 136, 136, 128, zero16(), lane);
#pragma unroll
    for (int ii = 0; ii < 16; ++ii) KK[(it * 32 + crow(ii, hh)) * 64 + jt * 32 + (lane & 31)] = acc[ii];
  }
  __syncthreads();
  for (int e0 = tid; e0 < 8192; e0 += 2048) {
    float wv[4];
#pragma unroll
    for (int k = 0; k < 4; ++k) {
      const int e = e0 + 512 * k, dir = e >> 12, ip = (e >> 6) & 63, jp = e & 63;
      const int ti = dir ? 63 - ip : ip, tj = dir ? 63 - jp : jp;
      const float w = bts[dir * 64 + ip] * KK[ti * 64 + tj] * __expf(fminf(gcs[dir * 64 + ip] - gcs[dir * 64 + jp], 0.f));
      wv[k] = (ip > jp) ? w : 0.f;
    }
#pragma unroll
    for (int k = 0; k < 4; ++k) Lm[e0 + 512 * k] = wv[k];
  }
  __syncthreads();
  for (int e = tid; e < 8192; e += 512) X[e] = 0.f;
  __syncthreads();
  {
    const int d = wid >> 2, bi = wid & 3;
    if (lane < 16) {
      const int c = lane; float x[16];
      const LAS float* L = Lm + d * 4096 + (16 * bi) * 64 + 16 * bi;
#pragma unroll
      for (int i = 0; i < 16; ++i) {
        float s = (c == i) ? 1.f : 0.f;
#pragma unroll
        for (int j = 0; j < i; ++j) s -= L[i * 64 + j] * x[j];
        x[i] = s;
      }
#pragma unroll
      for (int i = 0; i < 16; ++i) X[d * 4096 + (16 * bi + i) * 64 + 16 * bi + c] = x[i];
    }
  }
  __syncthreads();
  LAS float* Tm = (LAS float*)(lds + 119040) + wid * 256;
  for (int dd = 1; dd < 4; ++dd) {
    const int nb = 4 - dd; const bool act = wid < 2 * nb;
    const int d = act ? wid / nb : 0, bi = act ? dd + wid % nb : dd, bj = bi - dd;
    const int lr = lane & 15, lq = lane >> 4;
    if (act) {
      f32x4 acc = (f32x4){0.f, 0.f, 0.f, 0.f};
      for (int kb = bj; kb < bi; ++kb) {
#pragma unroll
        for (int kk = 0; kk < 4; ++kk) {
          const float a = Lm[d * 4096 + (16 * bi + lr) * 64 + 16 * kb + 4 * kk + lq];
          const float b = X[d * 4096 + (16 * kb + 4 * kk + lq) * 64 + 16 * bj + lr];
          acc = __builtin_amdgcn_mfma_f32_16x16x4f32(a, b, acc, 0, 0, 0);
        }
      }
#pragma unroll
      for (int rg = 0; rg < 4; ++rg) Tm[(lq * 4 + rg) * 16 + lr] = acc[rg];
    }
    __syncthreads();
    if (act) {
      f32x4 acc = (f32x4){0.f, 0.f, 0.f, 0.f};
#pragma unroll
      for (int kk = 0; kk < 4; ++kk) {
        const float a = X[d * 4096 + (16 * bi + lr) * 64 + 16 * bi + 4 * kk + lq];
        const float b = Tm[(4 * kk + lq) * 16 + lr];
        acc = __builtin_amdgcn_mfma_f32_16x16x4f32(a, b, acc, 0, 0, 0);
      }
#pragma unroll
      for (int rg = 0; rg < 4; ++rg) X[d * 4096 + (16 * bi + lq * 4 + rg) * 64 + 16 * bj + lr] = -acc[rg];
    }
    __syncthreads();
  }
  {
    bf16_t* Tg = (bf16_t*)(p.ws + WS_T) + ((size_t)(ck * 8 + hd) * 2) * 4096;
    for (int e = tid; e < 4096; e += 512) *(unsigned*)(Tg + 2 * e) = pack2(X[2 * e], X[2 * e + 1]);
  }
  __syncthreads();
  }
#undef DN1_PREFETCH
}

constexpr int DN2_DIR_BYTES = 80896;
DI void dn2_item(const Params& p, lptr lds, int l, int item) {
  const int tid = tid_opaque(), wid = tid >> 6, lane = tid & 63, r = lane & 31, hh = lane >> 5;
  const int i2 = l >> 1;
  const bool samp = item < 256;
  int b, hd, slab, nch, seqrow, ckb;
  if (samp) { b = item >> 5; hd = (item >> 2) & 7; slab = item & 3; nch = 64; seqrow = M_P + b * 4096; ckb = 64 + b * 64; }
  else { const int j = item - 256; b = j >> 5; hd = (j >> 2) & 7; slab = j & 3; nch = 4; seqrow = b * 256; ckb = b * 4; }
  const int dir = wid >> 2, w4 = wid & 3, td = tid & 255;
  const bf16_t* P = (const bf16_t*)(p.ws + WS_P);
  const bf16_t* Tg = (const bf16_t*)(p.ws + WS_T);
  const float* gcbase = (const float*)(p.ws + WS_CARRY);
  bf16_t* O = (bf16_t*)(p.ws + WS_H);
  lptr base = lds + dir * DN2_DIR_BYTES;
  LAS bf16_t* Qn = (LAS bf16_t*)base;
  LAS bf16_t* Kn = (LAS bf16_t*)(base + 17408);
  LAS bf16_t* Tm = (LAS bf16_t*)(base + 34816);
  LAS bf16_t* QK = (LAS bf16_t*)(base + 44032);
  LAS bf16_t* St = (LAS bf16_t*)(base + 53248);
  LAS bf16_t* Rt = (LAS bf16_t*)(base + 61952);
  LAS bf16_t* Vt = (LAS bf16_t*)(base + 66560);
  LAS bf16_t* Vn = (LAS bf16_t*)(base + 71168);
  LAS bf16_t* Vd = (LAS bf16_t*)(base + 75776);
  LAS float* gcs = (LAS float*)(base + 80384);
  LAS float* bts = gcs + 64;
  LAS float* egs = (LAS float*)(lds + 2 * DN2_DIR_BYTES) + dir * 128;
  LAS float* dds = egs + 64;
  f32x16 S;
  const size_t sidx = ((((size_t)(b * 2 + i2) * 2 + dir) * 8 + hd) * 128 + 32 * w4) * 128 + slab * 32 + r;
#pragma unroll
  for (int ii = 0; ii < 16; ++ii) S[ii] = samp ? p.in[6][sidx + (size_t)crow(ii, hh) * 128] : 0.f;
#pragma unroll
  for (int g = 0; g < 4; ++g) *(LAS u32x2*)(St + r * 136 + 32 * w4 + 8 * g + 4 * hh) = (u32x2){pack2(S[4 * g], S[4 * g + 1]), pack2(S[4 * g + 2], S[4 * g + 3])};
  u32x4 pq[4], pk[4], pt[2], pv; float pa0 = 0.f, pa1 = 0.f;
#define DN2_PREFETCH(sn) do { const int cn_ = dir ? nch - 1 - (sn) : (sn); const size_t r0_ = (size_t)seqrow + (size_t)cn_ * 64; \
    _Pragma("unroll") for (int k_ = 0; k_ < 4; ++k_) { const int e_ = td + 256 * k_, ip_ = e_ >> 4, pc_ = e_ & 15; const size_t rg_ = r0_ + (dir ? 63 - ip_ : ip_); \
      pq[k_] = *(const u32x4*)(P + rg_ * ODD_LD + hd * 128 + pc_ * 8); pk[k_] = *(const u32x4*)(P + rg_ * ODD_LD + 1024 + hd * 128 + pc_ * 8); } \
    _Pragma("unroll") for (int k_ = 0; k_ < 2; ++k_) { const int e_ = td + 256 * k_; pt[k_] = *(const u32x4*)(Tg + ((size_t)((ckb + cn_) * 8 + hd) * 2 + dir) * 4096 + e_ * 8); } \
    { const int ip_ = td >> 2, pc_ = td & 3; const size_t rg_ = r0_ + (dir ? 63 - ip_ : ip_); pv = *(const u32x4*)(P + rg_ * ODD_LD + 2048 + hd * 128 + slab * 32 + pc_ * 8); } \
    if (w4 == 0) { const float* gcb_ = gcbase + ((size_t)((ckb + cn_) * 8 + hd) * 2 + dir) * 128; pa0 = gcb_[lane]; pa1 = gcb_[64 + lane]; } } while (0)
  DN2_PREFETCH(0);
  f32x16 o1 = zero16();
  for (int s = 0; s < nch; ++s) {
    const int c = dir ? nch - 1 - s : s;
    const int row0c = seqrow + c * 64;
#pragma unroll
    for (int k = 0; k < 4; ++k) { const int e = td + 256 * k, ip = e >> 4, pc = e & 15; *(LAS u32x4*)(Qn + ip * 136 + pc * 8) = pq[k]; *(LAS u32x4*)(Kn + ip * 136 + pc * 8) = pk[k]; }
#pragma unroll
    for (int k = 0; k < 2; ++k) { const int e = td + 256 * k; *(LAS u32x4*)(Tm + (e >> 3) * 72 + (e & 7) * 8) = pt[k]; }
    { const int ip = td >> 2, pc = td & 3;
      Vt[(pc * 8 + 0) * 72 + ip] = (bf16_t)(pv.x & 0xffffu); Vt[(pc * 8 + 1) * 72 + ip] = (bf16_t)(pv.x >> 16);
      Vt[(pc * 8 + 2) * 72 + ip] = (bf16_t)(pv.y & 0xffffu); Vt[(pc * 8 + 3) * 72 + ip] = (bf16_t)(pv.y >> 16);
      Vt[(pc * 8 + 4) * 72 + ip] = (bf16_t)(pv.z & 0xffffu); Vt[(pc * 8 + 5) * 72 + ip] = (bf16_t)(pv.z >> 16);
      Vt[(pc * 8 + 6) * 72 + ip] = (bf16_t)(pv.w & 0xffffu); Vt[(pc * 8 + 7) * 72 + ip] = (bf16_t)(pv.w >> 16); }
    if (w4 == 0) { gcs[lane] = pa0; bts[lane] = pa1; egs[lane] = __expf(pa0); dds[lane] = __expf(__shfl(pa0, 63) - pa0); }
    __syncthreads();
    if (s + 1 < nch) DN2_PREFETCH(s + 1);
    bf16_t* const orow = O + (size_t)(row0c + (dir ? 63 - (td >> 2) : (td >> 2))) * 1024 + hd * 128 + slab * 32 + (td & 3) * 8;
    u32x4 po = (u32x4){0u, 0u, 0u, 0u};
    if (2 * s >= nch) po = *(const u32x4*)orow;
    {
      const int jt = w4 >> 1, it = w4 & 1;
      const LAS bf16_t* a2 = w4 < 2 ? Qn + w4 * 32 * 136 : Kn + (w4 - 2) * 32 * 136;
      f32x16 acc = zero16(), acc2 = zero16();
      {
        const LAS bf16_t* ap = Kn + jt * 32 * 136 + r * 136 + 8 * hh; const LAS bf16_t* bp = Qn + it * 32 * 136 + r * 136 + 8 * hh;
        const LAS bf16_t* cp = a2 + r * 136 + 8 * hh; const LAS bf16_t* dp = St + r * 136 + 8 * hh;
#pragma unroll 4
        for (int k0 = 0; k0 < 128; k0 += 16) {
          const bf16x8 fa = *(const LAS bf16x8*)(ap + k0), fb = *(const LAS bf16x8*)(bp + k0), fc = *(const LAS bf16x8*)(cp + k0), fd = *(const LAS bf16x8*)(dp + k0);
          acc = MFMA32(fa, fb, acc); acc2 = MFMA32(fc, fd, acc2);
        }
      }
      const int i = it * 32 + r; const float gi = gcs[i];
      f32x4 gjv[4];
#pragma unroll
      for (int g = 0; g < 4; ++g) gjv[g] = *(const LAS f32x4*)(gcs + jt * 32 + 8 * g + 4 * hh);
#pragma unroll
      for (int g = 0; g < 4; ++g) {
        const int j0 = jt * 32 + 8 * g + 4 * hh; float v[4];
        const f32x4 gj = gjv[g];
#pragma unroll
        for (int e = 0; e < 4; ++e) { const float w = acc[4 * g + e] * __expf(fminf(gi - gj[e], 0.f)); v[e] = (i >= j0 + e) ? w : 0.f; }
        *(LAS u32x2*)(QK + i * 72 + j0) = (u32x2){pack2(v[0], v[1]), pack2(v[2], v[3])};
      }
      if (w4 < 2) {
        o1 = acc2;
      } else {
        const int jt2 = w4 - 2;
#pragma unroll
        for (int g = 0; g < 4; ++g) {
          const int j0 = jt2 * 32 + 8 * g + 4 * hh;
          const u32x2 vv = *(const LAS u32x2*)(Vt + r * 72 + j0);
          const float ve[4] = {lo2f(vv.x), hi2f(vv.x), lo2f(vv.y), hi2f(vv.y)}; float rv[4];
          const f32x4 gj4 = *(const LAS f32x4*)(egs + j0), bj4 = *(const LAS f32x4*)(bts + j0);
#pragma unroll
          for (int e = 0; e < 4; ++e) rv[e] = bj4[e] * (ve[e] - gj4[e] * acc2[4 * g + e]);
          *(LAS u32x2*)(Rt + r * 72 + j0) = (u32x2){pack2(rv[0], rv[1]), pack2(rv[2], rv[3])};
        }
      }
    }
    __syncthreads();
    if (w4 >= 2) {
      const int it = w4 - 2;
      const f32x16 acc = mm32(Tm + it * 32 * 72, 72, Rt, 72, 64, zero16(), lane);
      f32x4 ddv[4];
#pragma unroll
      for (int g = 0; g < 4; ++g) ddv[g] = *(const LAS f32x4*)(dds + it * 32 + 8 * g + 4 * hh);
#pragma unroll
      for (int g = 0; g < 4; ++g) {
        const int i0 = it * 32 + 8 * g + 4 * hh; float dv[4];
        const f32x4 gi4 = ddv[g];
#pragma unroll
        for (int e = 0; e < 4; ++e) dv[e] = acc[4 * g + e] * gi4[e];
        *(LAS u32x2*)(Vn + r * 72 + i0) = (u32x2){pack2(acc[4 * g], acc[4 * g + 1]), pack2(acc[4 * g + 2], acc[4 * g + 3])};
        *(LAS u32x2*)(Vd + r * 72 + i0) = (u32x2){pack2(dv[0], dv[1]), pack2(dv[2], dv[3])};
      }
    }
    __syncthreads();
    if (w4 < 2) {
      const int it = w4;
#pragma unroll
      for (int g = 0; g < 4; ++g) { const f32x4 gi4 = *(const LAS f32x4*)(egs + it * 32 + 8 * g + 4 * hh);
#pragma unroll
        for (int e = 0; e < 4; ++e) o1[4 * g + e] *= gi4[e]; }
      o1 = mm32(QK + it * 32 * 72, 72, Vn, 72, 64, o1, lane);
#pragma unroll
      for (int ii = 0; ii < 16; ++ii) Rt[(it * 32 + crow(ii, hh)) * 32 + r] = f2bf(o1[ii]);
    }
    {
      const float gl = egs[63];
#pragma unroll
      for (int ii = 0; ii < 16; ++ii) S[ii] *= gl;
#pragma unroll
      for (int jt = 0; jt < 2; ++jt) {
        unsigned x[16];
#pragma unroll
        for (int ii = 0; ii < 16; ++ii) x[ii] = Kn[(jt * 32 + crow(ii, hh)) * 136 + 32 * w4 + r];
#pragma unroll
        for (int s2 = 0; s2 < 2; ++s2) {
          const u32x4 aw = (u32x4){x[8 * s2] | (x[8 * s2 + 1] << 16), x[8 * s2 + 2] | (x[8 * s2 + 3] << 16), x[8 * s2 + 4] | (x[8 * s2 + 5] << 16), x[8 * s2 + 6] | (x[8 * s2 + 7] << 16)};
          const LAS bf16_t* bp = Vd + r * 72 + jt * 32 + 16 * s2 + 4 * hh;
          const u32x2 lo = *(const LAS u32x2*)bp, hi = *(const LAS u32x2*)(bp + 8);
          S = MFMA32(__builtin_bit_cast(bf16x8, aw), __builtin_bit_cast(bf16x8, ((u32x4){lo.x, lo.y, hi.x, hi.y})), S);
        }
      }
#pragma unroll
      for (int g = 0; g < 4; ++g) *(LAS u32x2*)(St + r * 136 + 32 * w4 + 8 * g + 4 * hh) = (u32x2){pack2(S[4 * g], S[4 * g + 1]), pack2(S[4 * g + 2], S[4 * g + 3])};
    }
    __syncthreads();
    {
      u32x4 ov = *(const LAS u32x4*)(Rt + (td >> 2) * 32 + (td & 3) * 8);
      if (2 * s >= nch) {
        ov.x = pack2(lo2f(ov.x) + lo2f(po.x), hi2f(ov.x) + hi2f(po.x)); ov.y = pack2(lo2f(ov.y) + lo2f(po.y), hi2f(ov.y) + hi2f(po.y));
        ov.z = pack2(lo2f(ov.z) + lo2f(po.z), hi2f(ov.z) + hi2f(po.z)); ov.w = pack2(lo2f(ov.w) + lo2f(po.w), hi2f(ov.w) + hi2f(po.w));
      }
      *(u32x4*)orow = ov;
    }
  }
#undef DN2_PREFETCH
  if (!samp) {
    const size_t oidx = (size_t)OFF_DN + ((((size_t)(b * 2 + i2) * 2 + dir) * 8 + hd) * 128 + 32 * w4) * 128 + slab * 32 + r;
#pragma unroll
    for (int ii = 0; ii < 16; ++ii) p.out[oidx + (size_t)crow(ii, hh) * 128] = S[ii];
  }
}

DI void phase_dn3(const Params& p, int l) {
  const int i2 = l >> 1;
  bf16_t* Y = (bf16_t*)(p.ws + WS_H);
  const bf16_t* P = (const bf16_t*)(p.ws + WS_P);
  const float* gain = p.in[27] + i2 * 128;
  const int tstride = gridDim.x * 512, ntask = M_TOT * 128;
  u32x4 ov[2], zv[2], nov[2], nzv[2];
  int task0 = bid_opaque() * 512 + tid_opaque();
#define DN3_LOAD(ovv, zvv, t0_) do { _Pragma("unroll") for (int q_ = 0; q_ < 2; ++q_) { \
      int task_ = (t0_) + q_ * tstride; if (task_ >= ntask) task_ = bid_opaque() * 512 + tid_opaque(); \
      const int pc_ = task_ & 15, rh_ = task_ >> 4, hd_ = rh_ & 7, row_ = rh_ >> 3, col_ = hd_ * 128 + pc_ * 8; \
      ovv[q_] = *(const u32x4*)(Y + (size_t)row_ * 1024 + col_); zvv[q_] = *(const u32x4*)(P + (size_t)row_ * ODD_LD + 3072 + col_); } } while (0)
  if (task0 < ntask) DN3_LOAD(ov, zv, task0);
  const f32x4 g0 = *(const f32x4*)(gain + (tid_opaque() & 15) * 8), g1 = *(const f32x4*)(gain + (tid_opaque() & 15) * 8 + 4);
  const float gg[8] = {g0[0], g0[1], g0[2], g0[3], g1[0], g1[1], g1[2], g1[3]};
  for (; task0 < ntask; task0 += 2 * tstride) {
    if (task0 + 2 * tstride < ntask) DN3_LOAD(nov, nzv, task0 + 2 * tstride);
#pragma unroll
    for (int q = 0; q < 2; ++q) {
      const int task = task0 + q * tstride;
      const int pc = task & 15, rh = task >> 4, hd = rh & 7, row = rh >> 3, col = hd * 128 + pc * 8;
      float o[8] = {lo2f(ov[q].x), hi2f(ov[q].x), lo2f(ov[q].y), hi2f(ov[q].y), lo2f(ov[q].z), hi2f(ov[q].z), lo2f(ov[q].w), hi2f(ov[q].w)};
      const float z[8] = {lo2f(zv[q].x), hi2f(zv[q].x), lo2f(zv[q].y), hi2f(zv[q].y), lo2f(zv[q].z), hi2f(zv[q].z), lo2f(zv[q].w), hi2f(zv[q].w)};
      float ss = 0.f;
#pragma unroll
      for (int e = 0; e < 8; ++e) ss += o[e] * o[e];
      ss += __shfl_xor(ss, 1); ss += __shfl_xor(ss, 2); ss += __shfl_xor(ss, 4); ss += __shfl_xor(ss, 8);
      const float rstd = rsqrtf(ss * (1.f / 128.f) + 1e-6f);
#pragma unroll
      for (int e = 0; e < 8; ++e) o[e] = o[e] * rstd * gg[e] * siluf_(z[e]);
      if (task < ntask) *(u32x4*)(Y + (size_t)row * 1024 + col) = (u32x4){pack2(o[0], o[1]), pack2(o[2], o[3]), pack2(o[4], o[5]), pack2(o[6], o[7])};
    }
#pragma unroll
    for (int q = 0; q < 2; ++q) { ov[q] = nov[q]; zv[q] = nzv[q]; }
  }
#undef DN3_LOAD
}

constexpr int ROWS_A = 32768;
constexpr int N_PHASES = 1 + 11 + 11 + 10 + 11;
enum { ST_N1, ST_IN, ST_M0, ST_M1, ST_M2, ST_OUTA, ST_OUTB, ST_N2T, ST_GU, ST_DNA, ST_DNB, ST_N1T };
DI void run_phase(const Params& p, lptr lds, int ph) {
  const int G = gridDim.x, bid = bid_opaque();
  if (ph == 0) { phase_pre(p, lds, 0, G == 256 ? 2 : 4, bid, G, true); return; }
  int l, k; { int q = ph - 1; if (q < 11) { l = 0; k = q; } else if (q < 22) { l = 1; k = q - 11; } else if (q < 32) { l = 2; k = q - 22; } else { l = 3; k = q - 32; } }
  const bool odd = l & 1; const int i2 = l >> 1;
  int st;
  if (l == 0) { const int tab[11] = {ST_N1, ST_IN, ST_M0, ST_M1, ST_OUTA, ST_OUTB, ST_N2T, ST_GU, ST_DNA, ST_DNB, ST_N1T}; st = tab[k]; }
  else if (odd) { const int tab[11] = {ST_IN, ST_M0, ST_M1, ST_M2, ST_OUTA, ST_OUTB, ST_N2T, ST_GU, ST_DNA, ST_DNB, ST_N1T}; st = tab[k]; }
  else { const int tab[10] = {ST_IN, ST_M0, ST_M1, ST_OUTA, ST_OUTB, ST_N2T, ST_GU, ST_DNA, ST_DNB, ST_N1T}; st = tab[k]; }
  float* mod = (float*)(p.ws + WS_MOD);
  bf16_t* H = (bf16_t*)(p.ws + WS_H); bf16_t* Pb = (bf16_t*)(p.ws + WS_P);
  if (st == ST_N1) { phase_norm(p, lds, l, 0); return; }
  if (st == ST_IN) {
    pg8::EpiIn E; E.P = Pb; E.ldp = odd ? ODD_LD : EVEN_IN; E.odd = odd ? 1 : 0;
    E.kout = p.out + OFF_K + (size_t)i2 * 256 * 128; E.vout = p.out + OFF_V + (size_t)i2 * 256 * 128;
    E.ab = (float*)(p.ws + WS_AB); E.halo = (bf16_t*)(p.ws + WS_HALO);
    run_gemm(lds, H, (const bf16_t*)(p.ws + WS_WIN), odd ? ODD_NP : EVEN_IN, 1024, E); return;
  }
  if (st == ST_M0 || st == ST_M1 || st == ST_M2) {
    const int ms = st - ST_M0;
    if (ms == 0 && l > 0) { cvt_layer(p, lds, l, 4, bid, G); __syncthreads(); }
    if (!odd) {
      if (ms == 0) {
        for (int it = bid; it < 1152; it += G) att_item(p, lds, l, it);
        rg_phase(p, lds, l, 0);
      } else { rg_phase(p, lds, l, 1); }
    } else {
      if (ms == 0) dn1_phase(p, lds, l);
      else if (ms == 1) {
        for (int it = bid; it < 768; it += G) {
          const int grp = it >> 8, j = it & 255, xcd = j & 7, idx = j >> 3;
          dn2_item(p, lds, l, grp * 256 + ((xcd * 8 + (idx >> 2)) * 4 + (idx & 3))); __syncthreads();
        }
      }
      else phase_dn3(p, l);
    }
    return;
  }
  if (st == ST_OUTA || st == ST_OUTB) {
    pg8::EpiRes E; E.x = p.out; E.ga_base = mod + (size_t)l * 9 * 6144 + 2048;
    if (st == ST_OUTA) { E.rbase = 0; run_gemm_sub(lds, H, (const bf16_t*)(p.ws + WS_WOUT), ROWS_A, 1024, 1024, E, bid, G); return; }
    if (bid < 64) { E.rbase = ROWS_A; run_gemm_sub(lds, H + (size_t)ROWS_A * 1024, (const bf16_t*)(p.ws + WS_WOUT), M_TOT - ROWS_A, 1024, 1024, E, bid, 64); }
    else norm_rows(p, l, 1, 0, ROWS_A, bid - 64, G - 64);
    return;
  }
  if (st == ST_N2T) { norm_rows(p, l, 1, ROWS_A, M_TOT, bid, G); return; }
  if (st == ST_GU) { pg8::EpiGU E; E.act = Pb; run_gemm(lds, H, (const bf16_t*)(p.ws + WS_WGU), 5632, 1024, E); return; }
  if (st == ST_DNA || st == ST_DNB) {
    pg8::EpiRes E; E.x = p.out; E.ga_base = mod + (size_t)l * 9 * 6144 + 5120;
    if (st == ST_DNA) { E.rbase = 0; run_gemm_sub(lds, Pb, (const bf16_t*)(p.ws + WS_WDN), ROWS_A, 1024, DFF, E, bid, G); return; }
    if (bid < 64) { E.rbase = ROWS_A; run_gemm_sub(lds, Pb + (size_t)ROWS_A * DFF, (const bf16_t*)(p.ws + WS_WDN), M_TOT - ROWS_A, 1024, DFF, E, bid, 64); }
    else {
      if (l < 3) { norm_rows(p, l + 1, 0, 0, ROWS_A, bid - 64, G - 64); cvt_layer(p, lds, l + 1, 3, bid - 64, G - 64); if (l == 0 && G == 256) { __syncthreads(); phase_pre(p, lds, 2, 4, bid - 64, G - 64, false); } }
      else norm_rows(p, 0, 2, 0, ROWS_A, bid - 64, G - 64);
    }
    return;
  }
  if (l < 3) norm_rows(p, l + 1, 0, ROWS_A, M_TOT, bid, G); else norm_rows(p, 0, 2, ROWS_A, M_TOT, bid, G);
}

#define XB_TMO      128
#define XB_XCNT(j)  (256  + 64 * (j))
#define XB_XSUB(j)  (1280 + 64 * (j))
#define XB_XGEN(j)  (2304 + 64 * (j))
#define XB_TOP      3328
#define XB_TOPGEN   3392
#define XCD_BAR_WORDS 3456
#define XB_SPIN_CAP (1u << 20)
DI unsigned xb_ld(unsigned* p) { return __hip_atomic_load(p, __ATOMIC_RELAXED, __HIP_MEMORY_SCOPE_AGENT); }
DI unsigned xb_add(unsigned* p, unsigned v) { return __hip_atomic_fetch_add(p, v, __ATOMIC_RELAXED, __HIP_MEMORY_SCOPE_AGENT); }
DI unsigned xb_xcc_id() { return (unsigned)__builtin_amdgcn_s_getreg((3 << 11) | 20) & 0xFu; }
#define XB_SPIN(cond, bar) do { unsigned _sp = 0; while (cond) { __builtin_amdgcn_s_sleep(1); \
    if ((++_sp & 255u) == 0u) { if (xb_ld(&(bar)[XB_TMO])) break; if (_sp > XB_SPIN_CAP) { atomicAdd(&(bar)[XB_TMO], 1u); break; } } } } while (0)
struct XcdBarrier { unsigned* bar; unsigned x; volatile LAS unsigned* st; };
DI XcdBarrier xcd_barrier_post(unsigned* bar, volatile LAS unsigned* st) {
  XcdBarrier b; b.bar = bar; b.x = xb_xcc_id(); b.st = st;
  if (threadIdx.x == 0) (void)xb_add(&bar[XB_XCNT(b.x)], 1u);
  return b;
}
DI void xcd_barrier_complete(unsigned* bar, unsigned x, unsigned& nloc, unsigned& nx) {
  const unsigned G = gridDim.x;
  unsigned sum, cnt, mine, sp = 0u;
  for (;;) {
    sum = 0u; cnt = 0u; mine = 0u;
#pragma unroll
    for (unsigned j = 0; j < 16; ++j) { const unsigned c = xb_ld(&bar[XB_XCNT(j)]); sum += c; cnt += (c > 0u) ? 1u : 0u; mine = (j == x) ? c : mine; }
    if (sum == G) break;
    __builtin_amdgcn_s_sleep(1);
    if ((++sp & 255u) == 0u) { if (xb_ld(&bar[XB_TMO])) break; if (sp > XB_SPIN_CAP) { atomicAdd(&bar[XB_TMO], 1u); break; } }
  }
  nloc = mine > 0u ? mine : 1u; nx = cnt > 0u ? cnt : 1u;
}
DI void xcd_barrier(const XcdBarrier& b) {
  asm volatile("s_waitcnt vmcnt(0)" ::: "memory");
  __syncthreads();
  if (threadIdx.x == 0) {
    unsigned* bar = b.bar;
    __builtin_amdgcn_s_waitcnt(0);
    unsigned nloc = b.st[0], nx = b.st[1];
    if (nloc == 0u) { xcd_barrier_complete(bar, b.x, nloc, nx); b.st[0] = nloc; b.st[1] = nx; }
    const unsigned old = xb_add(&bar[XB_XSUB(b.x)], 1u);
    const unsigned gen = old / nloc;
    if (old + 1u == (gen + 1u) * nloc) {
      __builtin_amdgcn_fence(__ATOMIC_RELEASE, "agent");
      asm volatile("s_waitcnt vmcnt(0)" ::: "memory");
      const unsigned og = xb_add(&bar[XB_TOP], 1u);
      const unsigned tg = og / nx;
      if (og + 1u == (tg + 1u) * nx) xb_add(&bar[XB_TOPGEN], 1u);
      else XB_SPIN(xb_ld(&bar[XB_TOPGEN]) == tg, bar);
      __builtin_amdgcn_fence(__ATOMIC_ACQUIRE, "agent");
      xb_add(&bar[XB_XGEN(b.x)], 1u);
      asm volatile("s_waitcnt vmcnt(0)" ::: "memory");
    } else {
      XB_SPIN(xb_ld(&bar[XB_XGEN(b.x)]) == gen, bar);
      __builtin_amdgcn_fence(__ATOMIC_ACQUIRE, "agent");
      asm volatile("s_waitcnt vmcnt(0)" ::: "memory");
    }
  }
  __syncthreads();
}

__global__ void __launch_bounds__(512, 2) fwd_kernel(Params p) {
  extern __shared__ __attribute__((aligned(16))) unsigned char smem[];
  lptr lds = (lptr)smem;
  cg::grid_group grid = cg::this_grid();
  volatile LAS unsigned* xst = (volatile LAS unsigned*)(lds + LDS_BYTES - 16);
  if (threadIdx.x == 0) { xst[0] = 0u; xst[1] = 0u; }
  __syncthreads();
  const XcdBarrier xb = xcd_barrier_post((unsigned*)(p.ws + WS_BAR), xst);
  const int p_lo = p.p_lo, p_hi = p.p_hi, coop = p.coop;
  for (int ph = p_lo; ph < p_hi; ++ph) {
    unsigned long long kav = (unsigned long long)__builtin_amdgcn_kernarg_segment_ptr();
    asm volatile("" : "+s"(kav));
    const __attribute__((address_space(4))) Params* kp = (const __attribute__((address_space(4))) Params*)kav;
    run_phase(*(const Params*)kp, lds, ph);
    if (coop && ph + 1 < p_hi) {
      if (ph == p_lo) grid.sync();
      else xcd_barrier(xb);
    }
  }
}

extern "C" void kernel_launch(void* const* d_in, const int* in_sizes, int n_in, void* d_out, int out_size, void* d_ws, size_t ws_size, hipStream_t stream) {
  static int grid = 0;
  if (grid == 0) {
    if (n_in != 31 || ws_size < WS_TOTAL) { fprintf(stderr, "kernel_launch: unexpected n_in %d or ws_size %zu (need %zu)\n", n_in, ws_size, (size_t)WS_END); grid = -1; return; }
    int dev = 0, cus = 0, per_cu = 0;
    hipGetDevice(&dev);
    hipDeviceGetAttribute(&cus, hipDeviceAttributeMultiprocessorCount, dev);
    if (hipFuncSetAttribute((const void*)fwd_kernel, hipFuncAttributeMaxDynamicSharedMemorySize, LDS_BYTES) != hipSuccess) { fprintf(stderr, "kernel_launch: hipFuncSetAttribute failed\n"); }
    hipOccupancyMaxActiveBlocksPerMultiprocessor(&per_cu, (const void*)fwd_kernel, 512, LDS_BYTES);
    (void)hipGetLastError();
    if (per_cu < 1) per_cu = 1;
    grid = cus * per_cu;
    if (grid > 256) grid = 256;
    fprintf(stderr, "kernel_launch: cus %d per_cu %d grid %d ws %zu need %zu\n", cus, per_cu, grid, ws_size, (size_t)WS_END);
  }
  if (grid < 0) return;
  if (hipMemsetAsync((char*)d_ws + WS_BAR, 0, 16384, stream) != hipSuccess) fprintf(stderr, "kernel_launch: memset failed\n");
  Params p{};
  for (int i = 0; i < 31; ++i) p.in[i] = (const float*)d_in[i];
  p.out = (float*)d_out; p.ws = (unsigned char*)d_ws; p.p_lo = 0; p.p_hi = N_PHASES; p.coop = 1; p.pad = 0;
  void* args[] = {&p};
  hipError_t e = hipLaunchCooperativeKernel((const void*)fwd_kernel, dim3(grid), dim3(512), args, LDS_BYTES, stream);
  if (e != hipSuccess) fprintf(stderr, "cooperative launch failed: %s (grid %d)\n", hipGetErrorString(e), grid);
}
```

```cpp
#include <hip/hip_runtime.h>
#include <hip/hip_cooperative_groups.h>
#include <cstdio>
namespace cg = cooperative_groups;
#define DI __device__ __forceinline__
#define LAS __attribute__((address_space(3)))
typedef unsigned short bf16_t;
typedef short bf16x8 __attribute__((ext_vector_type(8)));
typedef float f32x4 __attribute__((ext_vector_type(4)));
typedef float f32x16 __attribute__((ext_vector_type(16)));
typedef unsigned u32x4 __attribute__((ext_vector_type(4)));
typedef unsigned u32x2 __attribute__((ext_vector_type(2)));
typedef LAS unsigned char* lptr;

constexpr int M_TOT = 36864, M_P = 4096, DM = 1024;
constexpr int EVEN_IN = 1792, ODD_NP = 4352, ODD_LD = 4096, DFF = 2816;
constexpr int OFF_K = M_TOT * DM, OFF_V = OFF_K + 1048576, OFF_RG = OFF_V + 1048576, OFF_DN = OFF_RG + 32768;
constexpr size_t WS_MOD = 0;
constexpr size_t WS_ROPE = WS_MOD + 884736;
constexpr size_t WS_WIN = WS_ROPE + 1048576;
constexpr size_t WS_WOUT = WS_WIN + (size_t)ODD_NP * 1024 * 2;
constexpr size_t WS_WGU = WS_WOUT + 1024 * 1024 * 2;
constexpr size_t WS_WDN = WS_WGU + (size_t)5632 * 1024 * 2;
constexpr size_t WS_RGW = WS_WDN + (size_t)1024 * 2816 * 2;
constexpr size_t WS_H = WS_RGW + 262144;
constexpr size_t WS_P = WS_H + (size_t)M_TOT * 1024 * 2;
constexpr size_t WS_AB = WS_P + (size_t)M_TOT * 4096 * 2;
constexpr size_t WS_HALO = WS_AB + (size_t)M_TOT * 32 * 4;
constexpr size_t WS_T = WS_HALO + (size_t)576 * 3 * 3072 * 2;
constexpr size_t WS_CARRY = WS_T + (size_t)576 * 8 * 2 * 4096 * 2;
constexpr size_t WS_END = WS_CARRY + (size_t)576 * 2 * 2 * 512 * 4;
constexpr size_t WS_BAR = WS_END;
constexpr size_t WS_TOTAL = WS_BAR + 16384;
constexpr int LDS_BYTES = 160 * 1024;

struct Params {
  const float* in[31];
  float* out;
  unsigned char* ws;
  int p_lo, p_hi, coop, pad;
};

DI int tid_opaque() { int t = threadIdx.x; asm volatile("" : "+v"(t)); return t; }
DI int bid_opaque() { int t = blockIdx.x; asm volatile("" : "+s"(t)); return t; }

typedef __bf16 hwbf16x2 __attribute__((ext_vector_type(2)));
typedef float f32x2v __attribute__((ext_vector_type(2)));
DI unsigned pack2(float lo, float hi) { const f32x2v v = {lo, hi}; return __builtin_bit_cast(unsigned, __builtin_convertvector(v, hwbf16x2)); }
DI bf16_t f2bf(float f) { return (bf16_t)(pack2(f, 0.f) & 0xffffu); }
DI float bf2f(bf16_t b) { return __uint_as_float(((unsigned)b) << 16); }
DI float lo2f(unsigned u) { return __uint_as_float(u << 16); }
DI float hi2f(unsigned u) { return __uint_as_float(u & 0xffff0000u); }
DI float sigmoidf_(float x) { return __builtin_amdgcn_rcpf(1.f + __expf(-x)); }
DI float siluf_(float x) { return x * __builtin_amdgcn_rcpf(1.f + __expf(-x)); }
DI float softplusf_(float x) { return x > 20.f ? x : log1pf(__expf(x)); }
DI int crow(int reg, int h) { return (reg & 3) + 8 * (reg >> 2) + 4 * h; }
DI int row_group(int r) { return r < M_P ? 0 : 1 + ((r - M_P) >> 12); }
DI float wave_sum(float v) {
#pragma unroll
  for (int o = 32; o > 0; o >>= 1) v += __shfl_xor(v, o);
  return v;
}
#define MFMA32(a, b, c) __builtin_amdgcn_mfma_f32_32x32x16_bf16((a), (b), (c), 0, 0, 0)
DI f32x16 mm32(const LAS bf16_t* A, int lda, const LAS bf16_t* Bt, int ldb, int K, f32x16 acc, int lane) {
  const int r = lane & 31, h = lane >> 5;
  const LAS bf16_t* ap = A + r * lda + 8 * h;
  const LAS bf16_t* bp = Bt + r * ldb + 8 * h;
_Pragma("unroll 4")
  for (int k0 = 0; k0 < K; k0 += 16) {
    bf16x8 a = *(const LAS bf16x8*)(ap + k0);
    bf16x8 b = *(const LAS bf16x8*)(bp + k0);
    acc = MFMA32(a, b, acc);
  }
  return acc;
}
DI f32x16 zero16() { f32x16 z; for (int i = 0; i < 16; ++i) z[i] = 0.f; return z; }

DI void phase_pre(const Params& p, lptr lds, int l_lo, int l_hi, int vb, int nb, bool rope) {
  const int tid = tid_opaque(), wid = tid >> 6, lane = tid & 63;
  float* rc = (float*)(p.ws + WS_ROPE); float* rs = rc + 4096 * 32;
  if (rope)
  for (int e = bid_opaque() * 512 + tid; e < 4096 * 32; e += gridDim.x * 512) {
    const int t = e >> 5, f = e & 31, fr = f & 15;
    const float inv = exp2f(-(float)fr * 0.83048202372184058696f);
    const float pos = (f < 16) ? (float)(t >> 6) : (float)(t & 63);
    float x = pos * inv * 0.15915494309189533577f; x -= floorf(x);
    rc[e] = __builtin_amdgcn_cosf(x); rs[e] = __builtin_amdgcn_sinf(x);
  }
  LAS float* sc = (LAS float*)lds;
  LAS float* red = sc + 9 * 1024;
  for (int e = tid; e < 9 * 1024; e += 512) { const int g = e >> 10, k = e & 1023; const float v = g == 0 ? p.in[7][k] : p.in[2][(g - 1) * 1024 + k]; sc[e] = siluf_(v); }
  __syncthreads();
  float* mod = (float*)(p.ws + WS_MOD);
  for (int it = vb; it < (l_hi - l_lo) * 96; it += nb) {
    const int l = l_lo + it / 96, n0 = (it % 96) * 64;
    const float* w = p.in[8] + (size_t)l * 1024 * 6144 + n0 + lane;
    float acc[9];
#pragma unroll
    for (int g = 0; g < 9; ++g) acc[g] = 0.f;
    for (int k0 = wid * 128; k0 < wid * 128 + 128; k0 += 16) {
      float wv[16];
#pragma unroll
      for (int j = 0; j < 16; ++j) wv[j] = w[(size_t)(k0 + j) * 6144];
#pragma unroll
      for (int j = 0; j < 16; ++j)
#pragma unroll
        for (int g = 0; g < 9; ++g) acc[g] += sc[g * 1024 + k0 + j] * wv[j];
    }
#pragma unroll
    for (int g = 0; g < 9; ++g) red[(wid * 9 + g) * 64 + lane] = acc[g];
    __syncthreads();
    for (int e = tid; e < 9 * 64; e += 512) {
      const int g = e >> 6, c = e & 63; float s = 0.f;
#pragma unroll
      for (int w8 = 0; w8 < 8; ++w8) s += red[(w8 * 9 + g) * 64 + c];
      mod[((size_t)l * 9 + g) * 6144 + n0 + c] = s + p.in[9][l * 6144 + n0 + c];
    }
    __syncthreads();
  }
}

DI void cvt_tile(const float* src, int lds_src, int nvalid, bf16_t* dst, int ldd, int k0, int n0, int mode, LAS float* buf) {
  const int tid = tid_opaque();
  {
    float v[8];
#pragma unroll
    for (int k = 0; k < 8; ++k) { const int e = tid + 512 * k, i = e >> 6, j = e & 63; v[k] = src[(size_t)i * lds_src + (j < nvalid ? j : nvalid - 1)]; }
#pragma unroll
    for (int k = 0; k < 8; ++k) { const int e = tid + 512 * k, i = e >> 6, j = e & 63; buf[i * 65 + j] = (j < nvalid) ? v[k] : 0.f; }
  }
  __syncthreads();
  for (int e = tid; e < 2048; e += 512) {
    const int j = e >> 5, i2 = (e & 31) * 2;
    if (j < nvalid) {
      int n = n0 + j, row = n;
      if (mode == 1) { const int up = n >= DFF ? 1 : 0; const int jj = n - up * DFF; row = 256 * (jj >> 7) + 128 * up + (jj & 127); }
      *(unsigned*)(dst + (size_t)row * ldd + k0 + i2) = pack2(buf[i2 * 65 + j], buf[(i2 + 1) * 65 + j]);
    }
  }
  __syncthreads();
}
DI void cvt_matrix(const float* W, int K, int N, bf16_t* dst, int mode, LAS float* buf, int vb, int nb) {
  const int nk = K / 64, nn = (N + 63) / 64;
  for (int t = vb; t < nk * nn; t += nb) {
    const int tk = t % nk, tn = t / nk, k0 = tk * 64, n0 = tn * 64;
    const int nvalid = (N - n0) < 64 ? (N - n0) : 64;
    cvt_tile(W + (size_t)k0 * N + n0, N, nvalid, dst, K, k0, n0, mode, buf);
  }
}

DI void cvt_layer(const Params& p, lptr lds, int l, int what, int vb, int nb) {
  const int tid = tid_opaque();
  const int i2 = l >> 1;
  LAS float* buf = (LAS float*)lds;
  if (what & 1) {
    if ((l & 1) == 0) {
      cvt_matrix(p.in[13] + (size_t)i2 * 1024 * EVEN_IN, 1024, EVEN_IN, (bf16_t*)(p.ws + WS_WIN), 0, buf, vb, nb);
      cvt_matrix(p.in[22] + (size_t)i2 * 1024 * 1024, 1024, 1024, (bf16_t*)(p.ws + WS_WOUT), 0, buf, vb, nb);
      for (int t = vb; t < 32; t += nb) {
        const int gate = t >> 4, dir = (t >> 3) & 1, n = t & 7;
        const float* srcp = (gate ? p.in[18] : p.in[16]) + ((size_t)(i2 * 2 + dir) * 8 + n) * 4096;
        cvt_tile(srcp, 64, 64, (bf16_t*)(p.ws + WS_RGW) + ((size_t)(dir * 2 + gate) * 8 + n) * 4096, 64, 0, 0, 0, buf);
      }
    } else {
      cvt_matrix(p.in[23] + (size_t)i2 * 1024 * 4128, 1024, 4128, (bf16_t*)(p.ws + WS_WIN), 0, buf, vb, nb);
      cvt_matrix(p.in[28] + (size_t)i2 * 1024 * 1024, 1024, 1024, (bf16_t*)(p.ws + WS_WOUT), 0, buf, vb, nb);
      u32x4* z = (u32x4*)((bf16_t*)(p.ws + WS_WIN) + (size_t)4128 * 1024);
      for (int e = vb * 512 + tid; e < 224 * 1024 / 8; e += nb * 512) z[e] = (u32x4){0u, 0u, 0u, 0u};
    }
  }
  if (what & 2) cvt_matrix(p.in[29] + (size_t)l * 1024 * 5632, 1024, 5632, (bf16_t*)(p.ws + WS_WGU), 1, buf, vb, nb);
  if (what & 4) cvt_matrix(p.in[30] + (size_t)l * DFF * 1024, DFF, 1024, (bf16_t*)(p.ws + WS_WDN), 0, buf, vb, nb);
}

DI void norm_core(const Params& p, int l, int mode, bool first, int row_lo, int row_hi, int vb, int nb) {
  const int tid = tid_opaque(), wid = tid >> 6, lane = tid & 63;
  const float* mod = (const float*)(p.ws + WS_MOD);
  bf16_t* h = (bf16_t*)(p.ws + WS_H);
  const float* gn = mode == 2 ? p.in[12] : (mode ? p.in[11] : p.in[10]) + l * 1024;
  f32x4 ggv[4];
#pragma unroll
  for (int i = 0; i < 4; ++i) ggv[i] = *(const f32x4*)(gn + lane * 4 + 256 * i);
  const int nchunk = (row_hi - row_lo + 5) / 6;
  for (int c = vb * 8 + wid; c < nchunk; c += nb * 8) {
    const int r0 = row_lo + 6 * c;
    f32x4 v[6][4]; float ss[6];
#pragma unroll
    for (int q = 0; q < 6; ++q) {
      const int row = r0 + q < row_hi ? r0 + q : r0;
      const float* xs = first ? (row < M_P ? p.in[0] + (size_t)row * 1024 : p.in[1] + (size_t)(row - M_P) * 1024) : p.out + (size_t)row * 1024;
#pragma unroll
      for (int i = 0; i < 4; ++i) v[q][i] = *(const f32x4*)(xs + lane * 4 + 256 * i);
    }
    int gcur = row_group(r0);
    f32x4 shv[4], scv[4];
    if (mode != 2) {
      const float* md = mod + ((size_t)l * 9 + gcur) * 6144 + (mode ? 3072 : 0);
#pragma unroll
      for (int i = 0; i < 4; ++i) { shv[i] = *(const f32x4*)(md + lane * 4 + 256 * i); scv[i] = *(const f32x4*)(md + 1024 + lane * 4 + 256 * i); }
    }
#pragma unroll
    for (int q = 0; q < 6; ++q) {
      float s = 0.f;
#pragma unroll
      for (int i = 0; i < 4; ++i) s += v[q][i][0] * v[q][i][0] + v[q][i][1] * v[q][i][1] + v[q][i][2] * v[q][i][2] + v[q][i][3] * v[q][i][3];
      ss[q] = wave_sum(s);
    }
#pragma unroll
    for (int q = 0; q < 6; ++q) {
      const int row = r0 + q;
      if (row < row_hi) {
        if (mode != 2 && row_group(row) != gcur) {
          gcur = row_group(row);
          const float* md = mod + ((size_t)l * 9 + gcur) * 6144 + (mode ? 3072 : 0);
#pragma unroll
          for (int i = 0; i < 4; ++i) { shv[i] = *(const f32x4*)(md + lane * 4 + 256 * i); scv[i] = *(const f32x4*)(md + 1024 + lane * 4 + 256 * i); }
        }
        const float rstd = rsqrtf(ss[q] * (1.f / 1024.f) + 1e-6f);
#pragma unroll
        for (int i = 0; i < 4; ++i) {
          const int cc = lane * 4 + 256 * i;
          f32x4 y;
          if (mode == 2) {
#pragma unroll
            for (int j = 0; j < 4; ++j) y[j] = v[q][i][j] * rstd * ggv[i][j];
            *(f32x4*)(p.out + (size_t)row * 1024 + cc) = y;
          } else {
#pragma unroll
            for (int j = 0; j < 4; ++j) y[j] = v[q][i][j] * rstd * ggv[i][j] * (1.f + scv[i][j]) + shv[i][j];
            *(u32x2*)(h + (size_t)row * 1024 + cc) = (u32x2){pack2(y[0], y[1]), pack2(y[2], y[3])};
          }
        }
      }
    }
    if (first) {
#pragma unroll
      for (int q = 0; q < 6; ++q) {
        const int row = r0 + q;
        if (row < row_hi) {
#pragma unroll
          for (int i = 0; i < 4; ++i) *(f32x4*)(p.out + (size_t)row * 1024 + lane * 4 + 256 * i) = v[q][i];
        }
      }
    }
  }
}

DI void phase_norm(const Params& p, lptr lds, int l, int which) {
  const int tid = tid_opaque(), wid = tid >> 6, lane = tid & 63;
  const int i2 = l >> 1;
  if (which == 0) { if (l == 0) cvt_layer(p, lds, 0, 7, bid_opaque(), gridDim.x); else cvt_layer(p, lds, l, gridDim.x == 256 ? 4 : 7, bid_opaque(), gridDim.x); }
  norm_core(p, l, which, l == 0 && which == 0, 0, M_TOT, bid_opaque(), gridDim.x);
}

DI void phase_final(const Params& p) {
  const int tid = tid_opaque(), wid = tid >> 6, lane = tid & 63;
  const float* gn = p.in[12];
  const int rstride = gridDim.x * 8;
  for (int row0 = bid_opaque() * 8 + wid; row0 < M_TOT; row0 += 3 * rstride) {
    f32x4 v[3][4]; float ss[3];
#pragma unroll
    for (int q = 0; q < 3; ++q) {
      const int row = row0 + q * rstride < M_TOT ? row0 + q * rstride : row0;
      const float* xs = p.out + (size_t)row * 1024;
#pragma unroll
      for (int i = 0; i < 4; ++i) v[q][i] = *(const f32x4*)(xs + lane * 4 + 256 * i);
    }
#pragma unroll
    for (int q = 0; q < 3; ++q) {
      float s = 0.f;
#pragma unroll
      for (int i = 0; i < 4; ++i) s += v[q][i][0] * v[q][i][0] + v[q][i][1] * v[q][i][1] + v[q][i][2] * v[q][i][2] + v[q][i][3] * v[q][i][3];
      ss[q] = wave_sum(s);
    }
#pragma unroll
    for (int q = 0; q < 3; ++q) {
      const int row = row0 + q * rstride;
      if (row < M_TOT) {
        const float rstd = rsqrtf(ss[q] * (1.f / 1024.f) + 1e-6f);
#pragma unroll
        for (int i = 0; i < 4; ++i) {
          const int c = lane * 4 + 256 * i;
          const f32x4 gg = *(const f32x4*)(gn + c);
          f32x4 y;
#pragma unroll
          for (int j = 0; j < 4; ++j) y[j] = v[q][i][j] * rstd * gg[j];
          *(f32x4*)(p.out + (size_t)row * 1024 + c) = y;
        }
      }
    }
  }
}

namespace pg8 {
constexpr int BM = 256, BK = 64, HALF = 128, HTB = HALF * BK * 2, STAGE_BYTES = 8 * HTB, NXCD = 8, WGM = 8;
DI int lds_byte(int r, int c) { const int st = (r >> 4) * 2 + (c >> 5), rr = r & 15, cc = c & 31, ob = rr * 64 + cc * 2; return st * 1024 + (ob ^ (((ob >> 9) & 1) << 5)); }
DI void stage_rc(int b, int& R, int& C) { const int st = b / 1024, sb = b % 1024, swz = sb ^ (((sb >> 9) & 1) << 5); R = (st >> 1) * 16 + swz / 64; C = (st & 1) * 32 + (swz % 64) / 2; }
DI int perm32(int rho) { const int n = rho >> 4, i = rho & 15; return 8 * (i >> 2) + 4 * n + (i & 3); }
struct Unit { int pm, pn; };
struct Gemm { const bf16_t* A; const bf16_t* Bt; int M, N, K; };
struct StaticOrder {
  int nM, nN, nwg, G, c;
  DI void init(int M, int N, int G_, int c_) { nM = M / BM; nN = N / BM; nwg = nM * nN; G = G_; c = c_; }
  DI bool next(int i, Unit& u) const {
    const long L = (long)i * G + c; if (L >= nwg) return false;
    int wgid = (int)L; { const int q = nwg / NXCD, r = nwg % NXCD, xcd = wgid % NXCD, off = wgid / NXCD; wgid = (xcd < r ? xcd * (q + 1) : r * (q + 1) + (xcd - r) * q) + off; }
    const int nig = WGM * nN, gid = wgid / nig, fm = gid * WGM, gsz = (nM - fm) < WGM ? (nM - fm) : WGM;
    u.pm = fm + ((wgid % nig) % gsz); u.pn = (wgid % nig) / gsz; return true;
  }
};
DI unsigned cvt_pk_bf16(float lo, float hi) { unsigned r; asm volatile("v_cvt_pk_bf16_f32 %0, %1, %2" : "=v"(r) : "v"(lo), "v"(hi)); return r; }

template <class Epi>
DI void gemm_phase(lptr lds, const Gemm g, const StaticOrder& S, const Epi& E) {
  const int tid = tid_opaque(), wid = __builtin_amdgcn_readfirstlane(tid >> 6), lane = tid & 63, wr = wid >> 2, wc = wid & 3, fr = lane & 15, fq = lane >> 4;
  const int K = g.K, nt = K / BK;
  unsigned voffA[2], voffB[2];
#pragma unroll
  for (int i = 0; i < 2; ++i) { int R, C; stage_rc(tid * 16 + i * 8192, R, C); const int Rb = Epi::PERM ? ((R & ~31) + perm32(R & 31)) : R;
    voffA[i] = (unsigned)(R * K + C) * 2u; voffB[i] = (unsigned)(Rb * K + C) * 2u; }
  const size_t kstep = (size_t)(BK * 2);
  const size_t hstep = (size_t)HALF * K * 2;
  const size_t tstep = 2 * hstep;
  const unsigned ldsw = (unsigned)wid * 1024u;
  const int aoff = lds_byte(wr * 64 + fr, fq * 8), boff = lds_byte(wc * 32 + fr, fq * 8);
#define PG8_SA(b, h) (((b) * 2 + (h)) * HTB)
#define PG8_SB(b, h) ((4 + (b) * 2 + (h)) * HTB)
#define PG8_STAGE(bufoff, gbase, voff) do { _Pragma("unroll") for (int _i = 0; _i < 2; ++_i) \
    __builtin_amdgcn_global_load_lds((const unsigned*)((const char*)(gbase) + (voff)[_i]), (LAS unsigned*)(lds + (bufoff) + ldsw + _i * 8192), 16, 0, 0); } while (0)
#define PG8_LDA(dst, b, h) do { _Pragma("unroll") for (int m = 0; m < 4; ++m) _Pragma("unroll") for (int k = 0; k < 2; ++k) dst[m][k] = *(const LAS bf16x8*)(lds + PG8_SA(b, h) + aoff + m * 2048 + k * 1024); } while (0)
#define PG8_LDB(dst, b, h) do { _Pragma("unroll") for (int n = 0; n < 2; ++n) _Pragma("unroll") for (int k = 0; k < 2; ++k) dst[n][k] = *(const LAS bf16x8*)(lds + PG8_SB(b, h) + boff + n * 2048 + k * 1024); } while (0)
#define PG8_MMA(ai, bj, At, Bt) do { __builtin_amdgcn_s_setprio(1); _Pragma("unroll") for (int m = 0; m < 4; ++m) _Pragma("unroll") for (int n = 0; n < 2; ++n) _Pragma("unroll") for (int k = 0; k < 2; ++k) \
    acc[ai][bj][m][n] = __builtin_amdgcn_mfma_f32_16x16x32_bf16(Bt[n][k], At[m][k], acc[ai][bj][m][n], 0, 0, 0); __builtin_amdgcn_s_setprio(0); } while (0)
#define PG8_WAIT_V(n) asm volatile("s_waitcnt vmcnt(" #n ")" ::: "memory")
#define PG8_WAIT_L(n) asm volatile("s_waitcnt lgkmcnt(" #n ")" ::: "memory")
#define PG8_BAR __builtin_amdgcn_s_barrier()
#define PG8_SCHED __builtin_amdgcn_sched_barrier(0)
  Unit cur, nxt; int ui = 0;
  if (!S.next(0, cur)) return;
  f32x4 acc[2][2][4][2];
#pragma unroll
  for (int a = 0; a < 2; ++a)
#pragma unroll
    for (int b = 0; b < 2; ++b)
#pragma unroll
      for (int m = 0; m < 4; ++m)
#pragma unroll
        for (int n = 0; n < 2; ++n) acc[a][b][m][n] = (f32x4){0.f, 0.f, 0.f, 0.f};
  bf16x8 At[4][2], B0[2][2], B1[2][2];
  const char* cA = (const char*)g.A + (size_t)cur.pm * tstep; const char* cB = (const char*)g.Bt + (size_t)cur.pn * tstep;
  PG8_STAGE(PG8_SB(0, 0), cB, voffB); PG8_STAGE(PG8_SA(0, 0), cA, voffA); PG8_STAGE(PG8_SB(0, 1), cB + hstep, voffB); PG8_STAGE(PG8_SA(0, 1), cA + hstep, voffA);
  if (wr == 1) PG8_BAR;
  PG8_WAIT_V(4); PG8_BAR;
  PG8_STAGE(PG8_SB(1, 0), cB + kstep, voffB); PG8_STAGE(PG8_SA(1, 0), cA + kstep, voffA); PG8_STAGE(PG8_SB(1, 1), cB + hstep + kstep, voffB);
  PG8_WAIT_V(6); PG8_BAR;
  for (;;) {
    const bool has_next = S.next(ui + 1, nxt);
    const char* nA = has_next ? (const char*)g.A + (size_t)nxt.pm * tstep : cA; const char* nB = has_next ? (const char*)g.Bt + (size_t)nxt.pn * tstep : cB;
    for (int t = 0; t < nt; t += 2) {
      const bool last = (t == nt - 2);
      const char* a1 = cA + (size_t)(t + 1) * kstep;
      const char* a2 = last ? nA : cA + (size_t)(t + 2) * kstep; const char* b2 = last ? nB : cB + (size_t)(t + 2) * kstep;
      const char* a3 = a2 + kstep; const char* b3 = b2 + kstep;
      PG8_LDB(B0, 0, 0); PG8_SCHED; PG8_LDA(At, 0, 0); PG8_STAGE(PG8_SA(1, 1), a1 + hstep, voffA);
      PG8_WAIT_L(8); PG8_BAR; PG8_WAIT_L(0); PG8_MMA(0, 0, At, B0); PG8_BAR; PG8_SCHED;
      PG8_LDB(B1, 0, 1); PG8_STAGE(PG8_SB(0, 0), b2, voffB);
      PG8_BAR; PG8_WAIT_L(0); PG8_MMA(0, 1, At, B1); PG8_BAR;
      PG8_LDA(At, 0, 1); PG8_STAGE(PG8_SA(0, 0), a2, voffA);
      PG8_BAR; PG8_WAIT_L(0); PG8_MMA(1, 0, At, B0); PG8_BAR; PG8_SCHED;
      PG8_STAGE(PG8_SB(0, 1), b2 + hstep, voffB);
      PG8_WAIT_V(6); PG8_BAR; PG8_MMA(1, 1, At, B1); PG8_BAR;
      PG8_LDB(B0, 1, 0); PG8_SCHED; PG8_LDA(At, 1, 0); PG8_STAGE(PG8_SA(0, 1), a2 + hstep, voffA);
      PG8_WAIT_L(8); PG8_BAR; PG8_WAIT_L(0); PG8_MMA(0, 0, At, B0); PG8_BAR; PG8_SCHED;
      PG8_LDB(B1, 1, 1); PG8_STAGE(PG8_SB(1, 0), b3, voffB);
      PG8_BAR; PG8_WAIT_L(0); PG8_MMA(0, 1, At, B1); PG8_BAR;
      PG8_LDA(At, 1, 1); PG8_STAGE(PG8_SA(1, 0), a3, voffA);
      PG8_BAR; PG8_WAIT_L(0); PG8_MMA(1, 0, At, B0); PG8_BAR; PG8_SCHED;
      PG8_STAGE(PG8_SB(1, 1), b3 + hstep, voffB);
      PG8_WAIT_V(6); PG8_BAR; PG8_MMA(1, 1, At, B1); PG8_BAR;
    }
    E(acc, cur, wr, wc, fr, fq);
    if (!has_next) break;
#pragma unroll
    for (int a = 0; a < 2; ++a)
#pragma unroll
      for (int b = 0; b < 2; ++b)
#pragma unroll
        for (int m = 0; m < 4; ++m)
#pragma unroll
          for (int n = 0; n < 2; ++n) acc[a][b][m][n] = (f32x4){0.f, 0.f, 0.f, 0.f};
    cur = nxt; cA = nA; cB = nB; ++ui;
  }
  PG8_WAIT_V(0);
  if (wr == 0) PG8_BAR;
  PG8_BAR;
#undef PG8_SA
#undef PG8_SB
#undef PG8_STAGE
#undef PG8_LDA
#undef PG8_LDB
#undef PG8_MMA
#undef PG8_WAIT_V
#undef PG8_WAIT_L
#undef PG8_BAR
#undef PG8_SCHED
}

struct EpiIn {
  static constexpr bool PERM = true;
  bf16_t* P; int ldp; int odd; float* kout; float* vout; float* ab; bf16_t* halo;
  DI void operator()(const f32x4 (&acc)[2][2][4][2], const Unit& u, int wr, int wc, int fr, int fq) const {
    const int row0 = u.pm * BM + wr * 64 + fr;
    if (odd && u.pn == 16) {
      if (wc == 0) {
#pragma unroll
        for (int ai = 0; ai < 2; ++ai)
#pragma unroll
          for (int m = 0; m < 4; ++m) { const int r = row0 + ai * HALF + m * 16;
#pragma unroll
            for (int n = 0; n < 2; ++n) *(f32x4*)(ab + (size_t)r * 32 + 8 * fq + 4 * n) = acc[ai][0][m][n]; }
      }
      return;
    }
    const int col0 = u.pn * BM + wc * 32 + 8 * fq;
#pragma unroll
    for (int ai = 0; ai < 2; ++ai)
#pragma unroll
      for (int m = 0; m < 4; ++m) {
        const int r = row0 + ai * HALF + m * 16; bf16_t* rowp = P + (size_t)r * ldp + col0;
#pragma unroll
        for (int bj = 0; bj < 2; ++bj) {
          const f32x4 v0 = acc[ai][bj][m][0], v1 = acc[ai][bj][m][1];
          u32x4 w; w.x = cvt_pk_bf16(v0[0], v0[1]); w.y = cvt_pk_bf16(v0[2], v0[3]); w.z = cvt_pk_bf16(v1[0], v1[1]); w.w = cvt_pk_bf16(v1[2], v1[3]);
          *(u32x4*)(rowp + bj * HALF) = w;
          if (odd) {
            const int rc = m * 16 + fr, c = col0 + bj * HALF;
            if (c < 3072 && (rc == 0 || rc >= 62)) { const int slot = rc == 0 ? 0 : rc - 61; *(u32x4*)(halo + ((size_t)(r >> 6) * 3 + slot) * 3072 + c) = w; }
          } else if (u.pn == 6 && r < M_P) {
            float* dst = (bj ? vout : kout) + ((size_t)(r >> 8) * 512 + (r & 255)) * 128 + wc * 32 + 8 * fq;
            *(f32x4*)dst = v0; *(f32x4*)(dst + 4) = v1;
          }
        }
      }
  }
};
struct EpiRes {
  static constexpr bool PERM = false;
  float* x; const float* ga_base; int rbase;
  DI void operator()(const f32x4 (&acc)[2][2][4][2], const Unit& u, int wr, int wc, int fr, int fq) const {
    const int row0 = rbase + u.pm * BM + wr * 64 + fr, col0 = u.pn * BM + wc * 32 + 4 * fq;
    const float* ga = ga_base + (size_t)row_group(rbase + u.pm * BM) * 6144;
    f32x4 gv[2][2];
#pragma unroll
    for (int bj = 0; bj < 2; ++bj)
#pragma unroll
      for (int n = 0; n < 2; ++n) gv[bj][n] = *(const f32x4*)(ga + col0 + bj * HALF + n * 16);
#pragma unroll
    for (int ai = 0; ai < 2; ++ai) {
      f32x4 xv[4][2][2];
#pragma unroll
      for (int m = 0; m < 4; ++m) { const float* rowp = x + (size_t)(row0 + ai * HALF + m * 16) * 1024 + col0;
#pragma unroll
        for (int bj = 0; bj < 2; ++bj)
#pragma unroll
          for (int n = 0; n < 2; ++n) xv[m][bj][n] = *(const f32x4*)(rowp + bj * HALF + n * 16); }
#pragma unroll
      for (int m = 0; m < 4; ++m) { float* rowp = x + (size_t)(row0 + ai * HALF + m * 16) * 1024 + col0;
#pragma unroll
        for (int bj = 0; bj < 2; ++bj)
#pragma unroll
          for (int n = 0; n < 2; ++n) *(f32x4*)(rowp + bj * HALF + n * 16) = xv[m][bj][n] + gv[bj][n] * acc[ai][bj][m][n]; }
    }
  }
};
struct EpiGU {
  static constexpr bool PERM = true;
  bf16_t* act;
  DI void operator()(const f32x4 (&acc)[2][2][4][2], const Unit& u, int wr, int wc, int fr, int fq) const {
    const int row0 = u.pm * BM + wr * 64 + fr, col0 = u.pn * HALF + wc * 32 + 8 * fq;
#pragma unroll
    for (int ai = 0; ai < 2; ++ai)
#pragma unroll
      for (int m = 0; m < 4; ++m) {
        bf16_t* rowp = act + (size_t)(row0 + ai * HALF + m * 16) * DFF + col0;
        float o[8];
#pragma unroll
        for (int n = 0; n < 2; ++n)
#pragma unroll
          for (int j = 0; j < 4; ++j) { const float gt = acc[ai][0][m][n][j], up = acc[ai][1][m][n][j]; o[n * 4 + j] = siluf_(gt) * up; }
        u32x4 w; w.x = cvt_pk_bf16(o[0], o[1]); w.y = cvt_pk_bf16(o[2], o[3]); w.z = cvt_pk_bf16(o[4], o[5]); w.w = cvt_pk_bf16(o[6], o[7]);
        *(u32x4*)rowp = w;
      }
  }
};
}

template <class Epi> DI void run_gemm(lptr lds, const bf16_t* A, const bf16_t* Bt, int N, int K, const Epi& E) {
  pg8::Gemm g; g.A = A; g.Bt = Bt; g.M = M_TOT; g.N = N; g.K = K;
  pg8::StaticOrder S; S.init(M_TOT, N, (int)gridDim.x, (int)bid_opaque());
  pg8::gemm_phase<Epi>(lds, g, S, E);
}
template <class Epi> DI void run_gemm_sub(lptr lds, const bf16_t* A, const bf16_t* Bt, int mrows, int N, int K, const Epi& E, int vb, int nb) {
  pg8::Gemm g; g.A = A; g.Bt = Bt; g.M = mrows; g.N = N; g.K = K;
  pg8::StaticOrder S; S.init(mrows, N, nb, vb);
  pg8::gemm_phase<Epi>(lds, g, S, E);
}
DI void norm_rows(const Params& p, int l, int mode, int row_lo, int row_hi, int vb, int nb) { norm_core(p, l, mode, false, row_lo, row_hi, vb, nb); }

DI float gelu_tanh(float x) { const float u = 0.7978845608028654f * (x + 0.044715f * x * x * x); const float t = 1.f - 2.f * __builtin_amdgcn_rcpf(1.f + __expf(2.f * u)); return 0.5f * x * (1.f + t); }
DI void rg_phase(const Params& p, lptr lds, int l, int mode) {
  const int tid = tid_opaque(), wid = tid >> 6, lane = tid & 63;
  const int i2 = l >> 1, bid = bid_opaque(), G = gridDim.x;
  const int n = bid & 7;
  const bf16_t* P = (const bf16_t*)(p.ws + WS_P);
  bf16_t* Y = (bf16_t*)(p.ws + WS_H);
  float* carry = (float*)(p.ws + WS_CARRY);
  constexpr int SUB = 74752;
  LAS float* Pf = (LAS float*)(lds + 2 * SUB);
  const int ct = tid >> 3, c8 = (tid & 7) * 8, chc = n * 64 + c8;
  LAS float* cwl = (LAS float*)(lds + 2 * SUB + 8192);
  if (tid < 320) { const int j = tid >> 6, c = tid & 63; cwl[tid] = j < 4 ? p.in[14][((size_t)i2 * 4 + j) * 512 + n * 64 + c] : p.in[15][i2 * 512 + n * 64 + c]; }
  __syncthreads();
  const int gdir = wid >> 2, gdt = (wid >> 1) & 1, gt2 = wid & 1, r = lane & 31, hh = lane >> 5;
  bf16x8 wa[4], wx[4];
  {
    const bf16_t* rgw = (const bf16_t*)(p.ws + WS_RGW);
    const bf16_t* wap = rgw + ((size_t)(gdir * 2 + 0) * 8 + n) * 4096 + (gdt * 32 + r) * 64 + 8 * hh;
    const bf16_t* wxp = rgw + ((size_t)(gdir * 2 + 1) * 8 + n) * 4096 + (gdt * 32 + r) * 64 + 8 * hh;
#pragma unroll
    for (int s = 0; s < 4; ++s) { wa[s] = *(const bf16x8*)(wap + 16 * s); wx[s] = *(const bf16x8*)(wxp + 16 * s); }
  }
  const int gd = gdt * 32 + r, gpi = (i2 * 2 + gdir) * 512 + n * 64 + gd;
  const float ba = p.in[17][gpi], bx = p.in[19][gpi], sp8 = -8.f * softplusf_(-p.in[20][gpi]);
  u32x4 praw[2][4], pgr[2];
  pgr[0] = pgr[1] = (u32x4){0u, 0u, 0u, 0u};
#define RG_PREFETCH(s_, item_) do { const int tt_ = (item_) >> 3; const int row0_ = tt_ * 64; \
    const int ti_ = tt_ < 64 ? (tt_ & 3) : ((tt_ - 64) & 63); const int nt_ = tt_ < 64 ? 4 : 64; \
    _Pragma("unroll") for (int j_ = 0; j_ < 4; ++j_) { const int tl_ = ti_ * 64 + ct + j_ - 2; const bool ok_ = tl_ >= 0 && tl_ < nt_ * 64; \
      const u32x4 v_ = *(const u32x4*)(P + (size_t)(row0_ + (ok_ ? ct + j_ - 2 : ct)) * EVEN_IN + chc); praw[s_][j_] = ok_ ? v_ : (u32x4){0u, 0u, 0u, 0u}; } \
    if (mode == 1) pgr[s_] = *(const u32x4*)(P + (size_t)(row0_ + ct) * EVEN_IN + 512 + chc); } while (0)
  if (bid < 4608) RG_PREFETCH(0, bid);
  if (bid + G < 4608) RG_PREFETCH(1, bid + G);
  for (int item0 = bid; item0 < 4608; item0 += 2 * G) {
    const int nsub = item0 + G < 4608 ? 2 : 1;
    u32x4 gr_cur[2];
#pragma unroll
    for (int s = 0; s < 2; ++s) {
      if (s < nsub) {
        const int tt = (item0 + s * G) >> 3;
        const int ti = tt < 64 ? (tt & 3) : ((tt - 64) & 63), ntile = tt < 64 ? 4 : 64;
        LAS bf16_t* Xc = (LAS bf16_t*)(lds + s * SUB);
        float ca[16], cbv[16];
        if (mode == 1) {
          const int q4 = tid >> 7, dir = (tid >> 6) & 1, d = tid & 63, ch = n * 64 + d, tbase = tt - ti;
#pragma unroll
          for (int jj = 0; jj < 16; ++jj) {
            const int j = dir ? (16 * q4 + 15 - jj) : (16 * q4 + jj);
            const bool valid = dir ? (j > ti && j < ntile) : (j < ti);
            const int jc = valid ? j : ti;
            const size_t o = ((size_t)((tbase + jc) * 2 + dir) * 2) * 512 + ch;
            const float va = carry[o], vb = carry[o + 512];
            ca[jj] = valid ? va : 1.f; cbv[jj] = valid ? vb : 0.f;
          }
        }
        {
          const f32x4 b0 = *(const LAS f32x4*)(cwl + 256 + c8), b1 = *(const LAS f32x4*)(cwl + 256 + c8 + 4);
          float a[8] = {b0[0], b0[1], b0[2], b0[3], b1[0], b1[1], b1[2], b1[3]};
#pragma unroll
          for (int j = 0; j < 4; ++j) {
            const u32x4 raw = praw[s][j];
            const f32x4 w0 = *(const LAS f32x4*)(cwl + j * 64 + c8), w1 = *(const LAS f32x4*)(cwl + j * 64 + c8 + 4);
            a[0] += w0[0] * lo2f(raw.x); a[1] += w0[1] * hi2f(raw.x); a[2] += w0[2] * lo2f(raw.y); a[3] += w0[3] * hi2f(raw.y);
            a[4] += w1[0] * lo2f(raw.z); a[5] += w1[1] * hi2f(raw.z); a[6] += w1[2] * lo2f(raw.w); a[7] += w1[3] * hi2f(raw.w);
          }
          *(LAS u32x4*)(Xc + ct * 72 + c8) = (u32x4){pack2(a[0], a[1]), pack2(a[2], a[3]), pack2(a[4], a[5]), pack2(a[6], a[7])};
        }
        gr_cur[s] = pgr[s];
        if (mode == 1) {
          const int q4 = tid >> 7, dir = (tid >> 6) & 1, d = tid & 63;
          float A = 1.f, B = 0.f;
#pragma unroll
          for (int jj = 0; jj < 16; ++jj) { B = ca[jj] * B + cbv[jj]; A = ca[jj] * A; }
          Pf[s * 1024 + (q4 * 2 + dir) * 64 + d] = A; Pf[s * 1024 + 512 + (q4 * 2 + dir) * 64 + d] = B;
        }
      }
      __builtin_amdgcn_sched_barrier(0);
    }
    __syncthreads();
#pragma unroll 1
    for (int s = 0; s < 2; ++s) {
      if (s < nsub) {
        LAS bf16_t* Xc = (LAS bf16_t*)(lds + s * SUB);
        LAS float* Aa = (LAS float*)(lds + s * SUB + 9216); LAS float* Bb = (LAS float*)(lds + s * SUB + 41984);
        f32x16 ga = zero16(), gx = zero16();
#pragma unroll
        for (int ks = 0; ks < 4; ++ks) {
          const bf16x8 a = *(const LAS bf16x8*)(Xc + (gt2 * 32 + r) * 72 + 16 * ks + 8 * hh);
          ga = MFMA32(a, wa[ks], ga); gx = MFMA32(a, wx[ks], gx);
        }
        float xcv[16];
#pragma unroll
        for (int ii = 0; ii < 16; ++ii) xcv[ii] = bf2f(Xc[(gt2 * 32 + crow(ii, hh)) * 72 + gd]);
#pragma unroll
        for (int ii = 0; ii < 16; ++ii) {
          const int t = gt2 * 32 + crow(ii, hh);
          const float rr = sigmoidf_(ga[ii] + ba), iv = sigmoidf_(gx[ii] + bx);
          const float la = rr * sp8, a = __expf(la), x2 = 2.f * la;
          const float om = x2 > -0.25f ? -x2 * (1.f + x2 * (0.5f + x2 * (0.16666667f + x2 * (0.041666668f + x2 * 0.0083333338f)))) : 1.f - __expf(x2);
          const float bb = __builtin_amdgcn_sqrtf(fmaxf(om, 0.f)) * (iv * xcv[ii]);
          Aa[(gdir * 64 + t) * 64 + gd] = a; Bb[(gdir * 64 + t) * 64 + gd] = bb;
        }
      }
    }
    __syncthreads();
    if (item0 + 2 * G < 4608) RG_PREFETCH(0, item0 + 2 * G);
    if (item0 + 3 * G < 4608) RG_PREFETCH(1, item0 + 3 * G);
    if (tid < 128 * nsub) {
      const int s = tid >> 7, dir = (tid >> 6) & 1, d = tid & 63, ch = n * 64 + d;
      const int tt = (item0 + s * G) >> 3;
      const int ti = tt < 64 ? (tt & 3) : ((tt - 64) & 63), ntile = tt < 64 ? 4 : 64;
      const int seq = tt < 64 ? (tt >> 2) : 16 + ((tt - 64) >> 6);
      LAS float* Aa = (LAS float*)(lds + s * SUB + 9216); LAS float* Bb = (LAS float*)(lds + s * SUB + 41984);
      if (mode == 0) {
        float A = 1.f, B = 0.f;
#pragma unroll 1
        for (int s0 = 0; s0 < 64; s0 += 8) {
          float av[8], bv[8];
#pragma unroll
          for (int k = 0; k < 8; ++k) { const int t = dir ? 63 - (s0 + k) : s0 + k; av[k] = Aa[(dir * 64 + t) * 64 + d]; bv[k] = Bb[(dir * 64 + t) * 64 + d]; }
#pragma unroll
          for (int k = 0; k < 8; ++k) { A *= av[k]; B = av[k] * B + bv[k]; }
        }
        carry[((size_t)(tt * 2 + dir) * 2 + 0) * 512 + ch] = A; carry[((size_t)(tt * 2 + dir) * 2 + 1) * 512 + ch] = B;
      } else {
        float h = (tt < 64) ? 0.f : p.in[5][(((size_t)(seq - 16) * 2 + i2) * 2 + dir) * 512 + ch];
#pragma unroll
        for (int qq = 0; qq < 4; ++qq) { const int q4 = dir ? 3 - qq : qq; h = Pf[s * 1024 + (q4 * 2 + dir) * 64 + d] * h + Pf[s * 1024 + 512 + (q4 * 2 + dir) * 64 + d]; }
#pragma unroll 1
        for (int s0 = 0; s0 < 64; s0 += 8) {
          float av[8], bv[8];
#pragma unroll
          for (int k = 0; k < 8; ++k) { const int t = dir ? 63 - (s0 + k) : s0 + k; av[k] = Aa[(dir * 64 + t) * 64 + d]; bv[k] = Bb[(dir * 64 + t) * 64 + d]; }
#pragma unroll
          for (int k = 0; k < 8; ++k) { const int t = dir ? 63 - (s0 + k) : s0 + k; h = av[k] * h + bv[k]; Aa[(dir * 64 + t) * 64 + d] = h; }
        }
        if (tt < 64 && ((dir == 0 && ti == ntile - 1) || (dir == 1 && ti == 0))) p.out[OFF_RG + (((size_t)seq * 2 + i2) * 2 + dir) * 512 + ch] = h;
      }
    }
    if (mode == 1) {
      __syncthreads();
#pragma unroll
      for (int s = 0; s < 2; ++s) {
        if (s < nsub) {
          const int row0 = ((item0 + s * G) >> 3) * 64;
          const LAS float* Hf = (const LAS float*)(lds + s * SUB + 9216); const LAS float* Hb = Hf + 4096;
          const u32x4 raw = gr_cur[s];
          float gr[8] = {lo2f(raw.x), hi2f(raw.x), lo2f(raw.y), hi2f(raw.y), lo2f(raw.z), hi2f(raw.z), lo2f(raw.w), hi2f(raw.w)};
          float y[8];
#pragma unroll
          for (int e = 0; e < 8; ++e) y[e] = (Hf[ct * 64 + c8 + e] + Hb[ct * 64 + c8 + e]) * gelu_tanh(gr[e]);
          *(u32x4*)(Y + (size_t)(row0 + ct) * 1024 + n * 64 + c8) = (u32x4){pack2(y[0], y[1]), pack2(y[2], y[3]), pack2(y[4], y[5]), pack2(y[6], y[7])};
        }
      }
    }
    __syncthreads();
  }
#undef RG_PREFETCH
}

DI void att_item(const Params& p, lptr lds, int l, int item) {
  const int tid = tid_opaque(), wid = tid >> 6, lane = tid & 63, q = lane & 31, hh = lane >> 5;
  const int i2 = l >> 1;
  const bool samp = item < 1024;
  int b, kvh, qt, rowbase;
  if (samp) { b = item >> 7; kvh = (item >> 6) & 1; qt = item & 63; rowbase = M_P + b * 4096; }
  else { const int j = item - 1024; b = j >> 3; kvh = (j >> 2) & 1; qt = j & 3; rowbase = b * 256; }
  const bf16_t* P = (const bf16_t*)(p.ws + WS_P);
  bf16_t* Y = (bf16_t*)(p.ws + WS_H);
  const float* rc = (const float*)(p.ws + WS_ROPE); const float* rs = rc + 4096 * 32;
  LAS bf16_t* Ks = (LAS bf16_t*)lds; LAS bf16_t* Vt = (LAS bf16_t*)(lds + 9216);
  const int head = kvh * 4 + (wid >> 1);
  const int qpos = qt * 64 + 32 * (wid & 1) + q;
  bf16x8 Qf[4];
  {
    const bf16_t* qp = P + (size_t)(rowbase + qpos) * EVEN_IN + 1024 + head * 64 + 8 * hh;
    float qv[4][8];
#pragma unroll
    for (int s = 0; s < 4; ++s) { const u32x4 raw = *(const u32x4*)(qp + 16 * s);
      qv[s][0] = lo2f(raw.x); qv[s][1] = hi2f(raw.x); qv[s][2] = lo2f(raw.y); qv[s][3] = hi2f(raw.y); qv[s][4] = lo2f(raw.z); qv[s][5] = hi2f(raw.z); qv[s][6] = lo2f(raw.w); qv[s][7] = hi2f(raw.w); }
    if (samp) {
#pragma unroll
      for (int pr = 0; pr < 2; ++pr)
#pragma unroll
        for (int j = 0; j < 8; ++j) { const int f = 16 * pr + 8 * hh + j; const float c = rc[qpos * 32 + f], sn = rs[qpos * 32 + f];
          const float x1 = qv[2 * pr][j], x2 = qv[2 * pr + 1][j]; qv[2 * pr][j] = x1 * c - x2 * sn; qv[2 * pr + 1][j] = x1 * sn + x2 * c; }
    }
#pragma unroll
    for (int s = 0; s < 4; ++s) { const float qs = 0.125f * 1.44269504088896341f;
      u32x4 w; w.x = pack2(qv[s][0] * qs, qv[s][1] * qs); w.y = pack2(qv[s][2] * qs, qv[s][3] * qs); w.z = pack2(qv[s][4] * qs, qv[s][5] * qs); w.w = pack2(qv[s][6] * qs, qv[s][7] * qs); Qf[s] = __builtin_bit_cast(bf16x8, w); }
  }
  float m_run = p.in[21][i2 * 8 + head] * 1.44269504088896341f, l_run = hh == 0 ? 1.f : 0.f;
  f32x16 o0 = zero16(), o1 = zero16();
  const int nctx = samp ? 8 : 0;
  int w0, w1; if (samp) { w0 = qt - 2 < 0 ? 0 : qt - 2; w1 = qt + 2 > 63 ? 63 : qt + 2; } else { w0 = 0; w1 = 3; }
  const int ntiles = nctx + (w1 - w0 + 1);
  const bool isK = tid < 256;
  const int skey = (tid & 255) >> 2, spc = tid & 3;
  const int sd0 = isK ? (spc & 1) * 8 + (spc >> 1) * 32 : spc * 16;
  const int so1 = isK ? 16 : 8;
  f32x4 pc4[4]; u32x4 pw2[2]; f32x4 prc[4];
#define ATT_PREFETCH(kt_) do { const bool ctx_ = (kt_) < nctx; const int wt_ = w0 + ((kt_) - nctx); \
    if (ctx_) { const float* sp_ = (isK ? p.in[3] : p.in[4]) + (((size_t)(b * 2 + i2) * 512 + (kt_) * 64 + skey) * 2 + kvh) * 64 + sd0; \
      pc4[0] = *(const f32x4*)sp_; pc4[1] = *(const f32x4*)(sp_ + 4); pc4[2] = *(const f32x4*)(sp_ + so1); pc4[3] = *(const f32x4*)(sp_ + so1 + 4); } \
    else { const bf16_t* sp_ = P + (size_t)(rowbase + wt_ * 64 + skey) * EVEN_IN + (isK ? 1536 : 1664) + kvh * 64 + sd0; \
      pw2[0] = *(const u32x4*)sp_; pw2[1] = *(const u32x4*)(sp_ + so1); \
      if (samp && isK) { const int kpos_ = wt_ * 64 + skey, fb_ = (sd0 & 8) + (sd0 >= 32 ? 16 : 0); \
        prc[0] = *(const f32x4*)(rc + kpos_ * 32 + fb_); prc[1] = *(const f32x4*)(rc + kpos_ * 32 + fb_ + 4); \
        prc[2] = *(const f32x4*)(rs + kpos_ * 32 + fb_); prc[3] = *(const f32x4*)(rs + kpos_ * 32 + fb_ + 4); } } } while (0)
  ATT_PREFETCH(0);
  for (int kt = 0; kt < ntiles; ++kt) {
    const bool ctx = kt < nctx; const int wt = w0 + (kt - nctx);
    __syncthreads();
    {
      float x1[8], x2[8];
      if (ctx) {
#pragma unroll
        for (int e = 0; e < 4; ++e) { x1[e] = pc4[0][e]; x1[4 + e] = pc4[1][e]; x2[e] = pc4[2][e]; x2[4 + e] = pc4[3][e]; }
      } else {
        const u32x4 r1 = pw2[0], r2 = pw2[1];
        x1[0] = lo2f(r1.x); x1[1] = hi2f(r1.x); x1[2] = lo2f(r1.y); x1[3] = hi2f(r1.y); x1[4] = lo2f(r1.z); x1[5] = hi2f(r1.z); x1[6] = lo2f(r1.w); x1[7] = hi2f(r1.w);
        x2[0] = lo2f(r2.x); x2[1] = hi2f(r2.x); x2[2] = lo2f(r2.y); x2[3] = hi2f(r2.y); x2[4] = lo2f(r2.z); x2[5] = hi2f(r2.z); x2[6] = lo2f(r2.w); x2[7] = hi2f(r2.w);
        if (samp && isK) {
#pragma unroll
          for (int j = 0; j < 8; ++j) { const float c = prc[j >> 2][j & 3], sn = prc[2 + (j >> 2)][j & 3]; const float a = x1[j], bb = x2[j]; x1[j] = a * c - bb * sn; x2[j] = a * sn + bb * c; }
        }
      }
      if (isK) {
        *(LAS u32x4*)(Ks + skey * 72 + sd0) = (u32x4){pack2(x1[0], x1[1]), pack2(x1[2], x1[3]), pack2(x1[4], x1[5]), pack2(x1[6], x1[7])};
        *(LAS u32x4*)(Ks + skey * 72 + sd0 + 16) = (u32x4){pack2(x2[0], x2[1]), pack2(x2[2], x2[3]), pack2(x2[4], x2[5]), pack2(x2[6], x2[7])};
      } else {
#pragma unroll
        for (int e = 0; e < 8; ++e) { Vt[(sd0 + e) * 72 + skey] = f2bf(x1[e]); Vt[(sd0 + 8 + e) * 72 + skey] = f2bf(x2[e]); }
      }
    }
    __syncthreads();
    if (kt + 1 < ntiles) ATT_PREFETCH(kt + 1);
#pragma unroll
    for (int ks = 0; ks < 2; ++ks) {
      f32x16 sacc = zero16();
#pragma unroll
      for (int s = 0; s < 4; ++s) { const bf16x8 a = *(const LAS bf16x8*)(Ks + (32 * ks + q) * 72 + 16 * s + 8 * hh); sacc = MFMA32(a, Qf[s], sacc); }
      if (!ctx && samp) {
        const int kbase = wt * 64 + 32 * ks;
#pragma unroll
        for (int ii = 0; ii < 16; ++ii) { const int dl = qpos - (kbase + crow(ii, hh)); if (dl > 128 || dl < -128) sacc[ii] = -1e30f; }
      }
      float mx = sacc[0];
#pragma unroll
      for (int ii = 1; ii < 16; ++ii) mx = fmaxf(mx, sacc[ii]);
      mx = fmaxf(mx, __shfl_xor(mx, 32));
      if (__any(mx > m_run)) {
        const float m_new = fmaxf(m_run, mx), alpha = __builtin_amdgcn_exp2f(m_run - m_new); m_run = m_new;
        l_run *= alpha;
#pragma unroll
        for (int ii = 0; ii < 16; ++ii) { o0[ii] *= alpha; o1[ii] *= alpha; }
      }
      float pv[16], ps = 0.f;
#pragma unroll
      for (int ii = 0; ii < 16; ++ii) { pv[ii] = __builtin_amdgcn_exp2f(sacc[ii] - m_run); ps += pv[ii]; }
      l_run += ps;
#pragma unroll
      for (int s2 = 0; s2 < 2; ++s2) {
        u32x4 pw; pw.x = pack2(pv[8 * s2], pv[8 * s2 + 1]); pw.y = pack2(pv[8 * s2 + 2], pv[8 * s2 + 3]); pw.z = pack2(pv[8 * s2 + 4], pv[8 * s2 + 5]); pw.w = pack2(pv[8 * s2 + 6], pv[8 * s2 + 7]);
        const bf16x8 bfrag = __builtin_bit_cast(bf16x8, pw);
        {
          const LAS bf16_t* vp = Vt + q * 72 + 32 * ks + 16 * s2 + 4 * hh;
          const u32x2 lo = *(const LAS u32x2*)vp, hi = *(const LAS u32x2*)(vp + 8);
          o0 = MFMA32(__builtin_bit_cast(bf16x8, ((u32x4){lo.x, lo.y, hi.x, hi.y})), bfrag, o0);
        }
        {
          const LAS bf16_t* vp = Vt + (32 + q) * 72 + 32 * ks + 16 * s2 + 4 * hh;
          const u32x2 lo = *(const LAS u32x2*)vp, hi = *(const LAS u32x2*)(vp + 8);
          o1 = MFMA32(__builtin_bit_cast(bf16x8, ((u32x4){lo.x, lo.y, hi.x, hi.y})), bfrag, o1);
        }
      }
    }
  }
#undef ATT_PREFETCH
  const float inv = 1.f / (l_run + __shfl_xor(l_run, 32));
  bf16_t* yp = Y + (size_t)(rowbase + qpos) * 1024 + 512 + head * 64;
#pragma unroll
  for (int g = 0; g < 4; ++g) {
    *(u32x2*)(yp + 8 * g + 4 * hh) = (u32x2){pack2(o0[4 * g] * inv, o0[4 * g + 1] * inv), pack2(o0[4 * g + 2] * inv, o0[4 * g + 3] * inv)};
    *(u32x2*)(yp + 32 + 8 * g + 4 * hh) = (u32x2){pack2(o1[4 * g] * inv, o1[4 * g + 1] * inv), pack2(o1[4 * g + 2] * inv, o1[4 * g + 3] * inv)};
  }
  __syncthreads();
}

DI float wave_incl_scan(float v, int lane) {
#pragma unroll
  for (int o = 1; o < 64; o <<= 1) { const float t = __shfl_up(v, o); if (lane >= o) v += t; }
  return v;
}
DI void dn1_phase(const Params& p, lptr lds, int l) {
  const int tid = tid_opaque(), wid = tid >> 6, lane = tid & 63;
  const int i2 = l >> 1, bid = bid_opaque(), G = gridDim.x, hd = bid & 7;
  bf16_t* P = (bf16_t*)(p.ws + WS_P);
  const bf16_t* halo = (const bf16_t*)(p.ws + WS_HALO);
  const float* ab = (const float*)(p.ws + WS_AB);
  LAS bf16_t* Raw = (LAS bf16_t*)lds;
  LAS float* X = (LAS float*)lds;
  LAS bf16_t* Kn = (LAS bf16_t*)(lds + 51456);
  LAS float* KK = (LAS float*)(lds + 68864);
  LAS float* Lm = (LAS float*)(lds + 85248);
  LAS float* gcs = (LAS float*)(lds + 118016);
  LAS float* bts = (LAS float*)(lds + 118528);
  const float alog0 = -__expf(p.in[25][(i2 * 2 + (wid & 1)) * 8 + hd]), dtb0 = p.in[26][(i2 * 2 + (wid & 1)) * 8 + hd];
  LAS float* cwl = (LAS float*)(lds + 131072);
  for (int e = tid; e < 1536; e += 512) { const int part = e >> 9, j = (e >> 7) & 3, c = e & 127; cwl[e] = p.in[24][((size_t)i2 * 4 + j) * 3072 + part * 1024 + hd * 128 + c]; }
  __syncthreads();
  u32x4 rv[7]; float pa0 = 0.f, pa1 = 0.f;
#define DN1_PREFETCH(item_) do { const int ck_ = (item_) >> 3; const int row0_ = ck_ * 64; \
    const int ci_ = ck_ < 64 ? (ck_ & 3) : ((ck_ - 64) & 63); const int nch_ = ck_ < 64 ? 4 : 64; \
    _Pragma("unroll") for (int k_ = 0; k_ < 7; ++k_) { \
      int e_ = tid + 512 * k_; if (e_ > 3215) e_ = 3215; \
      const int part_ = e_ / 1072, rem_ = e_ % 1072, rr_ = rem_ >> 4, pc_ = rem_ & 15, col_ = part_ * 1024 + hd * 128 + pc_ * 8; \
      const bool mid_ = rr_ >= 2 && rr_ < 66; \
      const bool zero_ = (rr_ < 2 && ci_ == 0) || (rr_ >= 66 && ci_ == nch_ - 1); \
      const bf16_t* srcp_ = mid_ ? P + (size_t)(row0_ + rr_ - 2) * ODD_LD + col_ \
                               : (rr_ < 2 ? halo + ((size_t)(ck_ - 1) * 3 + 1 + rr_) * 3072 + col_ : halo + ((size_t)(ck_ + 1) * 3) * 3072 + col_); \
      if (zero_) srcp_ = P + (size_t)row0_ * ODD_LD + col_; \
      u32x4 v_ = *(const u32x4*)srcp_; \
      if (zero_) v_ = (u32x4){0u, 0u, 0u, 0u}; \
      rv[k_] = v_; } \
    if (wid < 2) { const int t_ = wid ? 63 - lane : lane; pa0 = ab[(size_t)(row0_ + t_) * 32 + wid * 8 + hd]; pa1 = ab[(size_t)(row0_ + t_) * 32 + 16 + wid * 8 + hd]; } } while (0)
  if (bid < 4608) DN1_PREFETCH(bid);
  for (int item = bid; item < 4608; item += G) {
  const int ck = item >> 3;
  const int row0 = ck * 64;
  {
#pragma unroll
    for (int k = 0; k < 7; ++k) {
      int e = tid + 512 * k; if (e > 3215) e = 3215;
      const int part = e / 1072, rem = e % 1072, rr = rem >> 4, pc = rem & 15;
      *(LAS u32x4*)(Raw + (part * 67 + rr) * 128 + pc * 8) = rv[k];
    }
  }
  const float a0 = pa0, a1 = pa1;
  __syncthreads();
  if (item + G < 4608) DN1_PREFETCH(item + G);
#pragma unroll 2
  for (int tk = 0; tk < 6; ++tk) {
    const int task = tid + 512 * tk;
    const int c8i = task & 15, rp = task >> 4, part = tk >> 1, t = rp & 63, col = part * 1024 + hd * 128 + c8i * 8;
    float y[8];
#pragma unroll
    for (int e = 0; e < 8; ++e) y[e] = 0.f;
#pragma unroll
    for (int j = 0; j < 4; ++j) {
      const u32x4 raw = *(const LAS u32x4*)(Raw + (part * 67 + t + j) * 128 + c8i * 8);
      const f32x4 cw0 = *(const LAS f32x4*)(cwl + (part * 4 + j) * 128 + c8i * 8), cw1 = *(const LAS f32x4*)(cwl + (part * 4 + j) * 128 + c8i * 8 + 4);
      y[0] += cw0[0] * lo2f(raw.x); y[1] += cw0[1] * hi2f(raw.x); y[2] += cw0[2] * lo2f(raw.y); y[3] += cw0[3] * hi2f(raw.y);
      y[4] += cw1[0] * lo2f(raw.z); y[5] += cw1[1] * hi2f(raw.z); y[6] += cw1[2] * lo2f(raw.w); y[7] += cw1[3] * hi2f(raw.w);
    }
    float ss = 0.f;
#pragma unroll
    for (int e = 0; e < 8; ++e) { y[e] = siluf_(y[e]); ss += y[e] * y[e]; }
    if (part < 2) {
      ss += __shfl_xor(ss, 1); ss += __shfl_xor(ss, 2); ss += __shfl_xor(ss, 4); ss += __shfl_xor(ss, 8);
      const float sc = rsqrtf(ss + 1e-6f) * (part == 0 ? 0.08838834764831845f : 1.f);
#pragma unroll
      for (int e = 0; e < 8; ++e) y[e] *= sc;
    }
    const u32x4 w = (u32x4){pack2(y[0], y[1]), pack2(y[2], y[3]), pack2(y[4], y[5]), pack2(y[6], y[7])};
    *(u32x4*)(P + (size_t)(row0 + t) * ODD_LD + col) = w;
    if (part == 1) *(LAS u32x4*)(Kn + t * 136 + c8i * 8) = w;
  }
  if (wid < 2) {
    const int dir = wid;
    const float g = alog0 * softplusf_(a0 + dtb0);
    const float gcv = wave_incl_scan(g, lane), btv = sigmoidf_(a1);
    gcs[dir * 64 + lane] = gcv; bts[dir * 64 + lane] = btv;
    float* gcb = (float*)(p.ws + WS_CARRY) + ((size_t)(ck * 8 + hd) * 2 + dir) * 128;
    gcb[lane] = gcv; gcb[64 + lane] = btv;
  }
  __syncthreads();
  if (wid < 4) {
    const int it = wid >> 1, jt = wid & 1, hh = lane >> 5;
    const f32x16 acc = mm32(Kn + it * 32 * 136, 136, Kn + jt * 32 * 136, 136, 128, zero16(), lane);
#pragma unroll
    for (int ii = 0; ii < 16; ++ii) KK[(it * 32 + crow(ii, hh)) * 64 + jt * 32 + (lane & 31)] = acc[ii];
  }
  __syncthreads();
  for (int e0 = tid; e0 < 8192; e0 += 2048) {
    float wv[4];
#pragma unroll
    for (int k = 0; k < 4; ++k) {
      const int e = e0 + 512 * k, dir = e >> 12, ip = (e >> 6) & 63, jp = e & 63;
      const int ti = dir ? 63 - ip : ip, tj = dir ? 63 - jp : jp;
      const float w = bts[dir * 64 + ip] * KK[ti * 64 + tj] * __expf(fminf(gcs[dir * 64 + ip] - gcs[dir * 64 + jp], 0.f));
      wv[k] = (ip > jp) ? w : 0.f;
    }
#pragma unroll
    for (int k = 0; k < 4; ++k) Lm[e0 + 512 * k] = wv[k];
  }
  __syncthreads();
  for (int e = tid; e < 8192; e += 512) X[e] = 0.f;
  __syncthreads();
  {
    const int d = wid >> 2, bi = wid & 3;
    if (lane < 16) {
      const int c = lane; float x[16];
      const LAS float* L = Lm + d * 4096 + (16 * bi) * 64 + 16 * bi;
#pragma unroll
      for (int i = 0; i < 16; ++i) {
        float s = (c == i) ? 1.f : 0.f;
#pragma unroll
        for (int j = 0; j < i; ++j) s -= L[i * 64 + j] * x[j];
        x[i] = s;
      }
#pragma unroll
      for (int i = 0; i < 16; ++i) X[d * 4096 + (16 * bi + i) * 64 + 16 * bi + c] = x[i];
    }
  }
  __syncthreads();
  LAS float* Tm = (LAS float*)(lds + 119040) + wid * 256;
  for (int dd = 1; dd < 4; ++dd) {
    const int nb = 4 - dd; const bool act = wid < 2 * nb;
    const int d = act ? wid / nb : 0, bi = act ? dd + wid % nb : dd, bj = bi - dd;
    const int lr = lane & 15, lq = lane >> 4;
    if (act) {
      f32x4 acc = (f32x4){0.f, 0.f, 0.f, 0.f};
      for (int kb = bj; kb < bi; ++kb) {
#pragma unroll
        for (int kk = 0; kk < 4; ++kk) {
          const float a = Lm[d * 4096 + (16 * bi + lr) * 64 + 16 * kb + 4 * kk + lq];
          const float b = X[d * 4096 + (16 * kb + 4 * kk + lq) * 64 + 16 * bj + lr];
          acc = __builtin_amdgcn_mfma_f32_16x16x4f32(a, b, acc, 0, 0, 0);
        }
      }
#pragma unroll
      for (int rg = 0; rg < 4; ++rg) Tm[(lq * 4 + rg) * 16 + lr] = acc[rg];
    }
    __syncthreads();
    if (act) {
      f32x4 acc = (f32x4){0.f, 0.f, 0.f, 0.f};
#pragma unroll
      for (int kk = 0; kk < 4; ++kk) {
        const float a = X[d * 4096 + (16 * bi + lr) * 64 + 16 * bi + 4 * kk + lq];
        const float b = Tm[(4 * kk + lq) * 16 + lr];
        acc = __builtin_amdgcn_mfma_f32_16x16x4f32(a, b, acc, 0, 0, 0);
      }
#pragma unroll
      for (int rg = 0; rg < 4; ++rg) X[d * 4096 + (16 * bi + lq * 4 + rg) * 64 + 16 * bj + lr] = -acc[rg];
    }
    __syncthreads();
  }
  {
    bf16_t* Tg = (bf16_t*)(p.ws + WS_T) + ((size_t)(ck * 8 + hd) * 2) * 4096;
    for (int e = tid; e < 4096; e += 512) *(unsigned*)(Tg + 2 * e) = pack2(X[2 * e], X[2 * e + 1]);
  }
  __syncthreads();
  }
#undef DN1_PREFETCH
}

constexpr int DN2_DIR_BYTES = 80896;
DI void dn2_item(const Params& p, lptr lds, int l, int item) {
  const int tid = tid_opaque(), wid = tid >> 6, lane = tid & 63, r = lane & 31, hh = lane >> 5;
  const int i2 = l >> 1;
  const bool samp = item < 256;
  int b, hd, slab, nch, seqrow, ckb;
  if (samp) { b = item >> 5; hd = (item >> 2) & 7; slab = item & 3; nch = 64; seqrow = M_P + b * 4096; ckb = 64 + b * 64; }
  else { const int j = item - 256; b = j >> 5; hd = (j >> 2) & 7; slab = j & 3; nch = 4; seqrow = b * 256; ckb = b * 4; }
  const int dir = wid >> 2, w4 = wid & 3, td = tid & 255;
  const bf16_t* P = (const bf16_t*)(p.ws + WS_P);
  const bf16_t* Tg = (const bf16_t*)(p.ws + WS_T);
  const float* gcbase = (const float*)(p.ws + WS_CARRY);
  bf16_t* O = (bf16_t*)(p.ws + WS_H);
  lptr base = lds + dir * DN2_DIR_BYTES;
  LAS bf16_t* Qn = (LAS bf16_t*)base;
  LAS bf16_t* Kn = (LAS bf16_t*)(base + 17408);
  LAS bf16_t* Tm = (LAS bf16_t*)(base + 34816);
  LAS bf16_t* QK = (LAS bf16_t*)(base + 44032);
  LAS bf16_t* St = (LAS bf16_t*)(base + 53248);
  LAS bf16_t* Rt = (LAS bf16_t*)(base + 61952);
  LAS bf16_t* Vt = (LAS bf16_t*)(base + 66560);
  LAS bf16_t* Vn = (LAS bf16_t*)(base + 71168);
  LAS bf16_t* Vd = (LAS bf16_t*)(base + 75776);
  LAS float* gcs = (LAS float*)(base + 80384);
  LAS float* bts = gcs + 64;
  LAS float* egs = (LAS float*)(lds + 2 * DN2_DIR_BYTES) + dir * 128;
  LAS float* dds = egs + 64;
  f32x16 S;
  const size_t sidx = ((((size_t)(b * 2 + i2) * 2 + dir) * 8 + hd) * 128 + 32 * w4) * 128 + slab * 32 + r;
#pragma unroll
  for (int ii = 0; ii < 16; ++ii) S[ii] = samp ? p.in[6][sidx + (size_t)crow(ii, hh) * 128] : 0.f;
#pragma unroll
  for (int g = 0; g < 4; ++g) *(LAS u32x2*)(St + r * 136 + 32 * w4 + 8 * g + 4 * hh) = (u32x2){pack2(S[4 * g], S[4 * g + 1]), pack2(S[4 * g + 2], S[4 * g + 3])};
  u32x4 pq[4], pk[4], pt[2], pv; float pa0 = 0.f, pa1 = 0.f;
#define DN2_PREFETCH(sn) do { const int cn_ = dir ? nch - 1 - (sn) : (sn); const size_t r0_ = (size_t)seqrow + (size_t)cn_ * 64; \
    _Pragma("unroll") for (int k_ = 0; k_ < 4; ++k_) { const int e_ = td + 256 * k_, ip_ = e_ >> 4, pc_ = e_ & 15; const size_t rg_ = r0_ + (dir ? 63 - ip_ : ip_); \
      pq[k_] = *(const u32x4*)(P + rg_ * ODD_LD + hd * 128 + pc_ * 8); pk[k_] = *(const u32x4*)(P + rg_ * ODD_LD + 1024 + hd * 128 + pc_ * 8); } \
    _Pragma("unroll") for (int k_ = 0; k_ < 2; ++k_) { const int e_ = td + 256 * k_; pt[k_] = *(const u32x4*)(Tg + ((size_t)((ckb + cn_) * 8 + hd) * 2 + dir) * 4096 + e_ * 8); } \
    { const int ip_ = td >> 2, pc_ = td & 3; const size_t rg_ = r0_ + (dir ? 63 - ip_ : ip_); pv = *(const u32x4*)(P + rg_ * ODD_LD + 2048 + hd * 128 + slab * 32 + pc_ * 8); } \
    if (w4 == 0) { const float* gcb_ = gcbase + ((size_t)((ckb + cn_) * 8 + hd) * 2 + dir) * 128; pa0 = gcb_[lane]; pa1 = gcb_[64 + lane]; } } while (0)
  DN2_PREFETCH(0);
  f32x16 o1 = zero16();
  for (int s = 0; s < nch; ++s) {
    const int c = dir ? nch - 1 - s : s;
    const int row0c = seqrow + c * 64;
#pragma unroll
    for (int k = 0; k < 4; ++k) { const int e = td + 256 * k, ip = e >> 4, pc = e & 15; *(LAS u32x4*)(Qn + ip * 136 + pc * 8) = pq[k]; *(LAS u32x4*)(Kn + ip * 136 + pc * 8) = pk[k]; }
#pragma unroll
    for (int k = 0; k < 2; ++k) { const int e = td + 256 * k; *(LAS u32x4*)(Tm + (e >> 3) * 72 + (e & 7) * 8) = pt[k]; }
    { const int ip = td >> 2, pc = td & 3;
      Vt[(pc * 8 + 0) * 72 + ip] = (bf16_t)(pv.x & 0xffffu); Vt[(pc * 8 + 1) * 72 + ip] = (bf16_t)(pv.x >> 16);
      Vt[(pc * 8 + 2) * 72 + ip] = (bf16_t)(pv.y & 0xffffu); Vt[(pc * 8 + 3) * 72 + ip] = (bf16_t)(pv.y >> 16);
      Vt[(pc * 8 + 4) * 72 + ip] = (bf16_t)(pv.z & 0xffffu); Vt[(pc * 8 + 5) * 72 + ip] = (bf16_t)(pv.z >> 16);
      Vt[(pc * 8 + 6) * 72 + ip] = (bf16_t)(pv.w & 0xffffu); Vt[(pc * 8 + 7) * 72 + ip] = (bf16_t)(pv.w >> 16); }
    if (w4 == 0) { gcs[lane] = pa0; bts[lane] = pa1; egs[lane] = __expf(pa0); dds[lane] = __expf(__shfl(pa0, 63) - pa0); }
    __syncthreads();
    if (s + 1 < nch) DN2_PREFETCH(s + 1);
    bf16_t* const orow = O + (size_t)(row0c + (dir ? 63 - (td >> 2) : (td >> 2))) * 1024 + hd * 128 + slab * 32 + (td & 3) * 8;
    u32x4 po = (u32x4){0u, 0u, 0u, 0u};
    if (2 * s >= nch) po = *(const u32x4*)orow;
    {
      const int jt = w4 >> 1, it = w4 & 1;
      const LAS bf16_t* a2 = w4 < 2 ? Qn + w4 * 32 * 136 : Kn + (w4 - 2) * 32 * 136;
      f32x16 acc = zero16(), acc2 = zero16();
      {
        const LAS bf16_t* ap = Kn + jt * 32 * 136 + r * 136 + 8 * hh; const LAS bf16_t* bp = Qn + it * 32 * 136 + r * 136 + 8 * hh;
        const LAS bf16_t* cp = a2 + r * 136 + 8 * hh; const LAS bf16_t* dp = St + r * 136 + 8 * hh;
#pragma unroll 4
        for (int k0 = 0; k0 < 128; k0 += 16) {
          const bf16x8 fa = *(const LAS bf16x8*)(ap + k0), fb = *(const LAS bf16x8*)(bp + k0), fc = *(const LAS bf16x8*)(cp + k0), fd = *(const LAS bf16x8*)(dp + k0);
          acc = MFMA32(fa, fb, acc); acc2 = MFMA32(fc, fd, acc2);
        }
      }
      const int i = it * 32 + r; const float gi = gcs[i];
      f32x4 gjv[4];
#pragma unroll
      for (int g = 0; g < 4; ++g) gjv[g] = *(const LAS f32x4*)(gcs + jt * 32 + 8 * g + 4 * hh);
#pragma unroll
      for (int g = 0; g < 4; ++g) {
        const int j0 = jt * 32 + 8 * g + 4 * hh; float v[4];
        const f32x4 gj = gjv[g];
#pragma unroll
        for (int e = 0; e < 4; ++e) { const float w = acc[4 * g + e] * __expf(fminf(gi - gj[e], 0.f)); v[e] = (i >= j0 + e) ? w : 0.f; }
        *(LAS u32x2*)(QK + i * 72 + j0) = (u32x2){pack2(v[0], v[1]), pack2(v[2], v[3])};
      }
      if (w4 < 2) {
        o1 = acc2;
      } else {
        const int jt2 = w4 - 2;
#pragma unroll
        for (int g = 0; g < 4; ++g) {
          const int j0 = jt2 * 32 + 8 * g + 4 * hh;
          const u32x2 vv = *(const LAS u32x2*)(Vt + r * 72 + j0);
          const float ve[4] = {lo2f(vv.x), hi2f(vv.x), lo2f(vv.y), hi2f(vv.y)}; float rv[4];
          const f32x4 gj4 = *(const LAS f32x4*)(egs + j0), bj4 = *(const LAS f32x4*)(bts + j0);
#pragma unroll
          for (int e = 0; e < 4; ++e) rv[e] = bj4[e] * (ve[e] - gj4[e] * acc2[4 * g + e]);
          *(LAS u32x2*)(Rt + r * 72 + j0) = (u32x2){pack2(rv[0], rv[1]), pack2(rv[2], rv[3])};
        }
      }
    }
    __syncthreads();
    if (w4 >= 2) {
      const int it = w4 - 2;
      const f32x16 acc = mm32(Tm + it * 32 * 72, 72, Rt, 72, 64, zero16(), lane);
      f32x4 ddv[4];
#pragma unroll
      for (int g = 0; g < 4; ++g) ddv[g] = *(const LAS f32x4*)(dds + it * 32 + 8 * g + 4 * hh);
#pragma unroll
      for (int g = 0; g < 4; ++g) {
        const int i0 = it * 32 + 8 * g + 4 * hh; float dv[4];
        const f32x4 gi4 = ddv[g];
#pragma unroll
        for (int e = 0; e < 4; ++e) dv[e] = acc[4 * g + e] * gi4[e];
        *(LAS u32x2*)(Vn + r * 72 + i0) = (u32x2){pack2(acc[4 * g], acc[4 * g + 1]), pack2(acc[4 * g + 2], acc[4 * g + 3])};
        *(LAS u32x2*)(Vd + r * 72 + i0) = (u32x2){pack2(dv[0], dv[1]), pack2(dv[2], dv[3])};
      }
    }
    __syncthreads();
    if (w4 < 2) {
      const int it = w4;
#pragma unroll
      for (int g = 0; g < 4; ++g) { const f32x4 gi4 = *(const LAS f32x4*)(egs + it * 32 + 8 * g + 4 * hh);
#pragma unroll
        for (int e = 0; e < 4; ++e) o1[4 * g + e] *= gi4[e]; }
      o1 = mm32(QK + it * 32 * 72, 72, Vn, 72, 64, o1, lane);
#pragma unroll
      for (int ii = 0; ii < 16; ++ii) Rt[(it * 32 + crow(ii, hh)) * 32 + r] = f2bf(o1[ii]);
    }
    {
      const float gl = egs[63];
#pragma unroll
      for (int ii = 0; ii < 16; ++ii) S[ii] *= gl;
#pragma unroll
      for (int jt = 0; jt < 2; ++jt) {
        unsigned x[16];
#pragma unroll
        for (int ii = 0; ii < 16; ++ii) x[ii] = Kn[(jt * 32 + crow(ii, hh)) * 136 + 32 * w4 + r];
#pragma unroll
        for (int s2 = 0; s2 < 2; ++s2) {
          const u32x4 aw = (u32x4){x[8 * s2] | (x[8 * s2 + 1] << 16), x[8 * s2 + 2] | (x[8 * s2 + 3] << 16), x[8 * s2 + 4] | (x[8 * s2 + 5] << 16), x[8 * s2 + 6] | (x[8 * s2 + 7] << 16)};
          const LAS bf16_t* bp = Vd + r * 72 + jt * 32 + 16 * s2 + 4 * hh;
          const u32x2 lo = *(const LAS u32x2*)bp, hi = *(const LAS u32x2*)(bp + 8);
          S = MFMA32(__builtin_bit_cast(bf16x8, aw), __builtin_bit_cast(bf16x8, ((u32x4){lo.x, lo.y, hi.x, hi.y})), S);
        }
      }
#pragma unroll
      for (int g = 0; g < 4; ++g) *(LAS u32x2*)(St + r * 136 + 32 * w4 + 8 * g + 4 * hh) = (u32x2){pack2(S[4 * g], S[4 * g + 1]), pack2(S[4 * g + 2], S[4 * g + 3])};
    }
    __syncthreads();
    {
      u32x4 ov = *(const LAS u32x4*)(Rt + (td >> 2) * 32 + (td & 3) * 8);
      if (2 * s >= nch) {
        ov.x = pack2(lo2f(ov.x) + lo2f(po.x), hi2f(ov.x) + hi2f(po.x)); ov.y = pack2(lo2f(ov.y) + lo2f(po.y), hi2f(ov.y) + hi2f(po.y));
        ov.z = pack2(lo2f(ov.z) + lo2f(po.z), hi2f(ov.z) + hi2f(po.z)); ov.w = pack2(lo2f(ov.w) + lo2f(po.w), hi2f(ov.w) + hi2f(po.w));
      }
      *(u32x4*)orow = ov;
    }
  }
#undef DN2_PREFETCH
  if (!samp) {
    const size_t oidx = (size_t)OFF_DN + ((((size_t)(b * 2 + i2) * 2 + dir) * 8 + hd) * 128 + 32 * w4) * 128 + slab * 32 + r;
#pragma unroll
    for (int ii = 0; ii < 16; ++ii) p.out[oidx + (size_t)crow(ii, hh) * 128] = S[ii];
  }
}

DI void phase_dn3(const Params& p, int l) {
  const int i2 = l >> 1;
  bf16_t* Y = (bf16_t*)(p.ws + WS_H);
  const bf16_t* P = (const bf16_t*)(p.ws + WS_P);
  const float* gain = p.in[27] + i2 * 128;
  const int tstride = gridDim.x * 512, ntask = M_TOT * 128;
  u32x4 ov[2], zv[2], nov[2], nzv[2];
  int task0 = bid_opaque() * 512 + tid_opaque();
#define DN3_LOAD(ovv, zvv, t0_) do { _Pragma("unroll") for (int q_ = 0; q_ < 2; ++q_) { \
      int task_ = (t0_) + q_ * tstride; if (task_ >= ntask) task_ = bid_opaque() * 512 + tid_opaque(); \
      const int pc_ = task_ & 15, rh_ = task_ >> 4, hd_ = rh_ & 7, row_ = rh_ >> 3, col_ = hd_ * 128 + pc_ * 8; \
      ovv[q_] = *(const u32x4*)(Y + (size_t)row_ * 1024 + col_); zvv[q_] = *(const u32x4*)(P + (size_t)row_ * ODD_LD + 3072 + col_); } } while (0)
  if (task0 < ntask) DN3_LOAD(ov, zv, task0);
  const f32x4 g0 = *(const f32x4*)(gain + (tid_opaque() & 15) * 8), g1 = *(const f32x4*)(gain + (tid_opaque() & 15) * 8 + 4);
  const float gg[8] = {g0[0], g0[1], g0[2], g0[3], g1[0], g1[1], g1[2], g1[3]};
  for (; task0 < ntask; task0 += 2 * tstride) {
    if (task0 + 2 * tstride < ntask) DN3_LOAD(nov, nzv, task0 + 2 * tstride);
#pragma unroll
    for (int q = 0; q < 2; ++q) {
      const int task = task0 + q * tstride;
      const int pc = task & 15, rh = task >> 4, hd = rh & 7, row = rh >> 3, col = hd * 128 + pc * 8;
      float o[8] = {lo2f(ov[q].x), hi2f(ov[q].x), lo2f(ov[q].y), hi2f(ov[q].y), lo2f(ov[q].z), hi2f(ov[q].z), lo2f(ov[q].w), hi2f(ov[q].w)};
      const float z[8] = {lo2f(zv[q].x), hi2f(zv[q].x), lo2f(zv[q].y), hi2f(zv[q].y), lo2f(zv[q].z), hi2f(zv[q].z), lo2f(zv[q].w), hi2f(zv[q].w)};
      float ss = 0.f;
#pragma unroll
      for (int e = 0; e < 8; ++e) ss += o[e] * o[e];
      ss += __shfl_xor(ss, 1); ss += __shfl_xor(ss, 2); ss += __shfl_xor(ss, 4); ss += __shfl_xor(ss, 8);
      const float rstd = rsqrtf(ss * (1.f / 128.f) + 1e-6f);
#pragma unroll
      for (int e = 0; e < 8; ++e) o[e] = o[e] * rstd * gg[e] * siluf_(z[e]);
      if (task < ntask) *(u32x4*)(Y + (size_t)row * 1024 + col) = (u32x4){pack2(o[0], o[1]), pack2(o[2], o[3]), pack2(o[4], o[5]), pack2(o[6], o[7])};
    }
#pragma unroll
    for (int q = 0; q < 2; ++q) { ov[q] = nov[q]; zv[q] = nzv[q]; }
  }
#undef DN3_LOAD
}

constexpr int ROWS_A = 32768;
constexpr int N_PHASES = 1 + 11 + 11 + 10 + 11;
enum { ST_N1, ST_IN, ST_M0, ST_M1, ST_M2, ST_OUTA, ST_OUTB, ST_N2T, ST_GU, ST_DNA, ST_DNB, ST_N1T };
DI void run_phase(const Params& p, lptr lds, int ph) {
  const int G = gridDim.x, bid = bid_opaque();
  if (ph == 0) { phase_pre(p, lds, 0, G == 256 ? 2 : 4, bid, G, true); return; }
  int l, k; { int q = ph - 1; if (q < 11) { l = 0; k = q; } else if (q < 22) { l = 1; k = q - 11; } else if (q < 32) { l = 2; k = q - 22; } else { l = 3; k = q - 32; } }
  const bool odd = l & 1; const int i2 = l >> 1;
  int st;
  if (l == 0) { const int tab[11] = {ST_N1, ST_IN, ST_M0, ST_M1, ST_OUTA, ST_OUTB, ST_N2T, ST_GU, ST_DNA, ST_DNB, ST_N1T}; st = tab[k]; }
  else if (odd) { const int tab[11] = {ST_IN, ST_M0, ST_M1, ST_M2, ST_OUTA, ST_OUTB, ST_N2T, ST_GU, ST_DNA, ST_DNB, ST_N1T}; st = tab[k]; }
  else { const int tab[10] = {ST_IN, ST_M0, ST_M1, ST_OUTA, ST_OUTB, ST_N2T, ST_GU, ST_DNA, ST_DNB, ST_N1T}; st = tab[k]; }
  float* mod = (float*)(p.ws + WS_MOD);
  bf16_t* H = (bf16_t*)(p.ws + WS_H); bf16_t* Pb = (bf16_t*)(p.ws + WS_P);
  if (st == ST_N1) { phase_norm(p, lds, l, 0); return; }
  if (st == ST_IN) {
    pg8::EpiIn E; E.P = Pb; E.ldp = odd ? ODD_LD : EVEN_IN; E.odd = odd ? 1 : 0;
    E.kout = p.out + OFF_K + (size_t)i2 * 256 * 128; E.vout = p.out + OFF_V + (size_t)i2 * 256 * 128;
    E.ab = (float*)(p.ws + WS_AB); E.halo = (bf16_t*)(p.ws + WS_HALO);
    run_gemm(lds, H, (const bf16_t*)(p.ws + WS_WIN), odd ? ODD_NP : EVEN_IN, 1024, E); return;
  }
  if (st == ST_M0 || st == ST_M1 || st == ST_M2) {
    const int ms = st - ST_M0;
    if (ms == 0 && l > 0) { cvt_layer(p, lds, l, 4, bid, G); __syncthreads(); }
    if (!odd) {
      if (ms == 0) {
        for (int it = bid; it < 1152; it += G) att_item(p, lds, l, it);
        rg_phase(p, lds, l, 0);
      } else { rg_phase(p, lds, l, 1); }
    } else {
      if (ms == 0) dn1_phase(p, lds, l);
      else if (ms == 1) {
        for (int it = bid; it < 768; it += G) {
          const int grp = it >> 8, j = it & 255, xcd = j & 7, idx = j >> 3;
          dn2_item(p, lds, l, grp * 256 + ((xcd * 8 + (idx >> 2)) * 4 + (idx & 3))); __syncthreads();
        }
      }
      else phase_dn3(p, l);
    }
    return;
  }
  if (st == ST_OUTA || st == ST_OUTB) {
    pg8::EpiRes E; E.x = p.out; E.ga_base = mod + (size_t)l * 9 * 6144 + 2048;
    if (st == ST_OUTA) { E.rbase = 0; run_gemm_sub(lds, H, (const bf16_t*)(p.ws + WS_WOUT), ROWS_A, 1024, 1024, E, bid, G); return; }
    if (bid < 64) { E.rbase = ROWS_A; run_gemm_sub(lds, H + (size_t)ROWS_A * 1024, (const bf16_t*)(p.ws + WS_WOUT), M_TOT - ROWS_A, 1024, 1024, E, bid, 64); }
    else norm_rows(p, l, 1, 0, ROWS_A, bid - 64, G - 64);
    return;
  }
  if (st == ST_N2T) { norm_rows(p, l, 1, ROWS_A, M_TOT, bid, G); return; }
  if (st == ST_GU) { pg8::EpiGU E; E.act = Pb; run_gemm(lds, H, (const bf16_t*)(p.ws + WS_WGU), 5632, 1024, E); return; }
  if (st == ST_DNA || st == ST_DNB) {
    pg8::EpiRes E; E.x = p.out; E.ga_base = mod + (size_t)l * 9 * 6144 + 5120;
    if (st == ST_DNA) { E.rbase = 0; run_gemm_sub(lds, Pb, (const bf16_t*)(p.ws + WS_WDN), ROWS_A, 1024, DFF, E, bid, G); return; }
    if (bid < 64) { E.rbase = ROWS_A; run_gemm_sub(lds, Pb + (size_t)ROWS_A * DFF, (const bf16_t*)(p.ws + WS_WDN), M_TOT - ROWS_A, 1024, DFF, E, bid, 64); }
    else {
      if (l < 3) { norm_rows(p, l + 1, 0, 0, ROWS_A, bid - 64, G - 64); cvt_layer(p, lds, l + 1, 3, bid - 64, G - 64); if (l == 0 && G == 256) { __syncthreads(); phase_pre(p, lds, 2, 4, bid - 64, G - 64, false); } }
      else norm_rows(p, 0, 2, 0, ROWS_A, bid - 64, G - 64);
    }
    return;
  }
  if (l < 3) norm_rows(p, l + 1, 0, ROWS_A, M_TOT, bid, G); else norm_rows(p, 0, 2, ROWS_A, M_TOT, bid, G);
}

#define XB_TMO      128
#define XB_XCNT(j)  (256  + 64 * (j))
#define XB_XSUB(j)  (1280 + 64 * (j))
#define XB_XGEN(j)  (2304 + 64 * (j))
#define XB_TOP      3328
#define XB_TOPGEN   3392
#define XCD_BAR_WORDS 3456
#define XB_SPIN_CAP (1u << 20)
DI unsigned xb_ld(unsigned* p) { return __hip_atomic_load(p, __ATOMIC_RELAXED, __HIP_MEMORY_SCOPE_AGENT); }
DI unsigned xb_add(unsigned* p, unsigned v) { return __hip_atomic_fetch_add(p, v, __ATOMIC_RELAXED, __HIP_MEMORY_SCOPE_AGENT); }
DI unsigned xb_xcc_id() { return (unsigned)__builtin_amdgcn_s_getreg((3 << 11) | 20) & 0xFu; }
#define XB_SPIN(cond, bar) do { unsigned _sp = 0; while (cond) { __builtin_amdgcn_s_sleep(1); \
    if ((++_sp & 255u) == 0u) { if (xb_ld(&(bar)[XB_TMO])) break; if (_sp > XB_SPIN_CAP) { atomicAdd(&(bar)[XB_TMO], 1u); break; } } } } while (0)
struct XcdBarrier { unsigned* bar; unsigned x; volatile LAS unsigned* st; };
DI XcdBarrier xcd_barrier_post(unsigned* bar, volatile LAS unsigned* st) {
  XcdBarrier b; b.bar = bar; b.x = xb_xcc_id(); b.st = st;
  if (threadIdx.x == 0) (void)xb_add(&bar[XB_XCNT(b.x)], 1u);
  return b;
}
DI void xcd_barrier_complete(unsigned* bar, unsigned x, unsigned& nloc, unsigned& nx) {
  const unsigned G = gridDim.x;
  unsigned sum, cnt, mine, sp = 0u;
  for (;;) {
    sum = 0u; cnt = 0u; mine = 0u;
#pragma unroll
    for (unsigned j = 0; j < 16; ++j) { const unsigned c = xb_ld(&bar[XB_XCNT(j)]); sum += c; cnt += (c > 0u) ? 1u : 0u; mine = (j == x) ? c : mine; }
    if (sum == G) break;
    __builtin_amdgcn_s_sleep(1);
    if ((++sp & 255u) == 0u) { if (xb_ld(&bar[XB_TMO])) break; if (sp > XB_SPIN_CAP) { atomicAdd(&bar[XB_TMO], 1u); break; } }
  }
  nloc = mine > 0u ? mine : 1u; nx = cnt > 0u ? cnt : 1u;
}
DI void xcd_barrier(const XcdBarrier& b) {
  asm volatile("s_waitcnt vmcnt(0)" ::: "memory");
  __syncthreads();
  if (threadIdx.x == 0) {
    unsigned* bar = b.bar;
    __builtin_amdgcn_s_waitcnt(0);
    unsigned nloc = b.st[0], nx = b.st[1];
    if (nloc == 0u) { xcd_barrier_complete(bar, b.x, nloc, nx); b.st[0] = nloc; b.st[1] = nx; }
    const unsigned old = xb_add(&bar[XB_XSUB(b.x)], 1u);
    const unsigned gen = old / nloc;
    if (old + 1u == (gen + 1u) * nloc) {
      __builtin_amdgcn_fence(__ATOMIC_RELEASE, "agent");
      asm volatile("s_waitcnt vmcnt(0)" ::: "memory");
      const unsigned og = xb_add(&bar[XB_TOP], 1u);
      const unsigned tg = og / nx;
      if (og + 1u == (tg + 1u) * nx) xb_add(&bar[XB_TOPGEN], 1u);
      else XB_SPIN(xb_ld(&bar[XB_TOPGEN]) == tg, bar);
      __builtin_amdgcn_fence(__ATOMIC_ACQUIRE, "agent");
      xb_add(&bar[XB_XGEN(b.x)], 1u);
      asm volatile("s_waitcnt vmcnt(0)" ::: "memory");
    } else {
      XB_SPIN(xb_ld(&bar[XB_XGEN(b.x)]) == gen, bar);
      __builtin_amdgcn_fence(__ATOMIC_ACQUIRE, "agent");
      asm volatile("s_waitcnt vmcnt(0)" ::: "memory");
    }
  }
  __syncthreads();
}

__global__ void __launch_bounds__(512, 2) fwd_kernel(Params p) {
  extern __shared__ __attribute__((aligned(16))) unsigned char smem[];
  lptr lds = (lptr)smem;
  cg::grid_group grid = cg::this_grid();
  volatile LAS unsigned* xst = (volatile LAS unsigned*)(lds + LDS_BYTES - 16);
  if (threadIdx.x == 0) { xst[0] = 0u; xst[1] = 0u; }
  __syncthreads();
  const XcdBarrier xb = xcd_barrier_post((unsigned*)(p.ws + WS_BAR), xst);
  const int p_lo = p.p_lo, p_hi = p.p_hi, coop = p.coop;
  for (int ph = p_lo; ph < p_hi; ++ph) {
    unsigned long long kav = (unsigned long long)__builtin_amdgcn_kernarg_segment_ptr();
    asm volatile("" : "+s"(kav));
    const __attribute__((address_space(4))) Params* kp = (const __attribute__((address_space(4))) Params*)kav;
    run_phase(*(const Params*)kp, lds, ph);
    if (coop && ph + 1 < p_hi) {
      if (ph == p_lo) grid.sync();
      else xcd_barrier(xb);
    }
  }
}

extern "C" void kernel_launch(void* const* d_in, const int* in_sizes, int n_in, void* d_out, int out_size, void* d_ws, size_t ws_size, hipStream_t stream) {
  static int grid = 0;
  if (grid == 0) {
    if (n_in != 31 || ws_size < WS_TOTAL) { fprintf(stderr, "kernel_launch: unexpected n_in %d or ws_size %zu (need %zu)\n", n_in, ws_size, (size_t)WS_END); grid = -1; return; }
    int dev = 0, cus = 0, per_cu = 0;
    hipGetDevice(&dev);
    hipDeviceGetAttribute(&cus, hipDeviceAttributeMultiprocessorCount, dev);
    if (hipFuncSetAttribute((const void*)fwd_kernel, hipFuncAttributeMaxDynamicSharedMemorySize, LDS_BYTES) != hipSuccess) { fprintf(stderr, "kernel_launch: hipFuncSetAttribute failed\n"); }
    hipOccupancyMaxActiveBlocksPerMultiprocessor(&per_cu, (const void*)fwd_kernel, 512, LDS_BYTES);
    (void)hipGetLastError();
    if (per_cu < 1) per_cu = 1;
    grid = cus * per_cu;
    if (grid > 256) grid = 256;
    fprintf(stderr, "kernel_launch: cus %d per_cu %d grid %d ws %zu need %zu\n", cus, per_cu, grid, ws_size, (size_t)WS_END);
  }
  if (grid < 0) return;
  if (hipMemsetAsync((char*)d_ws + WS_BAR, 0, 16384, stream) != hipSuccess) fprintf(stderr, "kernel_launch: memset failed\n");
  Params p{};
  for (int i = 0; i < 31; ++i) p.in[i] = (const float*)d_in[i];
  p.out = (float*)d_out; p.ws = (unsigned char*)d_ws; p.p_lo = 0; p.p_hi = N_PHASES; p.coop = 1; p.pad = 0;
  void* args[] = {&p};
  hipError_t e = hipLaunchCooperativeKernel((const void*)fwd_kernel, dim3(grid), dim3(512), args, LDS_BYTES, stream);
  if (e != hipSuccess) fprintf(stderr, "cooperative launch failed: %s (grid %d)\n", hipGetErrorString(e), grid);
}
```

```cpp
#include <hip/hip_runtime.h>
#include <hip/hip_cooperative_groups.h>
#include <cstdio>
namespace cg = cooperative_groups;
#define DI __device__ __forceinline__
#define LAS __attribute__((address_space(3)))
typedef unsigned short bf16_t;
typedef short bf16x8 __attribute__((ext_vector_type(8)));
typedef float f32x4 __attribute__((ext_vector_type(4)));
typedef float f32x16 __attribute__((ext_vector_type(16)));
typedef unsigned u32x4 __attribute__((ext_vector_type(4)));
typedef unsigned u32x2 __attribute__((ext_vector_type(2)));
typedef LAS unsigned char* lptr;

constexpr int M_TOT = 36864, M_P = 4096, DM = 1024;
constexpr int EVEN_IN = 1792, ODD_NP = 4352, ODD_LD = 4096, DFF = 2816;
constexpr int OFF_K = M_TOT * DM, OFF_V = OFF_K + 1048576, OFF_RG = OFF_V + 1048576, OFF_DN = OFF_RG + 32768;
constexpr size_t WS_MOD = 0;
constexpr size_t WS_ROPE = WS_MOD + 884736;
constexpr size_t WS_WIN = WS_ROPE + 1048576;
constexpr size_t WS_WOUT = WS_WIN + (size_t)ODD_NP * 1024 * 2;
constexpr size_t WS_WGU = WS_WOUT + 1024 * 1024 * 2;
constexpr size_t WS_WDN = WS_WGU + (size_t)5632 * 1024 * 2;
constexpr size_t WS_RGW = WS_WDN + (size_t)1024 * 2816 * 2;
constexpr size_t WS_H = WS_RGW + 262144;
constexpr size_t WS_P = WS_H + (size_t)M_TOT * 1024 * 2;
constexpr size_t WS_AB = WS_P + (size_t)M_TOT * 4096 * 2;
constexpr size_t WS_HALO = WS_AB + (size_t)M_TOT * 32 * 4;
constexpr size_t WS_T = WS_HALO + (size_t)576 * 3 * 3072 * 2;
constexpr size_t WS_CARRY = WS_T + (size_t)576 * 8 * 2 * 4096 * 2;
constexpr size_t WS_END = WS_CARRY + (size_t)576 * 2 * 2 * 512 * 4;
constexpr size_t WS_BAR = WS_END;
constexpr size_t WS_TOTAL = WS_BAR + 16384;
constexpr int LDS_BYTES = 160 * 1024;

struct Params {
  const float* in[31];
  float* out;
  unsigned char* ws;
  int p_lo, p_hi, coop, pad;
};

DI int tid_opaque() { int t = threadIdx.x; asm volatile("" : "+v"(t)); return t; }
DI int bid_opaque() { int t = blockIdx.x; asm volatile("" : "+s"(t)); return t; }

typedef __bf16 hwbf16x2 __attribute__((ext_vector_type(2)));
typedef float f32x2v __attribute__((ext_vector_type(2)));
DI unsigned pack2(float lo, float hi) { const f32x2v v = {lo, hi}; return __builtin_bit_cast(unsigned, __builtin_convertvector(v, hwbf16x2)); }
DI bf16_t f2bf(float f) { return (bf16_t)(pack2(f, 0.f) & 0xffffu); }
DI float bf2f(bf16_t b) { return __uint_as_float(((unsigned)b) << 16); }
DI float lo2f(unsigned u) { return __uint_as_float(u << 16); }
DI float hi2f(unsigned u) { return __uint_as_float(u & 0xffff0000u); }
DI float sigmoidf_(float x) { return __builtin_amdgcn_rcpf(1.f + __expf(-x)); }
DI float siluf_(float x) { return x * __builtin_amdgcn_rcpf(1.f + __expf(-x)); }
DI float softplusf_(float x) { return x > 20.f ? x : log1pf(__expf(x)); }
DI int crow(int reg, int h) { return (reg & 3) + 8 * (reg >> 2) + 4 * h; }
DI int row_group(int r) { return r < M_P ? 0 : 1 + ((r - M_P) >> 12); }
DI float wave_sum(float v) {
#pragma unroll
  for (int o = 32; o > 0; o >>= 1) v += __shfl_xor(v, o);
  return v;
}
#define MFMA32(a, b, c) __builtin_amdgcn_mfma_f32_32x32x16_bf16((a), (b), (c), 0, 0, 0)
DI f32x16 mm32(const LAS bf16_t* A, int lda, const LAS bf16_t* Bt, int ldb, int K, f32x16 acc, int lane) {
  const int r = lane & 31, h = lane >> 5;
  const LAS bf16_t* ap = A + r * lda + 8 * h;
  const LAS bf16_t* bp = Bt + r * ldb + 8 * h;
_Pragma("unroll 4")
  for (int k0 = 0; k0 < K; k0 += 16) {
    bf16x8 a = *(const LAS bf16x8*)(ap + k0);
    bf16x8 b = *(const LAS bf16x8*)(bp + k0);
    acc = MFMA32(a, b, acc);
  }
  return acc;
}
DI f32x16 zero16() { f32x16 z; for (int i = 0; i < 16; ++i) z[i] = 0.f; return z; }

DI void phase_pre(const Params& p, lptr lds, int l_lo, int l_hi, int vb, int nb, bool rope) {
  const int tid = tid_opaque(), wid = tid >> 6, lane = tid & 63;
  float* rc = (float*)(p.ws + WS_ROPE); float* rs = rc + 4096 * 32;
  if (rope)
  for (int e = bid_opaque() * 512 + tid; e < 4096 * 32; e += gridDim.x * 512) {
    const int t = e >> 5, f = e & 31, fr = f & 15;
    const float inv = exp2f(-(float)fr * 0.83048202372184058696f);
    const float pos = (f < 16) ? (float)(t >> 6) : (float)(t & 63);
    float x = pos * inv * 0.15915494309189533577f; x -= floorf(x);
    rc[e] = __builtin_amdgcn_cosf(x); rs[e] = __builtin_amdgcn_sinf(x);
  }
  LAS float* sc = (LAS float*)lds;
  LAS float* red = sc + 9 * 1024;
  for (int e = tid; e < 9 * 1024; e += 512) { const int g = e >> 10, k = e & 1023; const float v = g == 0 ? p.in[7][k] : p.in[2][(g - 1) * 1024 + k]; sc[e] = siluf_(v); }
  __syncthreads();
  float* mod = (float*)(p.ws + WS_MOD);
  for (int it = vb; it < (l_hi - l_lo) * 96; it += nb) {
    const int l = l_lo + it / 96, n0 = (it % 96) * 64;
    const float* w = p.in[8] + (size_t)l * 1024 * 6144 + n0 + lane;
    float acc[9];
#pragma unroll
    for (int g = 0; g < 9; ++g) acc[g] = 0.f;
    for (int k0 = wid * 128; k0 < wid * 128 + 128; k0 += 16) {
      float wv[16];
#pragma unroll
      for (int j = 0; j < 16; ++j) wv[j] = w[(size_t)(k0 + j) * 6144];
#pragma unroll
      for (int j = 0; j < 16; ++j)
#pragma unroll
        for (int g = 0; g < 9; ++g) acc[g] += sc[g * 1024 + k0 + j] * wv[j];
    }
#pragma unroll
    for (int g = 0; g < 9; ++g) red[(wid * 9 + g) * 64 + lane] = acc[g];
    __syncthreads();
    for (int e = tid; e < 9 * 64; e += 512) {
      const int g = e >> 6, c = e & 63; float s = 0.f;
#pragma unroll
      for (int w8 = 0; w8 < 8; ++w8) s += red[(w8 * 9 + g) * 64 + c];
      mod[((size_t)l * 9 + g) * 6144 + n0 + c] = s + p.in[9][l * 6144 + n0 + c];
    }
    __syncthreads();
  }
}

DI void cvt_tile(const float* src, int lds_src, int nvalid, bf16_t* dst, int ldd, int k0, int n0, int mode, LAS float* buf) {
  const int tid = tid_opaque();
  {
    float v[8];
#pragma unroll
    for (int k = 0; k < 8; ++k) { const int e = tid + 512 * k, i = e >> 6, j = e & 63; v[k] = src[(size_t)i * lds_src + (j < nvalid ? j : nvalid - 1)]; }
#pragma unroll
    for (int k = 0; k < 8; ++k) { const int e = tid + 512 * k, i = e >> 6, j = e & 63; buf[i * 65 + j] = (j < nvalid) ? v[k] : 0.f; }
  }
  __syncthreads();
  for (int e = tid; e < 2048; e += 512) {
    const int j = e >> 5, i2 = (e & 31) * 2;
    if (j < nvalid) {
      int n = n0 + j, row = n;
      if (mode == 1) { const int up = n >= DFF ? 1 : 0; const int jj = n - up * DFF; row = 256 * (jj >> 7) + 128 * up + (jj & 127); }
      *(unsigned*)(dst + (size_t)row * ldd + k0 + i2) = pack2(buf[i2 * 65 + j], buf[(i2 + 1) * 65 + j]);
    }
  }
  __syncthreads();
}
DI void cvt_matrix(const float* W, int K, int N, bf16_t* dst, int mode, LAS float* buf, int vb, int nb) {
  const int nk = K / 64, nn = (N + 63) / 64;
  for (int t = vb; t < nk * nn; t += nb) {
    const int tk = t % nk, tn = t / nk, k0 = tk * 64, n0 = tn * 64;
    const int nvalid = (N - n0) < 64 ? (N - n0) : 64;
    cvt_tile(W + (size_t)k0 * N + n0, N, nvalid, dst, K, k0, n0, mode, buf);
  }
}

DI void cvt_layer(const Params& p, lptr lds, int l, int what, int vb, int nb) {
  const int tid = tid_opaque();
  const int i2 = l >> 1;
  LAS float* buf = (LAS float*)lds;
  if (what & 1) {
    if ((l & 1) == 0) {
      cvt_matrix(p.in[13] + (size_t)i2 * 1024 * EVEN_IN, 1024, EVEN_IN, (bf16_t*)(p.ws + WS_WIN), 0, buf, vb, nb);
      cvt_matrix(p.in[22] + (size_t)i2 * 1024 * 1024, 1024, 1024, (bf16_t*)(p.ws + WS_WOUT), 0, buf, vb, nb);
      for (int t = vb; t < 32; t += nb) {
        const int gate = t >> 4, dir = (t >> 3) & 1, n = t & 7;
        const float* srcp = (gate ? p.in[18] : p.in[16]) + ((size_t)(i2 * 2 + dir) * 8 + n) * 4096;
        cvt_tile(srcp, 64, 64, (bf16_t*)(p.ws + WS_RGW) + ((size_t)(dir * 2 + gate) * 8 + n) * 4096, 64, 0, 0, 0, buf);
      }
    } else {
      cvt_matrix(p.in[23] + (size_t)i2 * 1024 * 4128, 1024, 4128, (bf16_t*)(p.ws + WS_WIN), 0, buf, vb, nb);
      cvt_matrix(p.in[28] + (size_t)i2 * 1024 * 1024, 1024, 1024, (bf16_t*)(p.ws + WS_WOUT), 0, buf, vb, nb);
      u32x4* z = (u32x4*)((bf16_t*)(p.ws + WS_WIN) + (size_t)4128 * 1024);
      for (int e = vb * 512 + tid; e < 224 * 1024 / 8; e += nb * 512) z[e] = (u32x4){0u, 0u, 0u, 0u};
    }
  }
  if (what & 2) cvt_matrix(p.in[29] + (size_t)l * 1024 * 5632, 1024, 5632, (bf16_t*)(p.ws + WS_WGU), 1, buf, vb, nb);
  if (what & 4) cvt_matrix(p.in[30] + (size_t)l * DFF * 1024, DFF, 1024, (bf16_t*)(p.ws + WS_WDN), 0, buf, vb, nb);
}

DI void norm_core(const Params& p, int l, int mode, bool first, int row_lo, int row_hi, int vb, int nb) {
  const int tid = tid_opaque(), wid = tid >> 6, lane = tid & 63;
  const float* mod = (const float*)(p.ws + WS_MOD);
  bf16_t* h = (bf16_t*)(p.ws + WS_H);
  const float* gn = mode == 2 ? p.in[12] : (mode ? p.in[11] : p.in[10]) + l * 1024;
  f32x4 ggv[4];
#pragma unroll
  for (int i = 0; i < 4; ++i) ggv[i] = *(const f32x4*)(gn + lane * 4 + 256 * i);
  const int nchunk = (row_hi - row_lo + 5) / 6;
  for (int c = vb * 8 + wid; c < nchunk; c += nb * 8) {
    const int r0 = row_lo + 6 * c;
    f32x4 v[6][4]; float ss[6];
#pragma unroll
    for (int q = 0; q < 6; ++q) {
      const int row = r0 + q < row_hi ? r0 + q : r0;
      const float* xs = first ? (row < M_P ? p.in[0] + (size_t)row * 1024 : p.in[1] + (size_t)(row - M_P) * 1024) : p.out + (size_t)row * 1024;
#pragma unroll
      for (int i = 0; i < 4; ++i) v[q][i] = *(const f32x4*)(xs + lane * 4 + 256 * i);
    }
    int gcur = row_group(r0);
    f32x4 shv[4], scv[4];
    if (mode != 2) {
      const float* md = mod + ((size_t)l * 9 + gcur) * 6144 + (mode ? 3072 : 0);
#pragma unroll
      for (int i = 0; i < 4; ++i) { shv[i] = *(const f32x4*)(md + lane * 4 + 256 * i); scv[i] = *(const f32x4*)(md + 1024 + lane * 4 + 256 * i); }
    }
#pragma unroll
    for (int q = 0; q < 6; ++q) {
      float s = 0.f;
#pragma unroll
      for (int i = 0; i < 4; ++i) s += v[q][i][0] * v[q][i][0] + v[q][i][1] * v[q][i][1] + v[q][i][2] * v[q][i][2] + v[q][i][3] * v[q][i][3];
      ss[q] = wave_sum(s);
    }
#pragma unroll
    for (int q = 0; q < 6; ++q) {
      const int row = r0 + q;
      if (row < row_hi) {
        if (mode != 2 && row_group(row) != gcur) {
          gcur = row_group(row);
          const float* md = mod + ((size_t)l * 9 + gcur) * 6144 + (mode ? 3072 : 0);
#pragma unroll
          for (int i = 0; i < 4; ++i) { shv[i] = *(const f32x4*)(md + lane * 4 + 256 * i); scv[i] = *(const f32x4*)(md + 1024 + lane * 4 + 256 * i); }
        }
        const float rstd = rsqrtf(ss[q] * (1.f / 1024.f) + 1e-6f);
#pragma unroll
        for (int i = 0; i < 4; ++i) {
          const int cc = lane * 4 + 256 * i;
          f32x4 y;
          if (mode == 2) {
#pragma unroll
            for (int j = 0; j < 4; ++j) y[j] = v[q][i][j] * rstd * ggv[i][j];
            *(f32x4*)(p.out + (size_t)row * 1024 + cc) = y;
          } else {
#pragma unroll
            for (int j = 0; j < 4; ++j) y[j] = v[q][i][j] * rstd * ggv[i][j] * (1.f + scv[i][j]) + shv[i][j];
            *(u32x2*)(h + (size_t)row * 1024 + cc) = (u32x2){pack2(y[0], y[1]), pack2(y[2], y[3])};
          }
        }
      }
    }
    if (first) {
#pragma unroll
      for (int q = 0; q < 6; ++q) {
        const int row = r0 + q;
        if (row < row_hi) {
#pragma unroll
          for (int i = 0; i < 4; ++i) *(f32x4*)(p.out + (size_t)row * 1024 + lane * 4 + 256 * i) = v[q][i];
        }
      }
    }
  }
}

DI void phase_norm(const Params& p, lptr lds, int l, int which) {
  const int tid = tid_opaque(), wid = tid >> 6, lane = tid & 63;
  const int i2 = l >> 1;
  if (which == 0) { if (l == 0) cvt_layer(p, lds, 0, 7, bid_opaque(), gridDim.x); else cvt_layer(p, lds, l, gridDim.x == 256 ? 4 : 7, bid_opaque(), gridDim.x); }
  norm_core(p, l, which, l == 0 && which == 0, 0, M_TOT, bid_opaque(), gridDim.x);
}

DI void phase_final(const Params& p) {
  const int tid = tid_opaque(), wid = tid >> 6, lane = tid & 63;
  const float* gn = p.in[12];
  const int rstride = gridDim.x * 8;
  for (int row0 = bid_opaque() * 8 + wid; row0 < M_TOT; row0 += 3 * rstride) {
    f32x4 v[3][4]; float ss[3];
#pragma unroll
    for (int q = 0; q < 3; ++q) {
      const int row = row0 + q * rstride < M_TOT ? row0 + q * rstride : row0;
      const float* xs = p.out + (size_t)row * 1024;
#pragma unroll
      for (int i = 0; i < 4; ++i) v[q][i] = *(const f32x4*)(xs + lane * 4 + 256 * i);
    }
#pragma unroll
    for (int q = 0; q < 3; ++q) {
      float s = 0.f;
#pragma unroll
      for (int i = 0; i < 4; ++i) s += v[q][i][0] * v[q][i][0] + v[q][i][1] * v[q][i][1] + v[q][i][2] * v[q][i][2] + v[q][i][3] * v[q][i][3];
      ss[q] = wave_sum(s);
    }
#pragma unroll
    for (int q = 0; q < 3; ++q) {
      const int row = row0 + q * rstride;
      if (row < M_TOT) {
        const float rstd = rsqrtf(ss[q] * (1.f / 1024.f) + 1e-6f);
#pragma unroll
        for (int i = 0; i < 4; ++i) {
          const int c = lane * 4 + 256 * i;
          const f32x4 gg = *(const f32x4*)(gn + c);
          f32x4 y;
#pragma unroll
          for (int j = 0; j < 4; ++j) y[j] = v[q][i][j] * rstd * gg[j];
          *(f32x4*)(p.out + (size_t)row * 1024 + c) = y;
        }
      }
    }
  }
}

namespace pg8 {
constexpr int BM = 256, BK = 64, HALF = 128, HTB = HALF * BK * 2, STAGE_BYTES = 8 * HTB, NXCD = 8, WGM = 8;
DI int lds_byte(int r, int c) { const int st = (r >> 4) * 2 + (c >> 5), rr = r & 15, cc = c & 31, ob = rr * 64 + cc * 2; return st * 1024 + (ob ^ (((ob >> 9) & 1) << 5)); }
DI void stage_rc(int b, int& R, int& C) { const int st = b / 1024, sb = b % 1024, swz = sb ^ (((sb >> 9) & 1) << 5); R = (st >> 1) * 16 + swz / 64; C = (st & 1) * 32 + (swz % 64) / 2; }
DI int perm32(int rho) { const int n = rho >> 4, i = rho & 15; return 8 * (i >> 2) + 4 * n + (i & 3); }
struct Unit { int pm, pn; };
struct Gemm { const bf16_t* A; const bf16_t* Bt; int M, N, K; };
struct StaticOrder {
  int nM, nN, nwg, G, c;
  DI void init(int M, int N, int G_, int c_) { nM = M / BM; nN = N / BM; nwg = nM * nN; G = G_; c = c_; }
  DI bool next(int i, Unit& u) const {
    const long L = (long)i * G + c; if (L >= nwg) return false;
    int wgid = (int)L; { const int q = nwg / NXCD, r = nwg % NXCD, xcd = wgid % NXCD, off = wgid / NXCD; wgid = (xcd < r ? xcd * (q + 1) : r * (q + 1) + (xcd - r) * q) + off; }
    const int nig = WGM * nN, gid = wgid / nig, fm = gid * WGM, gsz = (nM - fm) < WGM ? (nM - fm) : WGM;
    u.pm = fm + ((wgid % nig) % gsz); u.pn = (wgid % nig) / gsz; return true;
  }
};
DI unsigned cvt_pk_bf16(float lo, float hi) { unsigned r; asm volatile("v_cvt_pk_bf16_f32 %0, %1, %2" : "=v"(r) : "v"(lo), "v"(hi)); return r; }

template <class Epi>
DI void gemm_phase(lptr lds, const Gemm g, const StaticOrder& S, const Epi& E) {
  const int tid = tid_opaque(), wid = __builtin_amdgcn_readfirstlane(tid >> 6), lane = tid & 63, wr = wid >> 2, wc = wid & 3, fr = lane & 15, fq = lane >> 4;
  const int K = g.K, nt = K / BK;
  unsigned voffA[2], voffB[2];
#pragma unroll
  for (int i = 0; i < 2; ++i) { int R, C; stage_rc(tid * 16 + i * 8192, R, C); const int Rb = Epi::PERM ? ((R & ~31) + perm32(R & 31)) : R;
    voffA[i] = (unsigned)(R * K + C) * 2u; voffB[i] = (unsigned)(Rb * K + C) * 2u; }
  const size_t kstep = (size_t)(BK * 2);
  const size_t hstep = (size_t)HALF * K * 2;
  const size_t tstep = 2 * hstep;
  const unsigned ldsw = (unsigned)wid * 1024u;
  const int aoff = lds_byte(wr * 64 + fr, fq * 8), boff = lds_byte(wc * 32 + fr, fq * 8);
#define PG8_SA(b, h) (((b) * 2 + (h)) * HTB)
#define PG8_SB(b, h) ((4 + (b) * 2 + (h)) * HTB)
#define PG8_STAGE(bufoff, gbase, voff) do { _Pragma("unroll") for (int _i = 0; _i < 2; ++_i) \
    __builtin_amdgcn_global_load_lds((const unsigned*)((const char*)(gbase) + (voff)[_i]), (LAS unsigned*)(lds + (bufoff) + ldsw + _i * 8192), 16, 0, 0); } while (0)
#define PG8_LDA(dst, b, h) do { _Pragma("unroll") for (int m = 0; m < 4; ++m) _Pragma("unroll") for (int k = 0; k < 2; ++k) dst[m][k] = *(const LAS bf16x8*)(lds + PG8_SA(b, h) + aoff + m * 2048 + k * 1024); } while (0)
#define PG8_LDB(dst, b, h) do { _Pragma("unroll") for (int n = 0; n < 2; ++n) _Pragma("unroll") for (int k = 0; k < 2; ++k) dst[n][k] = *(const LAS bf16x8*)(lds + PG8_SB(b, h) + boff + n * 2048 + k * 1024); } while (0)
#define PG8_MMA(ai, bj, At, Bt) do { __builtin_amdgcn_s_setprio(1); _Pragma("unroll") for (int m = 0; m < 4; ++m) _Pragma("unroll") for (int n = 0; n < 2; ++n) _Pragma("unroll") for (int k = 0; k < 2; ++k) \
    acc[ai][bj][m][n] = __builtin_amdgcn_mfma_f32_16x16x32_bf16(Bt[n][k], At[m][k], acc[ai][bj][m][n], 0, 0, 0); __builtin_amdgcn_s_setprio(0); } while (0)
#define PG8_WAIT_V(n) asm volatile("s_waitcnt vmcnt(" #n ")" ::: "memory")
#define PG8_WAIT_L(n) asm volatile("s_waitcnt lgkmcnt(" #n ")" ::: "memory")
#define PG8_BAR __builtin_amdgcn_s_barrier()
#define PG8_SCHED __builtin_amdgcn_sched_barrier(0)
  Unit cur, nxt; int ui = 0;
  if (!S.next(0, cur)) return;
  f32x4 acc[2][2][4][2];
#pragma unroll
  for (int a = 0; a < 2; ++a)
#pragma unroll
    for (int b = 0; b < 2; ++b)
#pragma unroll
      for (int m = 0; m < 4; ++m)
#pragma unroll
        for (int n = 0; n < 2; ++n) acc[a][b][m][n] = (f32x4){0.f, 0.f, 0.f, 0.f};
  bf16x8 At[4][2], B0[2][2], B1[2][2];
  const char* cA = (const char*)g.A + (size_t)cur.pm * tstep; const char* cB = (const char*)g.Bt + (size_t)cur.pn * tstep;
  PG8_STAGE(PG8_SB(0, 0), cB, voffB); PG8_STAGE(PG8_SA(0, 0), cA, voffA); PG8_STAGE(PG8_SB(0, 1), cB + hstep, voffB); PG8_STAGE(PG8_SA(0, 1), cA + hstep, voffA);
  if (wr == 1) PG8_BAR;
  PG8_WAIT_V(4); PG8_BAR;
  PG8_STAGE(PG8_SB(1, 0), cB + kstep, voffB); PG8_STAGE(PG8_SA(1, 0), cA + kstep, voffA); PG8_STAGE(PG8_SB(1, 1), cB + hstep + kstep, voffB);
  PG8_WAIT_V(6); PG8_BAR;
  for (;;) {
    const bool has_next = S.next(ui + 1, nxt);
    const char* nA = has_next ? (const char*)g.A + (size_t)nxt.pm * tstep : cA; const char* nB = has_next ? (const char*)g.Bt + (size_t)nxt.pn * tstep : cB;
    for (int t = 0; t < nt; t += 2) {
      const bool last = (t == nt - 2);
      const char* a1 = cA + (size_t)(t + 1) * kstep;
      const char* a2 = last ? nA : cA + (size_t)(t + 2) * kstep; const char* b2 = last ? nB : cB + (size_t)(t + 2) * kstep;
      const char* a3 = a2 + kstep; const char* b3 = b2 + kstep;
      PG8_LDB(B0, 0, 0); PG8_SCHED; PG8_LDA(At, 0, 0); PG8_STAGE(PG8_SA(1, 1), a1 + hstep, voffA);
      PG8_WAIT_L(8); PG8_BAR; PG8_WAIT_L(0); PG8_MMA(0, 0, At, B0); PG8_BAR; PG8_SCHED;
      PG8_LDB(B1, 0, 1); PG8_STAGE(PG8_SB(0, 0), b2, voffB);
      PG8_BAR; PG8_WAIT_L(0); PG8_MMA(0, 1, At, B1); PG8_BAR;
      PG8_LDA(At, 0, 1); PG8_STAGE(PG8_SA(0, 0), a2, voffA);
      PG8_BAR; PG8_WAIT_L(0); PG8_MMA(1, 0, At, B0); PG8_BAR; PG8_SCHED;
      PG8_STAGE(PG8_SB(0, 1), b2 + hstep, voffB);
      PG8_WAIT_V(6); PG8_BAR; PG8_MMA(1, 1, At, B1); PG8_BAR;
      PG8_LDB(B0, 1, 0); PG8_SCHED; PG8_LDA(At, 1, 0); PG8_STAGE(PG8_SA(0, 1), a2 + hstep, voffA);
      PG8_WAIT_L(8); PG8_BAR; PG8_WAIT_L(0); PG8_MMA(0, 0, At, B0); PG8_BAR; PG8_SCHED;
      PG8_LDB(B1, 1, 1); PG8_STAGE(PG8_SB(1, 0), b3, voffB);
      PG8_BAR; PG8_WAIT_L(0); PG8_MMA(0, 1, At, B1); PG8_BAR;
      PG8_LDA(At, 1, 1); PG8_STAGE(PG8_SA(1, 0), a3, voffA);
      PG8_BAR; PG8_WAIT_L(0); PG8_MMA(1, 0, At, B0); PG8_BAR; PG8_SCHED;
      PG8_STAGE(PG8_SB(1, 1), b3 + hstep, voffB);
      PG8_WAIT_V(6); PG8_BAR; PG8_MMA(1, 1, At, B1); PG8_BAR;
    }
    E(acc, cur, wr, wc, fr, fq);
    if (!has_next) break;
#pragma unroll
    for (int a = 0; a < 2; ++a)
#pragma unroll
      for (int b = 0; b < 2; ++b)
#pragma unroll
        for (int m = 0; m < 4; ++m)
#pragma unroll
          for (int n = 0; n < 2; ++n) acc[a][b][m][n] = (f32x4){0.f, 0.f, 0.f, 0.f};
    cur = nxt; cA = nA; cB = nB; ++ui;
  }
  PG8_WAIT_V(0);
  if (wr == 0) PG8_BAR;
  PG8_BAR;
#undef PG8_SA
#undef PG8_SB
#undef PG8_STAGE
#undef PG8_LDA
#undef PG8_LDB
#undef PG8_MMA
#undef PG8_WAIT_V
#undef PG8_WAIT_L
#undef PG8_BAR
#undef PG8_SCHED
}

struct EpiIn {
  static constexpr bool PERM = true;
  bf16_t* P; int ldp; int odd; float* kout; float* vout; float* ab; bf16_t* halo;
  DI void operator()(const f32x4 (&acc)[2][2][4][2], const Unit& u, int wr, int wc, int fr, int fq) const {
    const int row0 = u.pm * BM + wr * 64 + fr;
    if (odd && u.pn == 16) {
      if (wc == 0) {
#pragma unroll
        for (int ai = 0; ai < 2; ++ai)
#pragma unroll
          for (int m = 0; m < 4; ++m) { const int r = row0 + ai * HALF + m * 16;
#pragma unroll
            for (int n = 0; n < 2; ++n) *(f32x4*)(ab + (size_t)r * 32 + 8 * fq + 4 * n) = acc[ai][0][m][n]; }
      }
      return;
    }
    const int col0 = u.pn * BM + wc * 32 + 8 * fq;
#pragma unroll
    for (int ai = 0; ai < 2; ++ai)
#pragma unroll
      for (int m = 0; m < 4; ++m) {
        const int r = row0 + ai * HALF + m * 16; bf16_t* rowp = P + (size_t)r * ldp + col0;
#pragma unroll
        for (int bj = 0; bj < 2; ++bj) {
          const f32x4 v0 = acc[ai][bj][m][0], v1 = acc[ai][bj][m][1];
          u32x4 w; w.x = cvt_pk_bf16(v0[0], v0[1]); w.y = cvt_pk_bf16(v0[2], v0[3]); w.z = cvt_pk_bf16(v1[0], v1[1]); w.w = cvt_pk_bf16(v1[2], v1[3]);
          *(u32x4*)(rowp + bj * HALF) = w;
          if (odd) {
            const int rc = m * 16 + fr, c = col0 + bj * HALF;
            if (c < 3072 && (rc == 0 || rc >= 62)) { const int slot = rc == 0 ? 0 : rc - 61; *(u32x4*)(halo + ((size_t)(r >> 6) * 3 + slot) * 3072 + c) = w; }
          } else if (u.pn == 6 && r < M_P) {
            float* dst = (bj ? vout : kout) + ((size_t)(r >> 8) * 512 + (r & 255)) * 128 + wc * 32 + 8 * fq;
            *(f32x4*)dst = v0; *(f32x4*)(dst + 4) = v1;
          }
        }
      }
  }
};
struct EpiRes {
  static constexpr bool PERM = false;
  float* x; const float* ga_base; int rbase;
  DI void operator()(const f32x4 (&acc)[2][2][4][2], const Unit& u, int wr, int wc, int fr, int fq) const {
    const int row0 = rbase + u.pm * BM + wr * 64 + fr, col0 = u.pn * BM + wc * 32 + 4 * fq;
    const float* ga = ga_base + (size_t)row_group(rbase + u.pm * BM) * 6144;
    f32x4 gv[2][2];
#pragma unroll
    for (int bj = 0; bj < 2; ++bj)
#pragma unroll
      for (int n = 0; n < 2; ++n) gv[bj][n] = *(const f32x4*)(ga + col0 + bj * HALF + n * 16);
#pragma unroll
    for (int ai = 0; ai < 2; ++ai) {
      f32x4 xv[4][2][2];
#pragma unroll
      for (int m = 0; m < 4; ++m) { const float* rowp = x + (size_t)(row0 + ai * HALF + m * 16) * 1024 + col0;
#pragma unroll
        for (int bj = 0; bj < 2; ++bj)
#pragma unroll
          for (int n = 0; n < 2; ++n) xv[m][bj][n] = *(const f32x4*)(rowp + bj * HALF + n * 16); }
#pragma unroll
      for (int m = 0; m < 4; ++m) { float* rowp = x + (size_t)(row0 + ai * HALF + m * 16) * 1024 + col0;
#pragma unroll
        for (int bj = 0; bj < 2; ++bj)
#pragma unroll
          for (int n = 0; n < 2; ++n) *(f32x4*)(rowp + bj * HALF + n * 16) = xv[m][bj][n] + gv[bj][n] * acc[ai][bj][m][n]; }
    }
  }
};
struct EpiGU {
  static constexpr bool PERM = true;
  bf16_t* act;
  DI void operator()(const f32x4 (&acc)[2][2][4][2], const Unit& u, int wr, int wc, int fr, int fq) const {
    const int row0 = u.pm * BM + wr * 64 + fr, col0 = u.pn * HALF + wc * 32 + 8 * fq;
#pragma unroll
    for (int ai = 0; ai < 2; ++ai)
#pragma unroll
      for (int m = 0; m < 4; ++m) {
        bf16_t* rowp = act + (size_t)(row0 + ai * HALF + m * 16) * DFF + col0;
        float o[8];
#pragma unroll
        for (int n = 0; n < 2; ++n)
#pragma unroll
          for (int j = 0; j < 4; ++j) { const float gt = acc[ai][0][m][n][j], up = acc[ai][1][m][n][j]; o[n * 4 + j] = siluf_(gt) * up; }
        u32x4 w; w.x = cvt_pk_bf16(o[0], o[1]); w.y = cvt_pk_bf16(o[2], o[3]); w.z = cvt_pk_bf16(o[4], o[5]); w.w = cvt_pk_bf16(o[6], o[7]);
        *(u32x4*)rowp = w;
      }
  }
};
}

template <class Epi> DI void run_gemm(lptr lds, const bf16_t* A, const bf16_t* Bt, int N, int K, const Epi& E) {
  pg8::Gemm g; g.A = A; g.Bt = Bt; g.M = M_TOT; g.N = N; g.K = K;
  pg8::StaticOrder S; S.init(M_TOT, N, (int)gridDim.x, (int)bid_opaque());
  pg8::gemm_phase<Epi>(lds, g, S, E);
}
template <class Epi> DI void run_gemm_sub(lptr lds, const bf16_t* A, const bf16_t* Bt, int mrows, int N, int K, const Epi& E, int vb, int nb) {
  pg8::Gemm g; g.A = A; g.Bt = Bt; g.M = mrows; g.N = N; g.K = K;
  pg8::StaticOrder S; S.init(mrows, N, nb, vb);
  pg8::gemm_phase<Epi>(lds, g, S, E);
}
DI void norm_rows(const Params& p, int l, int mode, int row_lo, int row_hi, int vb, int nb) { norm_core(p, l, mode, false, row_lo, row_hi, vb, nb); }

DI float gelu_tanh(float x) { const float u = 0.7978845608028654f * (x + 0.044715f * x * x * x); const float t = 1.f - 2.f * __builtin_amdgcn_rcpf(1.f + __expf(2.f * u)); return 0.5f * x * (1.f + t); }
DI void rg_phase(const Params& p, lptr lds, int l, int mode) {
  const int tid = tid_opaque(), wid = tid >> 6, lane = tid & 63;
  const int i2 = l >> 1, bid = bid_opaque(), G = gridDim.x;
  const int n = bid & 7;
  const bf16_t* P = (const bf16_t*)(p.ws + WS_P);
  bf16_t* Y = (bf16_t*)(p.ws + WS_H);
  float* carry = (float*)(p.ws + WS_CARRY);
  constexpr int SUB = 74752;
  LAS float* Pf = (LAS float*)(lds + 2 * SUB);
  const int ct = tid >> 3, c8 = (tid & 7) * 8, chc = n * 64 + c8;
  LAS float* cwl = (LAS float*)(lds + 2 * SUB + 8192);
  if (tid < 320) { const int j = tid >> 6, c = tid & 63; cwl[tid] = j < 4 ? p.in[14][((size_t)i2 * 4 + j) * 512 + n * 64 + c] : p.in[15][i2 * 512 + n * 64 + c]; }
  __syncthreads();
  const int gdir = wid >> 2, gdt = (wid >> 1) & 1, gt2 = wid & 1, r = lane & 31, hh = lane >> 5;
  bf16x8 wa[4], wx[4];
  {
    const bf16_t* rgw = (const bf16_t*)(p.ws + WS_RGW);
    const bf16_t* wap = rgw + ((size_t)(gdir * 2 + 0) * 8 + n) * 4096 + (gdt * 32 + r) * 64 + 8 * hh;
    const bf16_t* wxp = rgw + ((size_t)(gdir * 2 + 1) * 8 + n) * 4096 + (gdt * 32 + r) * 64 + 8 * hh;
#pragma unroll
    for (int s = 0; s < 4; ++s) { wa[s] = *(const bf16x8*)(wap + 16 * s); wx[s] = *(const bf16x8*)(wxp + 16 * s); }
  }
  const int gd = gdt * 32 + r, gpi = (i2 * 2 + gdir) * 512 + n * 64 + gd;
  const float ba = p.in[17][gpi], bx = p.in[19][gpi], sp8 = -8.f * softplusf_(-p.in[20][gpi]);
  u32x4 praw[2][4], pgr[2];
  pgr[0] = pgr[1] = (u32x4){0u, 0u, 0u, 0u};
#define RG_PREFETCH(s_, item_) do { const int tt_ = (item_) >> 3; const int row0_ = tt_ * 64; \
    const int ti_ = tt_ < 64 ? (tt_ & 3) : ((tt_ - 64) & 63); const int nt_ = tt_ < 64 ? 4 : 64; \
    _Pragma("unroll") for (int j_ = 0; j_ < 4; ++j_) { const int tl_ = ti_ * 64 + ct + j_ - 2; const bool ok_ = tl_ >= 0 && tl_ < nt_ * 64; \
      const u32x4 v_ = *(const u32x4*)(P + (size_t)(row0_ + (ok_ ? ct + j_ - 2 : ct)) * EVEN_IN + chc); praw[s_][j_] = ok_ ? v_ : (u32x4){0u, 0u, 0u, 0u}; } \
    if (mode == 1) pgr[s_] = *(const u32x4*)(P + (size_t)(row0_ + ct) * EVEN_IN + 512 + chc); } while (0)
  if (bid < 4608) RG_PREFETCH(0, bid);
  if (bid + G < 4608) RG_PREFETCH(1, bid + G);
  for (int item0 = bid; item0 < 4608; item0 += 2 * G) {
    const int nsub = item0 + G < 4608 ? 2 : 1;
    u32x4 gr_cur[2];
#pragma unroll
    for (int s = 0; s < 2; ++s) {
      if (s < nsub) {
        const int tt = (item0 + s * G) >> 3;
        const int ti = tt < 64 ? (tt & 3) : ((tt - 64) & 63), ntile = tt < 64 ? 4 : 64;
        LAS bf16_t* Xc = (LAS bf16_t*)(lds + s * SUB);
        float ca[16], cbv[16];
        if (mode == 1) {
          const int q4 = tid >> 7, dir = (tid >> 6) & 1, d = tid & 63, ch = n * 64 + d, tbase = tt - ti;
#pragma unroll
          for (int jj = 0; jj < 16; ++jj) {
            const int j = dir ? (16 * q4 + 15 - jj) : (16 * q4 + jj);
            const bool valid = dir ? (j > ti && j < ntile) : (j < ti);
            const int jc = valid ? j : ti;
            const size_t o = ((size_t)((tbase + jc) * 2 + dir) * 2) * 512 + ch;
            const float va = carry[o], vb = carry[o + 512];
            ca[jj] = valid ? va : 1.f; cbv[jj] = valid ? vb : 0.f;
          }
        }
        {
          const f32x4 b0 = *(const LAS f32x4*)(cwl + 256 + c8), b1 = *(const LAS f32x4*)(cwl + 256 + c8 + 4);
          float a[8] = {b0[0], b0[1], b0[2], b0[3], b1[0], b1[1], b1[2], b1[3]};
#pragma unroll
          for (int j = 0; j < 4; ++j) {
            const u32x4 raw = praw[s][j];
            const f32x4 w0 = *(const LAS f32x4*)(cwl + j * 64 + c8), w1 = *(const LAS f32x4*)(cwl + j * 64 + c8 + 4);
            a[0] += w0[0] * lo2f(raw.x); a[1] += w0[1] * hi2f(raw.x); a[2] += w0[2] * lo2f(raw.y); a[3] += w0[3] * hi2f(raw.y);
            a[4] += w1[0] * lo2f(raw.z); a[5] += w1[1] * hi2f(raw.z); a[6] += w1[2] * lo2f(raw.w); a[7] += w1[3] * hi2f(raw.w);
          }
          *(LAS u32x4*)(Xc + ct * 72 + c8) = (u32x4){pack2(a[0], a[1]), pack2(a[2], a[3]), pack2(a[4], a[5]), pack2(a[6], a[7])};
        }
        gr_cur[s] = pgr[s];
        if (mode == 1) {
          const int q4 = tid >> 7, dir = (tid >> 6) & 1, d = tid & 63;
          float A = 1.f, B = 0.f;
#pragma unroll
          for (int jj = 0; jj < 16; ++jj) { B = ca[jj] * B + cbv[jj]; A = ca[jj] * A; }
          Pf[s * 1024 + (q4 * 2 + dir) * 64 + d] = A; Pf[s * 1024 + 512 + (q4 * 2 + dir) * 64 + d] = B;
        }
      }
      __builtin_amdgcn_sched_barrier(0);
    }
    __syncthreads();
#pragma unroll 1
    for (int s = 0; s < 2; ++s) {
      if (s < nsub) {
        LAS bf16_t* Xc = (LAS bf16_t*)(lds + s * SUB);
        LAS float* Aa = (LAS float*)(lds + s * SUB + 9216); LAS float* Bb = (LAS float*)(lds + s * SUB + 41984);
        f32x16 ga = zero16(), gx = zero16();
#pragma unroll
        for (int ks = 0; ks < 4; ++ks) {
          const bf16x8 a = *(const LAS bf16x8*)(Xc + (gt2 * 32 + r) * 72 + 16 * ks + 8 * hh);
          ga = MFMA32(a, wa[ks], ga); gx = MFMA32(a, wx[ks], gx);
        }
        float xcv[16];
#pragma unroll
        for (int ii = 0; ii < 16; ++ii) xcv[ii] = bf2f(Xc[(gt2 * 32 + crow(ii, hh)) * 72 + gd]);
#pragma unroll
        for (int ii = 0; ii < 16; ++ii) {
          const int t = gt2 * 32 + crow(ii, hh);
          const float rr = sigmoidf_(ga[ii] + ba), iv = sigmoidf_(gx[ii] + bx);
          const float la = rr * sp8, a = __expf(la), x2 = 2.f * la;
          const float om = x2 > -0.25f ? -x2 * (1.f + x2 * (0.5f + x2 * (0.16666667f + x2 * (0.041666668f + x2 * 0.0083333338f)))) : 1.f - __expf(x2);
          const float bb = __builtin_amdgcn_sqrtf(fmaxf(om, 0.f)) * (iv * xcv[ii]);
          Aa[(gdir * 64 + t) * 64 + gd] = a; Bb[(gdir * 64 + t) * 64 + gd] = bb;
        }
      }
    }
    __syncthreads();
    if (item0 + 2 * G < 4608) RG_PREFETCH(0, item0 + 2 * G);
    if (item0 + 3 * G < 4608) RG_PREFETCH(1, item0 + 3 * G);
    if (tid < 128 * nsub) {
      const int s = tid >> 7, dir = (tid >> 6) & 1, d = tid & 63, ch = n * 64 + d;
      const int tt = (item0 + s * G) >> 3;
      const int ti = tt < 64 ? (tt & 3) : ((tt - 64) & 63), ntile = tt < 64 ? 4 : 64;
      const int seq = tt < 64 ? (tt >> 2) : 16 + ((tt - 64) >> 6);
      LAS float* Aa = (LAS float*)(lds + s * SUB + 9216); LAS float* Bb = (LAS float*)(lds + s * SUB + 41984);
      if (mode == 0) {
        float A = 1.f, B = 0.f;
#pragma unroll 1
        for (int s0 = 0; s0 < 64; s0 += 8) {
          float av[8], bv[8];
#pragma unroll
          for (int k = 0; k < 8; ++k) { const int t = dir ? 63 - (s0 + k) : s0 + k; av[k] = Aa[(dir * 64 + t) * 64 + d]; bv[k] = Bb[(dir * 64 + t) * 64 + d]; }
#pragma unroll
          for (int k = 0; k < 8; ++k) { A *= av[k]; B = av[k] * B + bv[k]; }
        }
        carry[((size_t)(tt * 2 + dir) * 2 + 0) * 512 + ch] = A; carry[((size_t)(tt * 2 + dir) * 2 + 1) * 512 + ch] = B;
      } else {
        float h = (tt < 64) ? 0.f : p.in[5][(((size_t)(seq - 16) * 2 + i2) * 2 + dir) * 512 + ch];
#pragma unroll
        for (int qq = 0; qq < 4; ++qq) { const int q4 = dir ? 3 - qq : qq; h = Pf[s * 1024 + (q4 * 2 + dir) * 64 + d] * h + Pf[s * 1024 + 512 + (q4 * 2 + dir) * 64 + d]; }
#pragma unroll 1
        for (int s0 = 0; s0 < 64; s0 += 8) {
          float av[8], bv[8];
#pragma unroll
          for (int k = 0; k < 8; ++k) { const int t = dir ? 63 - (s0 + k) : s0 + k; av[k] = Aa[(dir * 64 + t) * 64 + d]; bv[k] = Bb[(dir * 64 + t) * 64 + d]; }
#pragma unroll
          for (int k = 0; k < 8; ++k) { const int t = dir ? 63 - (s0 + k) : s0 + k; h = av[k] * h + bv[k]; Aa[(dir * 64 + t) * 64 + d] = h; }
        }
        if (tt < 64 && ((dir == 0 && ti == ntile - 1) || (dir == 1 && ti == 0))) p.out[OFF_RG + (((size_t)seq * 2 + i2) * 2 + dir) * 512 + ch] = h;
      }
    }
    if (mode == 1) {
      __syncthreads();
#pragma unroll
      for (int s = 0; s < 2; ++s) {
        if (s < nsub) {
          const int row0 = ((item0 + s * G) >> 3) * 64;
          const LAS float* Hf = (const LAS float*)(lds + s * SUB + 9216); const LAS float* Hb = Hf + 4096;
          const u32x4 raw = gr_cur[s];
          float gr[8] = {lo2f(raw.x), hi2f(raw.x), lo2f(raw.y), hi2f(raw.y), lo2f(raw.z), hi2f(raw.z), lo2f(raw.w), hi2f(raw.w)};
          float y[8];
#pragma unroll
          for (int e = 0; e < 8; ++e) y[e] = (Hf[ct * 64 + c8 + e] + Hb[ct * 64 + c8 + e]) * gelu_tanh(gr[e]);
          *(u32x4*)(Y + (size_t)(row0 + ct) * 1024 + n * 64 + c8) = (u32x4){pack2(y[0], y[1]), pack2(y[2], y[3]), pack2(y[4], y[5]), pack2(y[6], y[7])};
        }
      }
    }
    __syncthreads();
  }
#undef RG_PREFETCH
}

DI void att_item(const Params& p, lptr lds, int l, int item) {
  const int tid = tid_opaque(), wid = tid >> 6, lane = tid & 63, q = lane & 31, hh = lane >> 5;
  const int i2 = l >> 1;
  const bool samp = item < 1024;
  int b, kvh, qt, rowbase;
  if (samp) { b = item >> 7; kvh = (item >> 6) & 1; qt = item & 63; rowbase = M_P + b * 4096; }
  else { const int j = item - 1024; b = j >> 3; kvh = (j >> 2) & 1; qt = j & 3; rowbase = b * 256; }
  const bf16_t* P = (const bf16_t*)(p.ws + WS_P);
  bf16_t* Y = (bf16_t*)(p.ws + WS_H);
  const float* rc = (const float*)(p.ws + WS_ROPE); const float* rs = rc + 4096 * 32;
  LAS bf16_t* Ks = (LAS bf16_t*)lds; LAS bf16_t* Vt = (LAS bf16_t*)(lds + 9216);
  const int head = kvh * 4 + (wid >> 1);
  const int qpos = qt * 64 + 32 * (wid & 1) + q;
  bf16x8 Qf[4];
  {
    const bf16_t* qp = P + (size_t)(rowbase + qpos) * EVEN_IN + 1024 + head * 64 + 8 * hh;
    float qv[4][8];
#pragma unroll
    for (int s = 0; s < 4; ++s) { const u32x4 raw = *(const u32x4*)(qp + 16 * s);
      qv[s][0] = lo2f(raw.x); qv[s][1] = hi2f(raw.x); qv[s][2] = lo2f(raw.y); qv[s][3] = hi2f(raw.y); qv[s][4] = lo2f(raw.z); qv[s][5] = hi2f(raw.z); qv[s][6] = lo2f(raw.w); qv[s][7] = hi2f(raw.w); }
    if (samp) {
#pragma unroll
      for (int pr = 0; pr < 2; ++pr)
#pragma unroll
        for (int j = 0; j < 8; ++j) { const int f = 16 * pr + 8 * hh + j; const float c = rc[qpos * 32 + f], sn = rs[qpos * 32 + f];
          const float x1 = qv[2 * pr][j], x2 = qv[2 * pr + 1][j]; qv[2 * pr][j] = x1 * c - x2 * sn; qv[2 * pr + 1][j] = x1 * sn + x2 * c; }
    }
#pragma unroll
    for (int s = 0; s < 4; ++s) { const float qs = 0.125f * 1.44269504088896341f;
      u32x4 w; w.x = pack2(qv[s][0] * qs, qv[s][1] * qs); w.y = pack2(qv[s][2] * qs, qv[s][3] * qs); w.z = pack2(qv[s][4] * qs, qv[s][5] * qs); w.w = pack2(qv[s][6] * qs, qv[s][7] * qs); Qf[s] = __builtin_bit_cast(bf16x8, w); }
  }
  float m_run = p.in[21][i2 * 8 + head] * 1.44269504088896341f, l_run = hh == 0 ? 1.f : 0.f;
  f32x16 o0 = zero16(), o1 = zero16();
  const int nctx = samp ? 8 : 0;
  int w0, w1; if (samp) { w0 = qt - 2 < 0 ? 0 : qt - 2; w1 = qt + 2 > 63 ? 63 : qt + 2; } else { w0 = 0; w1 = 3; }
  const int ntiles = nctx + (w1 - w0 + 1);
  const bool isK = tid < 256;
  const int skey = (tid & 255) >> 2, spc = tid & 3;
  const int sd0 = isK ? (spc & 1) * 8 + (spc >> 1) * 32 : spc * 16;
  const int so1 = isK ? 16 : 8;
  f32x4 pc4[4]; u32x4 pw2[2]; f32x4 prc[4];
#define ATT_PREFETCH(kt_) do { const bool ctx_ = (kt_) < nctx; const int wt_ = w0 + ((kt_) - nctx); \
    if (ctx_) { const float* sp_ = (isK ? p.in[3] : p.in[4]) + (((size_t)(b * 2 + i2) * 512 + (kt_) * 64 + skey) * 2 + kvh) * 64 + sd0; \
      pc4[0] = *(const f32x4*)sp_; pc4[1] = *(const f32x4*)(sp_ + 4); pc4[2] = *(const f32x4*)(sp_ + so1); pc4[3] = *(const f32x4*)(sp_ + so1 + 4); } \
    else { const bf16_t* sp_ = P + (size_t)(rowbase + wt_ * 64 + skey) * EVEN_IN + (isK ? 1536 : 1664) + kvh * 64 + sd0; \
      pw2[0] = *(const u32x4*)sp_; pw2[1] = *(const u32x4*)(sp_ + so1); \
      if (samp && isK) { const int kpos_ = wt_ * 64 + skey, fb_ = (sd0 & 8) + (sd0 >= 32 ? 16 : 0); \
        prc[0] = *(const f32x4*)(rc + kpos_ * 32 + fb_); prc[1] = *(const f32x4*)(rc + kpos_ * 32 + fb_ + 4); \
        prc[2] = *(const f32x4*)(rs + kpos_ * 32 + fb_); prc[3] = *(const f32x4*)(rs + kpos_ * 32 + fb_ + 4); } } } while (0)
  ATT_PREFETCH(0);
  for (int kt = 0; kt < ntiles; ++kt) {
    const bool ctx = kt < nctx; const int wt = w0 + (kt - nctx);
    __syncthreads();
    {
      float x1[8], x2[8];
      if (ctx) {
#pragma unroll
        for (int e = 0; e < 4; ++e) { x1[e] = pc4[0][e]; x1[4 + e] = pc4[1][e]; x2[e] = pc4[2][e]; x2[4 + e] = pc4[3][e]; }
      } else {
        const u32x4 r1 = pw2[0], r2 = pw2[1];
        x1[0] = lo2f(r1.x); x1[1] = hi2f(r1.x); x1[2] = lo2f(r1.y); x1[3] = hi2f(r1.y); x1[4] = lo2f(r1.z); x1[5] = hi2f(r1.z); x1[6] = lo2f(r1.w); x1[7] = hi2f(r1.w);
        x2[0] = lo2f(r2.x); x2[1] = hi2f(r2.x); x2[2] = lo2f(r2.y); x2[3] = hi2f(r2.y); x2[4] = lo2f(r2.z); x2[5] = hi2f(r2.z); x2[6] = lo2f(r2.w); x2[7] = hi2f(r2.w);
        if (samp && isK) {
#pragma unroll
          for (int j = 0; j < 8; ++j) { const float c = prc[j >> 2][j & 3], sn = prc[2 + (j >> 2)][j & 3]; const float a = x1[j], bb = x2[j]; x1[j] = a * c - bb * sn; x2[j] = a * sn + bb * c; }
        }
      }
      if (isK) {
        *(LAS u32x4*)(Ks + skey * 72 + sd0) = (u32x4){pack2(x1[0], x1[1]), pack2(x1[2], x1[3]), pack2(x1[4], x1[5]), pack2(x1[6], x1[7])};
        *(LAS u32x4*)(Ks + skey * 72 + sd0 + 16) = (u32x4){pack2(x2[0], x2[1]), pack2(x2[2], x2[3]), pack2(x2[4], x2[5]), pack2(x2[6], x2[7])};
      } else {
#pragma unroll
        for (int e = 0; e < 8; ++e) { Vt[(sd0 + e) * 72 + skey] = f2bf(x1[e]); Vt[(sd0 + 8 + e) * 72 + skey] = f2bf(x2[e]); }
      }
    }
    __syncthreads();
    if (kt + 1 < ntiles) ATT_PREFETCH(kt + 1);
#pragma unroll
    for (int ks = 0; ks < 2; ++ks) {
      f32x16 sacc = zero16();
#pragma unroll
      for (int s = 0; s < 4; ++s) { const bf16x8 a = *(const LAS bf16x8*)(Ks + (32 * ks + q) * 72 + 16 * s + 8 * hh); sacc = MFMA32(a, Qf[s], sacc); }
      if (!ctx && samp) {
        const int kbase = wt * 64 + 32 * ks;
#pragma unroll
        for (int ii = 0; ii < 16; ++ii) { const int dl = qpos - (kbase + crow(ii, hh)); if (dl > 128 || dl < -128) sacc[ii] = -1e30f; }
      }
      float mx = sacc[0];
#pragma unroll
      for (int ii = 1; ii < 16; ++ii) mx = fmaxf(mx, sacc[ii]);
      mx = fmaxf(mx, __shfl_xor(mx, 32));
      if (__any(mx > m_run)) {
        const float m_new = fmaxf(m_run, mx), alpha = __builtin_amdgcn_exp2f(m_run - m_new); m_run = m_new;
        l_run *= alpha;
#pragma unroll
        for (int ii = 0; ii < 16; ++ii) { o0[ii] *= alpha; o1[ii] *= alpha; }
      }
      float pv[16], ps = 0.f;
#pragma unroll
      for (int ii = 0; ii < 16; ++ii) { pv[ii] = __builtin_amdgcn_exp2f(sacc[ii] - m_run); ps += pv[ii]; }
      l_run += ps;
#pragma unroll
      for (int s2 = 0; s2 < 2; ++s2) {
        u32x4 pw; pw.x = pack2(pv[8 * s2], pv[8 * s2 + 1]); pw.y = pack2(pv[8 * s2 + 2], pv[8 * s2 + 3]); pw.z = pack2(pv[8 * s2 + 4], pv[8 * s2 + 5]); pw.w = pack2(pv[8 * s2 + 6], pv[8 * s2 + 7]);
        const bf16x8 bfrag = __builtin_bit_cast(bf16x8, pw);
        {
          const LAS bf16_t* vp = Vt + q * 72 + 32 * ks + 16 * s2 + 4 * hh;
          const u32x2 lo = *(const LAS u32x2*)vp, hi = *(const LAS u32x2*)(vp + 8);
          o0 = MFMA32(__builtin_bit_cast(bf16x8, ((u32x4){lo.x, lo.y, hi.x, hi.y})), bfrag, o0);
        }
        {
          const LAS bf16_t* vp = Vt + (32 + q) * 72 + 32 * ks + 16 * s2 + 4 * hh;
          const u32x2 lo = *(const LAS u32x2*)vp, hi = *(const LAS u32x2*)(vp + 8);
          o1 = MFMA32(__builtin_bit_cast(bf16x8, ((u32x4){lo.x, lo.y, hi.x, hi.y})), bfrag, o1);
        }
      }
    }
  }
#undef ATT_PREFETCH
  const float inv = 1.f / (l_run + __shfl_xor(l_run, 32));
  bf16_t* yp = Y + (size_t)(rowbase + qpos) * 1024 + 512 + head * 64;
#pragma unroll
  for (int g = 0; g < 4; ++g) {
    *(u32x2*)(yp + 8 * g + 4 * hh) = (u32x2){pack2(o0[4 * g] * inv, o0[4 * g + 1] * inv), pack2(o0[4 * g + 2] * inv, o0[4 * g + 3] * inv)};
    *(u32x2*)(yp + 32 + 8 * g + 4 * hh) = (u32x2){pack2(o1[4 * g] * inv, o1[4 * g + 1] * inv), pack2(o1[4 * g + 2] * inv, o1[4 * g + 3] * inv)};
  }
  __syncthreads();
}

DI float wave_incl_scan(float v, int lane) {
#pragma unroll
  for (int o = 1; o < 64; o <<= 1) { const float t = __shfl_up(v, o); if (lane >= o) v += t; }
  return v;
}
DI void dn1_phase(const Params& p, lptr lds, int l) {
  const int tid = tid_opaque(), wid = tid >> 6, lane = tid & 63;
  const int i2 = l >> 1, bid = bid_opaque(), G = gridDim.x, hd = bid & 7;
  bf16_t* P = (bf16_t*)(p.ws + WS_P);
  const bf16_t* halo = (const bf16_t*)(p.ws + WS_HALO);
  const float* ab = (const float*)(p.ws + WS_AB);
  LAS bf16_t* Raw = (LAS bf16_t*)lds;
  LAS float* X = (LAS float*)lds;
  LAS bf16_t* Kn = (LAS bf16_t*)(lds + 51456);
  LAS float* KK = (LAS float*)(lds + 68864);
  LAS float* Lm = (LAS float*)(lds + 85248);
  LAS float* gcs = (LAS float*)(lds + 118016);
  LAS float* bts = (LAS float*)(lds + 118528);
  const float alog0 = -__expf(p.in[25][(i2 * 2 + (wid & 1)) * 8 + hd]), dtb0 = p.in[26][(i2 * 2 + (wid & 1)) * 8 + hd];
  LAS float* cwl = (LAS float*)(lds + 131072);
  for (int e = tid; e < 1536; e += 512) { const int part = e >> 9, j = (e >> 7) & 3, c = e & 127; cwl[e] = p.in[24][((size_t)i2 * 4 + j) * 3072 + part * 1024 + hd * 128 + c]; }
  __syncthreads();
  u32x4 rv[7]; float pa0 = 0.f, pa1 = 0.f;
#define DN1_PREFETCH(item_) do { const int ck_ = (item_) >> 3; const int row0_ = ck_ * 64; \
    const int ci_ = ck_ < 64 ? (ck_ & 3) : ((ck_ - 64) & 63); const int nch_ = ck_ < 64 ? 4 : 64; \
    _Pragma("unroll") for (int k_ = 0; k_ < 7; ++k_) { \
      int e_ = tid + 512 * k_; if (e_ > 3215) e_ = 3215; \
      const int part_ = e_ / 1072, rem_ = e_ % 1072, rr_ = rem_ >> 4, pc_ = rem_ & 15, col_ = part_ * 1024 + hd * 128 + pc_ * 8; \
      const bool mid_ = rr_ >= 2 && rr_ < 66; \
      const bool zero_ = (rr_ < 2 && ci_ == 0) || (rr_ >= 66 && ci_ == nch_ - 1); \
      const bf16_t* srcp_ = mid_ ? P + (size_t)(row0_ + rr_ - 2) * ODD_LD + col_ \
                               : (rr_ < 2 ? halo + ((size_t)(ck_ - 1) * 3 + 1 + rr_) * 3072 + col_ : halo + ((size_t)(ck_ + 1) * 3) * 3072 + col_); \
      if (zero_) srcp_ = P + (size_t)row0_ * ODD_LD + col_; \
      u32x4 v_ = *(const u32x4*)srcp_; \
      if (zero_) v_ = (u32x4){0u, 0u, 0u, 0u}; \
      rv[k_] = v_; } \
    if (wid < 2) { const int t_ = wid ? 63 - lane : lane; pa0 = ab[(size_t)(row0_ + t_) * 32 + wid * 8 + hd]; pa1 = ab[(size_t)(row0_ + t_) * 32 + 16 + wid * 8 + hd]; } } while (0)
  if (bid < 4608) DN1_PREFETCH(bid);
  for (int item = bid; item < 4608; item += G) {
  const int ck = item >> 3;
  const int row0 = ck * 64;
  {
#pragma unroll
    for (int k = 0; k < 7; ++k) {
      int e = tid + 512 * k; if (e > 3215) e = 3215;
      const int part = e / 1072, rem = e % 1072, rr = rem >> 4, pc = rem & 15;
      *(LAS u32x4*)(Raw + (part * 67 + rr) * 128 + pc * 8) = rv[k];
    }
  }
  const float a0 = pa0, a1 = pa1;
  __syncthreads();
  if (item + G < 4608) DN1_PREFETCH(item + G);
#pragma unroll 3
  for (int tk = 0; tk < 6; ++tk) {
    const int task = tid + 512 * tk;
    const int c8i = task & 15, rp = task >> 4, part = tk >> 1, t = rp & 63, col = part * 1024 + hd * 128 + c8i * 8;
    float y[8];
#pragma unroll
    for (int e = 0; e < 8; ++e) y[e] = 0.f;
#pragma unroll
    for (int j = 0; j < 4; ++j) {
      const u32x4 raw = *(const LAS u32x4*)(Raw + (part * 67 + t + j) * 128 + c8i * 8);
      const f32x4 cw0 = *(const LAS f32x4*)(cwl + (part * 4 + j) * 128 + c8i * 8), cw1 = *(const LAS f32x4*)(cwl + (part * 4 + j) * 128 + c8i * 8 + 4);
      y[0] += cw0[0] * lo2f(raw.x); y[1] += cw0[1] * hi2f(raw.x); y[2] += cw0[2] * lo2f(raw.y); y[3] += cw0[3] * hi2f(raw.y);
      y[4] += cw1[0] * lo2f(raw.z); y[5] += cw1[1] * hi2f(raw.z); y[6] += cw1[2] * lo2f(raw.w); y[7] += cw1[3] * hi2f(raw.w);
    }
    float ss = 0.f;
#pragma unroll
    for (int e = 0; e < 8; ++e) { y[e] = siluf_(y[e]); ss += y[e] * y[e]; }
    if (part < 2) {
      ss += __shfl_xor(ss, 1); ss += __shfl_xor(ss, 2); ss += __shfl_xor(ss, 4); ss += __shfl_xor(ss, 8);
      const float sc = rsqrtf(ss + 1e-6f) * (part == 0 ? 0.08838834764831845f : 1.f);
#pragma unroll
      for (int e = 0; e < 8; ++e) y[e] *= sc;
    }
    const u32x4 w = (u32x4){pack2(y[0], y[1]), pack2(y[2], y[3]), pack2(y[4], y[5]), pack2(y[6], y[7])};
    *(u32x4*)(P + (size_t)(row0 + t) * ODD_LD + col) = w;
    if (part == 1) *(LAS u32x4*)(Kn + t * 136 + c8i * 8) = w;
  }
  if (wid < 2) {
    const int dir = wid;
    const float g = alog0 * softplusf_(a0 + dtb0);
    const float gcv = wave_incl_scan(g, lane), btv = sigmoidf_(a1);
    gcs[dir * 64 + lane] = gcv; bts[dir * 64 + lane] = btv;
    float* gcb = (float*)(p.ws + WS_CARRY) + ((size_t)(ck * 8 + hd) * 2 + dir) * 128;
    gcb[lane] = gcv; gcb[64 + lane] = btv;
  }
  __syncthreads();
  if (wid < 4) {
    const int it = wid >> 1, jt = wid & 1, hh = lane >> 5;
    const f32x16 acc = mm32(Kn + it * 32 * 136, 136, Kn + jt * 32 * 136, 136, 128, zero16(), lane);
#pragma unroll
    for (int ii = 0; ii < 16; ++ii) KK[(it * 32 + crow(ii, hh)) * 64 + jt * 32 + (lane & 31)] = acc[ii];
  }
  __syncthreads();
  for (int e0 = tid; e0 < 8192; e0 += 2048) {
    float wv[4];
#pragma unroll
    for (int k = 0; k < 4; ++k) {
      const int e = e0 + 512 * k, dir = e >> 12, ip = (e >> 6) & 63, jp = e & 63;
      const int ti = dir ? 63 - ip : ip, tj = dir ? 63 - jp : jp;
      const float w = bts[dir * 64 + ip] * KK[ti * 64 + tj] * __expf(fminf(gcs[dir * 64 + ip] - gcs[dir * 64 + jp], 0.f));
      wv[k] = (ip > jp) ? w : 0.f;
    }
#pragma unroll
    for (int k = 0; k < 4; ++k) Lm[e0 + 512 * k] = wv[k];
  }
  __syncthreads();
  for (int e = tid; e < 8192; e += 512) X[e] = 0.f;
  __syncthreads();
  {
    const int d = wid >> 2, bi = wid & 3;
    if (lane < 16) {
      const int c = lane; float x[16];
      const LAS float* L = Lm + d * 4096 + (16 * bi) * 64 + 16 * bi;
#pragma unroll
      for (int i = 0; i < 16; ++i) {
        float s = (c == i) ? 1.f : 0.f;
#pragma unroll
        for (int j = 0; j < i; ++j) s -= L[i * 64 + j] * x[j];
        x[i] = s;
      }
#pragma unroll
      for (int i = 0; i < 16; ++i) X[d * 4096 + (16 * bi + i) * 64 + 16 * bi + c] = x[i];
    }
  }
  __syncthreads();
  LAS float* Tm = (LAS float*)(lds + 119040) + wid * 256;
  for (int dd = 1; dd < 4; ++dd) {
    const int nb = 4 - dd; const bool act = wid < 2 * nb;
    const int d = act ? wid / nb : 0, bi = act ? dd + wid % nb : dd, bj = bi - dd;
    const int lr = lane & 15, lq = lane >> 4;
    if (act) {
      f32x4 acc = (f32x4){0.f, 0.f, 0.f, 0.f};
      for (int kb = bj; kb < bi; ++kb) {
#pragma unroll
        for (int kk = 0; kk < 4; ++kk) {
          const float a = Lm[d * 4096 + (16 * bi + lr) * 64 + 16 * kb + 4 * kk + lq];
          const float b = X[d * 4096 + (16 * kb + 4 * kk + lq) * 64 + 16 * bj + lr];
          acc = __builtin_amdgcn_mfma_f32_16x16x4f32(a, b, acc, 0, 0, 0);
        }
      }
#pragma unroll
      for (int rg = 0; rg < 4; ++rg) Tm[(lq * 4 + rg) * 16 + lr] = acc[rg];
    }
    __syncthreads();
    if (act) {
      f32x4 acc = (f32x4){0.f, 0.f, 0.f, 0.f};
#pragma unroll
      for (int kk = 0; kk < 4; ++kk) {
        const float a = X[d * 4096 + (16 * bi + lr) * 64 + 16 * bi + 4 * kk + lq];
        const float b = Tm[(4 * kk + lq) * 16 + lr];
        acc = __builtin_amdgcn_mfma_f32_16x16x4f32(a, b, acc, 0, 0, 0);
      }
#pragma unroll
      for (int rg = 0; rg < 4; ++rg) X[d * 4096 + (16 * bi + lq * 4 + rg) * 64 + 16 * bj + lr] = -acc[rg];
    }
    __syncthreads();
  }
  {
    bf16_t* Tg = (bf16_t*)(p.ws + WS_T) + ((size_t)(ck * 8 + hd) * 2) * 4096;
    for (int e = tid; e < 4096; e += 512) *(unsigned*)(Tg + 2 * e) = pack2(X[2 * e], X[2 * e + 1]);
  }
  __syncthreads();
  }
#undef DN1_PREFETCH
}

constexpr int DN2_DIR_BYTES = 80896;
DI void dn2_item(const Params& p, lptr lds, int l, int item) {
  const int tid = tid_opaque(), wid = tid >> 6, lane = tid & 63, r = lane & 31, hh = lane >> 5;
  const int i2 = l >> 1;
  const bool samp = item < 256;
  int b, hd, slab, nch, seqrow, ckb;
  if (samp) { b = item >> 5; hd = (item >> 2) & 7; slab = item & 3; nch = 64; seqrow = M_P + b * 4096; ckb = 64 + b * 64; }
  else { const int j = item - 256; b = j >> 5; hd = (j >> 2) & 7; slab = j & 3; nch = 4; seqrow = b * 256; ckb = b * 4; }
  const int dir = wid >> 2, w4 = wid & 3, td = tid & 255;
  const bf16_t* P = (const bf16_t*)(p.ws + WS_P);
  const bf16_t* Tg = (const bf16_t*)(p.ws + WS_T);
  const float* gcbase = (const float*)(p.ws + WS_CARRY);
  bf16_t* O = (bf16_t*)(p.ws + WS_H);
  lptr base = lds + dir * DN2_DIR_BYTES;
  LAS bf16_t* Qn = (LAS bf16_t*)base;
  LAS bf16_t* Kn = (LAS bf16_t*)(base + 17408);
  LAS bf16_t* Tm = (LAS bf16_t*)(base + 34816);
  LAS bf16_t* QK = (LAS bf16_t*)(base + 44032);
  LAS bf16_t* St = (LAS bf16_t*)(base + 53248);
  LAS bf16_t* Rt = (LAS bf16_t*)(base + 61952);
  LAS bf16_t* Vt = (LAS bf16_t*)(base + 66560);
  LAS bf16_t* Vn = (LAS bf16_t*)(base + 71168);
  LAS bf16_t* Vd = (LAS bf16_t*)(base + 75776);
  LAS float* gcs = (LAS float*)(base + 80384);
  LAS float* bts = gcs + 64;
  LAS float* egs = (LAS float*)(lds + 2 * DN2_DIR_BYTES) + dir * 128;
  LAS float* dds = egs + 64;
  f32x16 S;
  const size_t sidx = ((((size_t)(b * 2 + i2) * 2 + dir) * 8 + hd) * 128 + 32 * w4) * 128 + slab * 32 + r;
#pragma unroll
  for (int ii = 0; ii < 16; ++ii) S[ii] = samp ? p.in[6][sidx + (size_t)crow(ii, hh) * 128] : 0.f;
#pragma unroll
  for (int g = 0; g < 4; ++g) *(LAS u32x2*)(St + r * 136 + 32 * w4 + 8 * g + 4 * hh) = (u32x2){pack2(S[4 * g], S[4 * g + 1]), pack2(S[4 * g + 2], S[4 * g + 3])};
  u32x4 pq[4], pk[4], pt[2], pv; float pa0 = 0.f, pa1 = 0.f;
#define DN2_PREFETCH(sn) do { const int cn_ = dir ? nch - 1 - (sn) : (sn); const size_t r0_ = (size_t)seqrow + (size_t)cn_ * 64; \
    _Pragma("unroll") for (int k_ = 0; k_ < 4; ++k_) { const int e_ = td + 256 * k_, ip_ = e_ >> 4, pc_ = e_ & 15; const size_t rg_ = r0_ + (dir ? 63 - ip_ : ip_); \
      pq[k_] = *(const u32x4*)(P + rg_ * ODD_LD + hd * 128 + pc_ * 8); pk[k_] = *(const u32x4*)(P + rg_ * ODD_LD + 1024 + hd * 128 + pc_ * 8); } \
    _Pragma("unroll") for (int k_ = 0; k_ < 2; ++k_) { const int e_ = td + 256 * k_; pt[k_] = *(const u32x4*)(Tg + ((size_t)((ckb + cn_) * 8 + hd) * 2 + dir) * 4096 + e_ * 8); } \
    { const int ip_ = td >> 2, pc_ = td & 3; const size_t rg_ = r0_ + (dir ? 63 - ip_ : ip_); pv = *(const u32x4*)(P + rg_ * ODD_LD + 2048 + hd * 128 + slab * 32 + pc_ * 8); } \
    if (w4 == 0) { const float* gcb_ = gcbase + ((size_t)((ckb + cn_) * 8 + hd) * 2 + dir) * 128; pa0 = gcb_[lane]; pa1 = gcb_[64 + lane]; } } while (0)
  DN2_PREFETCH(0);
  f32x16 o1 = zero16();
  for (int s = 0; s < nch; ++s) {
    const int c = dir ? nch - 1 - s : s;
    const int row0c = seqrow + c * 64;
#pragma unroll
    for (int k = 0; k < 4; ++k) { const int e = td + 256 * k, ip = e >> 4, pc = e & 15; *(LAS u32x4*)(Qn + ip * 136 + pc * 8) = pq[k]; *(LAS u32x4*)(Kn + ip * 136 + pc * 8) = pk[k]; }
#pragma unroll
    for (int k = 0; k < 2; ++k) { const int e = td + 256 * k; *(LAS u32x4*)(Tm + (e >> 3) * 72 + (e & 7) * 8) = pt[k]; }
    { const int ip = td >> 2, pc = td & 3;
      Vt[(pc * 8 + 0) * 72 + ip] = (bf16_t)(pv.x & 0xffffu); Vt[(pc * 8 + 1) * 72 + ip] = (bf16_t)(pv.x >> 16);
      Vt[(pc * 8 + 2) * 72 + ip] = (bf16_t)(pv.y & 0xffffu); Vt[(pc * 8 + 3) * 72 + ip] = (bf16_t)(pv.y >> 16);
      Vt[(pc * 8 + 4) * 72 + ip] = (bf16_t)(pv.z & 0xffffu); Vt[(pc * 8 + 5) * 72 + ip] = (bf16_t)(pv.z >> 16);
      Vt[(pc * 8 + 6) * 72 + ip] = (bf16_t)(pv.w & 0xffffu); Vt[(pc * 8 + 7) * 72 + ip] = (bf16_t)(pv.w >> 16); }
    if (w4 == 0) { gcs[lane] = pa0; bts[lane] = pa1; egs[lane] = __expf(pa0); dds[lane] = __expf(__shfl(pa0, 63) - pa0); }
    __syncthreads();
    if (s + 1 < nch) DN2_PREFETCH(s + 1);
    bf16_t* const orow = O + (size_t)(row0c + (dir ? 63 - (td >> 2) : (td >> 2))) * 1024 + hd * 128 + slab * 32 + (td & 3) * 8;
    u32x4 po = (u32x4){0u, 0u, 0u, 0u};
    if (2 * s >= nch) po = *(const u32x4*)orow;
    {
      const int jt = w4 >> 1, it = w4 & 1;
      const LAS bf16_t* a2 = w4 < 2 ? Qn + w4 * 32 * 136 : Kn + (w4 - 2) * 32 * 136;
      f32x16 acc = zero16(), acc2 = zero16();
      {
        const LAS bf16_t* ap = Kn + jt * 32 * 136 + r * 136 + 8 * hh; const LAS bf16_t* bp = Qn + it * 32 * 136 + r * 136 + 8 * hh;
        const LAS bf16_t* cp = a2 + r * 136 + 8 * hh; const LAS bf16_t* dp = St + r * 136 + 8 * hh;
#pragma unroll 4
        for (int k0 = 0; k0 < 128; k0 += 16) {
          const bf16x8 fa = *(const LAS bf16x8*)(ap + k0), fb = *(const LAS bf16x8*)(bp + k0), fc = *(const LAS bf16x8*)(cp + k0), fd = *(const LAS bf16x8*)(dp + k0);
          acc = MFMA32(fa, fb, acc); acc2 = MFMA32(fc, fd, acc2);
        }
      }
      const int i = it * 32 + r; const float gi = gcs[i];
      f32x4 gjv[4];
#pragma unroll
      for (int g = 0; g < 4; ++g) gjv[g] = *(const LAS f32x4*)(gcs + jt * 32 + 8 * g + 4 * hh);
#pragma unroll
      for (int g = 0; g < 4; ++g) {
        const int j0 = jt * 32 + 8 * g + 4 * hh; float v[4];
        const f32x4 gj = gjv[g];
#pragma unroll
        for (int e = 0; e < 4; ++e) { const float w = acc[4 * g + e] * __expf(fminf(gi - gj[e], 0.f)); v[e] = (i >= j0 + e) ? w : 0.f; }
        *(LAS u32x2*)(QK + i * 72 + j0) = (u32x2){pack2(v[0], v[1]), pack2(v[2], v[3])};
      }
      if (w4 < 2) {
        o1 = acc2;
      } else {
        const int jt2 = w4 - 2;
#pragma unroll
        for (int g = 0; g < 4; ++g) {
          const int j0 = jt2 * 32 + 8 * g + 4 * hh;
          const u32x2 vv = *(const LAS u32x2*)(Vt + r * 72 + j0);
          const float ve[4] = {lo2f(vv.x), hi2f(vv.x), lo2f(vv.y), hi2f(vv.y)}; float rv[4];
          const f32x4 gj4 = *(const LAS f32x4*)(egs + j0), bj4 = *(const LAS f32x4*)(bts + j0);
#pragma unroll
          for (int e = 0; e < 4; ++e) rv[e] = bj4[e] * (ve[e] - gj4[e] * acc2[4 * g + e]);
          *(LAS u32x2*)(Rt + r * 72 + j0) = (u32x2){pack2(rv[0], rv[1]), pack2(rv[2], rv[3])};
        }
      }
    }
    __syncthreads();
    if (w4 >= 2) {
      const int it = w4 - 2;
      const f32x16 acc = mm32(Tm + it * 32 * 72, 72, Rt, 72, 64, zero16(), lane);
      f32x4 ddv[4];
#pragma unroll
      for (int g = 0; g < 4; ++g) ddv[g] = *(const LAS f32x4*)(dds + it * 32 + 8 * g + 4 * hh);
#pragma unroll
      for (int g = 0; g < 4; ++g) {
        const int i0 = it * 32 + 8 * g + 4 * hh; float dv[4];
        const f32x4 gi4 = ddv[g];
#pragma unroll
        for (int e = 0; e < 4; ++e) dv[e] = acc[4 * g + e] * gi4[e];
        *(LAS u32x2*)(Vn + r * 72 + i0) = (u32x2){pack2(acc[4 * g], acc[4 * g + 1]), pack2(acc[4 * g + 2], acc[4 * g + 3])};
        *(LAS u32x2*)(Vd + r * 72 + i0) = (u32x2){pack2(dv[0], dv[1]), pack2(dv[2], dv[3])};
      }
    }
    __syncthreads();
    if (w4 < 2) {
      const int it = w4;
#pragma unroll
      for (int g = 0; g < 4; ++g) { const f32x4 gi4 = *(const LAS f32x4*)(egs + it * 32 + 8 * g + 4 * hh);
#pragma unroll
        for (int e = 0; e < 4; ++e) o1[4 * g + e] *= gi4[e]; }
      o1 = mm32(QK + it * 32 * 72, 72, Vn, 72, 64, o1, lane);
#pragma unroll
      for (int ii = 0; ii < 16; ++ii) Rt[(it * 32 + crow(ii, hh)) * 32 + r] = f2bf(o1[ii]);
    }
    {
      const float gl = egs[63];
#pragma unroll
      for (int ii = 0; ii < 16; ++ii) S[ii] *= gl;
#pragma unroll
      for (int jt = 0; jt < 2; ++jt) {
        unsigned x[16];
#pragma unroll
        for (int ii = 0; ii < 16; ++ii) x[ii] = Kn[(jt * 32 + crow(ii, hh)) * 136 + 32 * w4 + r];
#pragma unroll
        for (int s2 = 0; s2 < 2; ++s2) {
          const u32x4 aw = (u32x4){x[8 * s2] | (x[8 * s2 + 1] << 16), x[8 * s2 + 2] | (x[8 * s2 + 3] << 16), x[8 * s2 + 4] | (x[8 * s2 + 5] << 16), x[8 * s2 + 6] | (x[8 * s2 + 7] << 16)};
          const LAS bf16_t* bp = Vd + r * 72 + jt * 32 + 16 * s2 + 4 * hh;
          const u32x2 lo = *(const LAS u32x2*)bp, hi = *(const LAS u32x2*)(bp + 8);
          S = MFMA32(__builtin_bit_cast(bf16x8, aw), __builtin_bit_cast(bf16x8, ((u32x4){lo.x, lo.y, hi.x, hi.y})), S);
        }
      }
#pragma unroll
      for (int g = 0; g < 4; ++g) *(LAS u32x2*)(St + r * 136 + 32 * w4 + 8 * g + 4 * hh) = (u32x2){pack2(S[4 * g], S[4 * g + 1]), pack2(S[4 * g + 2], S[4 * g + 3])};
    }
    __syncthreads();
    {
      u32x4 ov = *(const LAS u32x4*)(Rt + (td >> 2) * 32 + (td & 3) * 8);
      if (2 * s >= nch) {
        ov.x = pack2(lo2f(ov.x) + lo2f(po.x), hi2f(ov.x) + hi2f(po.x)); ov.y = pack2(lo2f(ov.y) + lo2f(po.y), hi2f(ov.y) + hi2f(po.y));
        ov.z = pack2(lo2f(ov.z) + lo2f(po.z), hi2f(ov.z) + hi2f(po.z)); ov.w = pack2(lo2f(ov.w) + lo2f(po.w), hi2f(ov.w) + hi2f(po.w));
      }
      *(u32x4*)orow = ov;
    }
  }
#undef DN2_PREFETCH
  if (!samp) {
    const size_t oidx = (size_t)OFF_DN + ((((size_t)(b * 2 + i2) * 2 + dir) * 8 + hd) * 128 + 32 * w4) * 128 + slab * 32 + r;
#pragma unroll
    for (int ii = 0; ii < 16; ++ii) p.out[oidx + (size_t)crow(ii, hh) * 128] = S[ii];
  }
}

DI void phase_dn3(const Params& p, int l) {
  const int i2 = l >> 1;
  bf16_t* Y = (bf16_t*)(p.ws + WS_H);
  const bf16_t* P = (const bf16_t*)(p.ws + WS_P);
  const float* gain = p.in[27] + i2 * 128;
  const int tstride = gridDim.x * 512, ntask = M_TOT * 128;
  u32x4 ov[2], zv[2], nov[2], nzv[2];
  int task0 = bid_opaque() * 512 + tid_opaque();
#define DN3_LOAD(ovv, zvv, t0_) do { _Pragma("unroll") for (int q_ = 0; q_ < 2; ++q_) { \
      int task_ = (t0_) + q_ * tstride; if (task_ >= ntask) task_ = bid_opaque() * 512 + tid_opaque(); \
      const int pc_ = task_ & 15, rh_ = task_ >> 4, hd_ = rh_ & 7, row_ = rh_ >> 3, col_ = hd_ * 128 + pc_ * 8; \
      ovv[q_] = *(const u32x4*)(Y + (size_t)row_ * 1024 + col_); zvv[q_] = *(const u32x4*)(P + (size_t)row_ * ODD_LD + 3072 + col_); } } while (0)
  if (task0 < ntask) DN3_LOAD(ov, zv, task0);
  const f32x4 g0 = *(const f32x4*)(gain + (tid_opaque() & 15) * 8), g1 = *(const f32x4*)(gain + (tid_opaque() & 15) * 8 + 4);
  const float gg[8] = {g0[0], g0[1], g0[2], g0[3], g1[0], g1[1], g1[2], g1[3]};
  for (; task0 < ntask; task0 += 2 * tstride) {
    if (task0 + 2 * tstride < ntask) DN3_LOAD(nov, nzv, task0 + 2 * tstride);
#pragma unroll
    for (int q = 0; q < 2; ++q) {
      const int task = task0 + q * tstride;
      const int pc = task & 15, rh = task >> 4, hd = rh & 7, row = rh >> 3, col = hd * 128 + pc * 8;
      float o[8] = {lo2f(ov[q].x), hi2f(ov[q].x), lo2f(ov[q].y), hi2f(ov[q].y), lo2f(ov[q].z), hi2f(ov[q].z), lo2f(ov[q].w), hi2f(ov[q].w)};
      const float z[8] = {lo2f(zv[q].x), hi2f(zv[q].x), lo2f(zv[q].y), hi2f(zv[q].y), lo2f(zv[q].z), hi2f(zv[q].z), lo2f(zv[q].w), hi2f(zv[q].w)};
      float ss = 0.f;
#pragma unroll
      for (int e = 0; e < 8; ++e) ss += o[e] * o[e];
      ss += __shfl_xor(ss, 1); ss += __shfl_xor(ss, 2); ss += __shfl_xor(ss, 4); ss += __shfl_xor(ss, 8);
      const float rstd = rsqrtf(ss * (1.f / 128.f) + 1e-6f);
#pragma unroll
      for (int e = 0; e < 8; ++e) o[e] = o[e] * rstd * gg[e] * siluf_(z[e]);
      if (task < ntask) *(u32x4*)(Y + (size_t)row * 1024 + col) = (u32x4){pack2(o[0], o[1]), pack2(o[2], o[3]), pack2(o[4], o[5]), pack2(o[6], o[7])};
    }
#pragma unroll
    for (int q = 0; q < 2; ++q) { ov[q] = nov[q]; zv[q] = nzv[q]; }
  }
#undef DN3_LOAD
}

constexpr int ROWS_A = 32768;
constexpr int N_PHASES = 1 + 11 + 11 + 10 + 11;
enum { ST_N1, ST_IN, ST_M0, ST_M1, ST_M2, ST_OUTA, ST_OUTB, ST_N2T, ST_GU, ST_DNA, ST_DNB, ST_N1T };
DI void run_phase(const Params& p, lptr lds, int ph) {
  const int G = gridDim.x, bid = bid_opaque();
  if (ph == 0) { phase_pre(p, lds, 0, G == 256 ? 2 : 4, bid, G, true); return; }
  int l, k; { int q = ph - 1; if (q < 11) { l = 0; k = q; } else if (q < 22) { l = 1; k = q - 11; } else if (q < 32) { l = 2; k = q - 22; } else { l = 3; k = q - 32; } }
  const bool odd = l & 1; const int i2 = l >> 1;
  int st;
  if (l == 0) { const int tab[11] = {ST_N1, ST_IN, ST_M0, ST_M1, ST_OUTA, ST_OUTB, ST_N2T, ST_GU, ST_DNA, ST_DNB, ST_N1T}; st = tab[k]; }
  else if (odd) { const int tab[11] = {ST_IN, ST_M0, ST_M1, ST_M2, ST_OUTA, ST_OUTB, ST_N2T, ST_GU, ST_DNA, ST_DNB, ST_N1T}; st = tab[k]; }
  else { const int tab[10] = {ST_IN, ST_M0, ST_M1, ST_OUTA, ST_OUTB, ST_N2T, ST_GU, ST_DNA, ST_DNB, ST_N1T}; st = tab[k]; }
  float* mod = (float*)(p.ws + WS_MOD);
  bf16_t* H = (bf16_t*)(p.ws + WS_H); bf16_t* Pb = (bf16_t*)(p.ws + WS_P);
  if (st == ST_N1) { phase_norm(p, lds, l, 0); return; }
  if (st == ST_IN) {
    pg8::EpiIn E; E.P = Pb; E.ldp = odd ? ODD_LD : EVEN_IN; E.odd = odd ? 1 : 0;
    E.kout = p.out + OFF_K + (size_t)i2 * 256 * 128; E.vout = p.out + OFF_V + (size_t)i2 * 256 * 128;
    E.ab = (float*)(p.ws + WS_AB); E.halo = (bf16_t*)(p.ws + WS_HALO);
    run_gemm(lds, H, (const bf16_t*)(p.ws + WS_WIN), odd ? ODD_NP : EVEN_IN, 1024, E); return;
  }
  if (st == ST_M0 || st == ST_M1 || st == ST_M2) {
    const int ms = st - ST_M0;
    if (ms == 0 && l > 0) { cvt_layer(p, lds, l, 4, bid, G); __syncthreads(); }
    if (!odd) {
      if (ms == 0) {
        for (int it = bid; it < 1152; it += G) att_item(p, lds, l, it);
        rg_phase(p, lds, l, 0);
      } else { rg_phase(p, lds, l, 1); }
    } else {
      if (ms == 0) dn1_phase(p, lds, l);
      else if (ms == 1) {
        for (int it = bid; it < 768; it += G) {
          const int grp = it >> 8, j = it & 255, xcd = j & 7, idx = j >> 3;
          dn2_item(p, lds, l, grp * 256 + ((xcd * 8 + (idx >> 2)) * 4 + (idx & 3))); __syncthreads();
        }
      }
      else phase_dn3(p, l);
    }
    return;
  }
  if (st == ST_OUTA || st == ST_OUTB) {
    pg8::EpiRes E; E.x = p.out; E.ga_base = mod + (size_t)l * 9 * 6144 + 2048;
    if (st == ST_OUTA) { E.rbase = 0; run_gemm_sub(lds, H, (const bf16_t*)(p.ws + WS_WOUT), ROWS_A, 1024, 1024, E, bid, G); return; }
    if (bid < 64) { E.rbase = ROWS_A; run_gemm_sub(lds, H + (size_t)ROWS_A * 1024, (const bf16_t*)(p.ws + WS_WOUT), M_TOT - ROWS_A, 1024, 1024, E, bid, 64); }
    else norm_rows(p, l, 1, 0, ROWS_A, bid - 64, G - 64);
    return;
  }
  if (st == ST_N2T) { norm_rows(p, l, 1, ROWS_A, M_TOT, bid, G); return; }
  if (st == ST_GU) { pg8::EpiGU E; E.act = Pb; run_gemm(lds, H, (const bf16_t*)(p.ws + WS_WGU), 5632, 1024, E); return; }
  if (st == ST_DNA || st == ST_DNB) {
    pg8::EpiRes E; E.x = p.out; E.ga_base = mod + (size_t)l * 9 * 6144 + 5120;
    if (st == ST_DNA) { E.rbase = 0; run_gemm_sub(lds, Pb, (const bf16_t*)(p.ws + WS_WDN), ROWS_A, 1024, DFF, E, bid, G); return; }
    if (bid < 64) { E.rbase = ROWS_A; run_gemm_sub(lds, Pb + (size_t)ROWS_A * DFF, (const bf16_t*)(p.ws + WS_WDN), M_TOT - ROWS_A, 1024, DFF, E, bid, 64); }
    else {
      if (l < 3) { norm_rows(p, l + 1, 0, 0, ROWS_A, bid - 64, G - 64); cvt_layer(p, lds, l + 1, 3, bid - 64, G - 64); if (l == 0 && G == 256) { __syncthreads(); phase_pre(p, lds, 2, 4, bid - 64, G - 64, false); } }
      else norm_rows(p, 0, 2, 0, ROWS_A, bid - 64, G - 64);
    }
    return;
  }
  if (l < 3) norm_rows(p, l + 1, 0, ROWS_A, M_TOT, bid, G); else norm_rows(p, 0, 2, ROWS_A, M_TOT, bid, G);
}

#define XB_TMO      128
#define XB_XCNT(j)  (256  + 64 * (j))
#define XB_XSUB(j)  (1280 + 64 * (j))
#define XB_XGEN(j)  (2304 + 64 * (j))
#define XB_TOP      3328
#define XB_TOPGEN   3392
#define XCD_BAR_WORDS 3456
#define XB_SPIN_CAP (1u << 20)
DI unsigned xb_ld(unsigned* p) { return __hip_atomic_load(p, __ATOMIC_RELAXED, __HIP_MEMORY_SCOPE_AGENT); }
DI unsigned xb_add(unsigned* p, unsigned v) { return __hip_atomic_fetch_add(p, v, __ATOMIC_RELAXED, __HIP_MEMORY_SCOPE_AGENT); }
DI unsigned xb_xcc_id() { return (unsigned)__builtin_amdgcn_s_getreg((3 << 11) | 20) & 0xFu; }
#define XB_SPIN(cond, bar) do { unsigned _sp = 0; while (cond) { __builtin_amdgcn_s_sleep(1); \
    if ((++_sp & 255u) == 0u) { if (xb_ld(&(bar)[XB_TMO])) break; if (_sp > XB_SPIN_CAP) { atomicAdd(&(bar)[XB_TMO], 1u); break; } } } } while (0)
struct XcdBarrier { unsigned* bar; unsigned x; volatile LAS unsigned* st; };
DI XcdBarrier xcd_barrier_post(unsigned* bar, volatile LAS unsigned* st) {
  XcdBarrier b; b.bar = bar; b.x = xb_xcc_id(); b.st = st;
  if (threadIdx.x == 0) (void)xb_add(&bar[XB_XCNT(b.x)], 1u);
  return b;
}
DI void xcd_barrier_complete(unsigned* bar, unsigned x, unsigned& nloc, unsigned& nx) {
  const unsigned G = gridDim.x;
  unsigned sum, cnt, mine, sp = 0u;
  for (;;) {
    sum = 0u; cnt = 0u; mine = 0u;
#pragma unroll
    for (unsigned j = 0; j < 16; ++j) { const unsigned c = xb_ld(&bar[XB_XCNT(j)]); sum += c; cnt += (c > 0u) ? 1u : 0u; mine = (j == x) ? c : mine; }
    if (sum == G) break;
    __builtin_amdgcn_s_sleep(1);
    if ((++sp & 255u) == 0u) { if (xb_ld(&bar[XB_TMO])) break; if (sp > XB_SPIN_CAP) { atomicAdd(&bar[XB_TMO], 1u); break; } }
  }
  nloc = mine > 0u ? mine : 1u; nx = cnt > 0u ? cnt : 1u;
}
DI void xcd_barrier(const XcdBarrier& b) {
  asm volatile("s_waitcnt vmcnt(0)" ::: "memory");
  __syncthreads();
  if (threadIdx.x == 0) {
    unsigned* bar = b.bar;
    __builtin_amdgcn_s_waitcnt(0);
    unsigned nloc = b.st[0], nx = b.st[1];
    if (nloc == 0u) { xcd_barrier_complete(bar, b.x, nloc, nx); b.st[0] = nloc; b.st[1] = nx; }
    const unsigned old = xb_add(&bar[XB_XSUB(b.x)], 1u);
    const unsigned gen = old / nloc;
    if (old + 1u == (gen + 1u) * nloc) {
      __builtin_amdgcn_fence(__ATOMIC_RELEASE, "agent");
      asm volatile("s_waitcnt vmcnt(0)" ::: "memory");
      const unsigned og = xb_add(&bar[XB_TOP], 1u);
      const unsigned tg = og / nx;
      if (og + 1u == (tg + 1u) * nx) xb_add(&bar[XB_TOPGEN], 1u);
      else XB_SPIN(xb_ld(&bar[XB_TOPGEN]) == tg, bar);
      __builtin_amdgcn_fence(__ATOMIC_ACQUIRE, "agent");
      xb_add(&bar[XB_XGEN(b.x)], 1u);
      asm volatile("s_waitcnt vmcnt(0)" ::: "memory");
    } else {
      XB_SPIN(xb_ld(&bar[XB_XGEN(b.x)]) == gen, bar);
      __builtin_amdgcn_fence(__ATOMIC_ACQUIRE, "agent");
      asm volatile("s_waitcnt vmcnt(0)" ::: "memory");
    }
  }
  __syncthreads();
}

__global__ void __launch_bounds__(512, 2) fwd_kernel(Params p) {
  extern __shared__ __attribute__((aligned(16))) unsigned char smem[];
  lptr lds = (lptr)smem;
  cg::grid_group grid = cg::this_grid();
  volatile LAS unsigned* xst = (volatile LAS unsigned*)(lds + LDS_BYTES - 16);
  if (threadIdx.x == 0) { xst[0] = 0u; xst[1] = 0u; }
  __syncthreads();
  const XcdBarrier xb = xcd_barrier_post((unsigned*)(p.ws + WS_BAR), xst);
  const int p_lo = p.p_lo, p_hi = p.p_hi, coop = p.coop;
  for (int ph = p_lo; ph < p_hi; ++ph) {
    unsigned long long kav = (unsigned long long)__builtin_amdgcn_kernarg_segment_ptr();
    asm volatile("" : "+s"(kav));
    const __attribute__((address_space(4))) Params* kp = (const __attribute__((address_space(4))) Params*)kav;
    run_phase(*(const Params*)kp, lds, ph);
    if (coop && ph + 1 < p_hi) {
      if (ph == p_lo) grid.sync();
      else xcd_barrier(xb);
    }
  }
}

extern "C" void kernel_launch(void* const* d_in, const int* in_sizes, int n_in, void* d_out, int out_size, void* d_ws, size_t ws_size, hipStream_t stream) {
  static int grid = 0;
  if (grid == 0) {
    if (n_in != 31 || ws_size < WS_TOTAL) { fprintf(stderr, "kernel_launch: unexpected n_in %d or ws_size %zu (need %zu)\n", n_in, ws_size, (size_t)WS_END); grid = -1; return; }
    int dev = 0, cus = 0, per_cu = 0;
    hipGetDevice(&dev);
    hipDeviceGetAttribute(&cus, hipDeviceAttributeMultiprocessorCount, dev);
    if (hipFuncSetAttribute((const void*)fwd_kernel, hipFuncAttributeMaxDynamicSharedMemorySize, LDS_BYTES) != hipSuccess) { fprintf(stderr, "kernel_launch: hipFuncSetAttribute failed\n"); }
    hipOccupancyMaxActiveBlocksPerMultiprocessor(&per_cu, (const void*)fwd_kernel, 512, LDS_BYTES);
    (void)hipGetLastError();
    if (per_cu < 1) per_cu = 1;
    grid = cus * per_cu;
    if (grid > 256) grid = 256;
    fprintf(stderr, "kernel_launch: cus %d per_cu %d grid %d ws %zu need %zu\n", cus, per_cu, grid, ws_size, (size_t)WS_END);
  }
  if (grid < 0) return;
  if (hipMemsetAsync((char*)d_ws + WS_BAR, 0, 16384, stream) != hipSuccess) fprintf(stderr, "kernel_launch: memset failed\n");
  Params p{};
  for (int i = 0; i < 31; ++i) p.in[i] = (const float*)d_in[i];
  p.out = (float*)d_out; p.ws = (unsigned char*)d_ws; p.p_lo = 0; p.p_hi = N_PHASES; p.coop = 1; p.pad = 0;
  void* args[] = {&p};
  hipError_t e = hipLaunchCooperativeKernel((const void*)fwd_kernel, dim3(grid), dim3(512), args, LDS_BYTES, stream);
  if (e != hipSuccess) fprintf(stderr, "cooperative launch failed: %s (grid %d)\n", hipGetErrorString(e), grid);
}
```
